# Optimizing an MI355X kernel written in HIP

```python
import math
import jax, jax.numpy as jnp
from jax import lax
import numpy as np

D_MODEL = 1024
BATCH = 4
SEQ = 8192
DEPTH = 4

MIX_WIDTH = 2 * D_MODEL
N_GROUPS = 4
GROUP_WIDTH = MIX_WIDTH // N_GROUPS
N_IN_SPLITS = 10
IN_WIDTH = N_IN_SPLITS * GROUP_WIDTH
EPS = 1e-6
S5_CH = 16
S5_GROUPS = GROUP_WIDTH // S5_CH
S5_STATE = 64
S5_DT_MIN = 1e-3
S5_DT_MAX = 1e-1
DA_HEADS = 4
DA_HEAD_DIM = GROUP_WIDTH // DA_HEADS // 2
DA_V_DIM = 2 * DA_HEAD_DIM
ROPE_THETA = 500000.0
ROPE_DIMS = DA_HEAD_DIM // 4
Q_BLOCK = 128
LRU_BLOCKS = 8
LRU_BLOCK_DIM = GROUP_WIDTH // LRU_BLOCKS
LRU_C = 8.0
CONV_WIDTH = 4
MEM_TOKENS = 256
MEM_HEADS = 4
MEM_HEAD_DIM = GROUP_WIDTH // MEM_HEADS

kernel_name = "hymba_s5_diffattn_rglru_memory"

F32 = jnp.float32


def rms_norm(x, g):
    xf = x.astype(F32)
    y = xf * lax.rsqrt(jnp.mean(xf * xf, axis=-1, keepdims=True) + EPS)
    return (y * g.astype(F32)).astype(x.dtype)


def rope_partial(x, cos, sin):
    xf = x.astype(F32)
    half = ROPE_DIMS // 2
    x1, x2, xp = xf[..., :half], xf[..., half:ROPE_DIMS], xf[..., ROPE_DIMS:]
    out = jnp.concatenate([x1 * cos - x2 * sin, x2 * cos + x1 * sin, xp], axis=-1)
    return out.astype(x.dtype)


def s5_mixer(u, lam_re, lam_im, log_dt, b_re, b_im, c_re, c_im, d_skip, w_glu):
    B, L, _ = u.shape
    uf = u.astype(F32).reshape(B, L, S5_GROUPS, S5_CH)
    dt = jnp.exp(log_dt.astype(F32))[:, None]
    lr, li = lam_re.astype(F32), lam_im.astype(F32)
    mag = jnp.exp(lr * dt)
    abar_re = mag * jnp.cos(li * dt)
    abar_im = mag * jnp.sin(li * dt)
    den = lr * lr + li * li
    nr, ni = abar_re - 1.0, abar_im
    f_re = (nr * lr + ni * li) / den
    f_im = (ni * lr - nr * li) / den
    br, bi = b_re.astype(F32), b_im.astype(F32)
    bb_re = f_re[..., None] * br - f_im[..., None] * bi
    bb_im = f_re[..., None] * bi + f_im[..., None] * br
    bu_re = jnp.einsum('blgh,gph->blgp', uf, bb_re)
    bu_im = jnp.einsum('blgh,gph->blgp', uf, bb_im)
    a_re = jnp.broadcast_to(abar_re, bu_re.shape)
    a_im = jnp.broadcast_to(abar_im, bu_im.shape)

    def combine(e1, e2):
        a1r, a1i, b1r, b1i = e1
        a2r, a2i, b2r, b2i = e2
        return (a2r * a1r - a2i * a1i,
                a2r * a1i + a2i * a1r,
                a2r * b1r - a2i * b1i + b2r,
                a2r * b1i + a2i * b1r + b2i)

    _, _, xr, xi = lax.associative_scan(combine, (a_re, a_im, bu_re, bu_im), axis=1)
    y = (jnp.einsum('blgp,ghp->blgh', xr, c_re.astype(F32))
         - jnp.einsum('blgp,ghp->blgh', xi, c_im.astype(F32))
         + d_skip.astype(F32) * uf)
    y = jax.nn.gelu(y.reshape(B, L, GROUP_WIDTH)).astype(u.dtype)
    ga, gb = jnp.split(y @ w_glu, 2, axis=-1)
    return ga * jax.nn.sigmoid(gb)


def diff_attention(q, k, v, lam):
    B, L = q.shape[:2]
    nb = L // Q_BLOCK
    scale = DA_HEAD_DIM ** -0.5
    k1, k2 = k[..., 0, :], k[..., 1, :]
    qb = (q * scale).reshape(B, nb, Q_BLOCK, DA_HEADS, 2, DA_HEAD_DIM)
    qb = jnp.moveaxis(qb, 1, 0)
    kpos = jnp.arange(L)

    def block(args):
        qblk, i = args
        qpos = i * Q_BLOCK + jnp.arange(Q_BLOCK)
        mask = kpos[None, :] <= qpos[:, None]
        s1 = jnp.einsum('bqhd,bkhd->bhqk', qblk[..., 0, :], k1).astype(F32)
        s2 = jnp.einsum('bqhd,bkhd->bhqk', qblk[..., 1, :], k2).astype(F32)
        s1 = jnp.where(mask, s1, -1e30)
        s2 = jnp.where(mask, s2, -1e30)
        p = jax.nn.softmax(s1, axis=-1) - lam * jax.nn.softmax(s2, axis=-1)
        return jnp.einsum('bhqk,bkhd->bqhd', p.astype(v.dtype), v)

    out = lax.map(block, (qb, jnp.arange(nb)))
    return jnp.moveaxis(out, 0, 1).reshape(B, L, DA_HEADS, DA_V_DIM)


def rglru_mixer(x, conv_w, conv_b, w_a, b_a, w_x, b_x, lam):
    B, L, W = x.shape
    xc = lax.conv_general_dilated(
        x, conv_w[:, None, :], window_strides=(1,), padding=((CONV_WIDTH - 1, 0),),
        dimension_numbers=('NWC', 'WIO', 'NWC'), feature_group_count=W) + conv_b
    xf = xc.astype(F32)
    xb = xf.reshape(B, L, LRU_BLOCKS, LRU_BLOCK_DIM)
    r = jax.nn.sigmoid(jnp.einsum('blni,nij->blnj', xb, w_a.astype(F32)).reshape(B, L, W)
                       + b_a.astype(F32))
    i = jax.nn.sigmoid(jnp.einsum('blni,nij->blnj', xb, w_x.astype(F32)).reshape(B, L, W)
                       + b_x.astype(F32))
    log_a = -LRU_C * r * jax.nn.softplus(-lam.astype(F32))
    a = jnp.exp(log_a)
    mult = jnp.sqrt(-jnp.expm1(2.0 * log_a))
    b = mult * (i * xf)

    def combine(e1, e2):
        a1, b1 = e1
        a2, b2 = e2
        return a2 * a1, a2 * b1 + b2

    _, h = lax.associative_scan(combine, (a, b), axis=1)
    return h.astype(x.dtype)


def memory_attention(q, mem_n, w_mem_kv):
    B, L = q.shape[:2]
    k, v = jnp.split(mem_n @ w_mem_kv, 2, axis=-1)
    k = k.reshape(B, -1, MEM_HEADS, MEM_HEAD_DIM)
    v = v.reshape(B, -1, MEM_HEADS, MEM_HEAD_DIM)
    qh = q.reshape(B, L, MEM_HEADS, MEM_HEAD_DIM)
    s = jnp.einsum('blhd,bmhd->bhlm', qh, k).astype(F32) * (MEM_HEAD_DIM ** -0.5)
    p = jax.nn.softmax(s, axis=-1)
    return jnp.einsum('bhlm,bmhd->blhd', p.astype(v.dtype), v).reshape(B, L, GROUP_WIDTH)


def setup_inputs(seed: int = 0) -> dict:
    key = jax.random.key(seed)
    ks = jax.random.split(key, 32)

    def nrm(k, shape, scale):
        return jax.random.normal(k, shape, F32) * scale

    x = nrm(ks[0], (BATCH, SEQ, D_MODEL), 1.0)
    mem = nrm(ks[1], (BATCH, MEM_TOKENS, D_MODEL), 1.0)
    positions = jnp.broadcast_to(jnp.arange(SEQ, dtype=jnp.int32)[None, :], (BATCH, SEQ))
    norm_g = 1.0 + nrm(ks[2], (DEPTH, D_MODEL), 0.02)
    w_in = nrm(ks[3], (DEPTH, D_MODEL, IN_WIDTH), D_MODEL ** -0.5)
    w_out = nrm(ks[4], (DEPTH, MIX_WIDTH, D_MODEL), MIX_WIDTH ** -0.5)
    n = jnp.arange(S5_STATE, dtype=F32)
    s5_lambda_re = -0.5 + nrm(ks[5], (DEPTH, S5_GROUPS, S5_STATE), 0.01)
    s5_lambda_im = math.pi * n + nrm(ks[6], (DEPTH, S5_GROUPS, S5_STATE), 0.01)
    s5_log_dt = jax.random.uniform(ks[7], (DEPTH, S5_GROUPS), F32,
                                   math.log(S5_DT_MIN), math.log(S5_DT_MAX))
    bscale = (2.0 * S5_CH) ** -0.5
    cscale = (2.0 * S5_STATE) ** -0.5
    s5_b_re = nrm(ks[8], (DEPTH, S5_GROUPS, S5_STATE, S5_CH), bscale)
    s5_b_im = nrm(ks[9], (DEPTH, S5_GROUPS, S5_STATE, S5_CH), bscale)
    s5_c_re = nrm(ks[10], (DEPTH, S5_GROUPS, S5_CH, S5_STATE), cscale)
    s5_c_im = nrm(ks[11], (DEPTH, S5_GROUPS, S5_CH, S5_STATE), cscale)
    s5_d = nrm(ks[12], (DEPTH, S5_GROUPS, S5_CH), 1.0)
    s5_w_glu = nrm(ks[13], (DEPTH, GROUP_WIDTH, 2 * GROUP_WIDTH), GROUP_WIDTH ** -0.5)
    da_lambda_q1 = nrm(ks[14], (DEPTH, DA_HEAD_DIM), 0.1)
    da_lambda_k1 = nrm(ks[15], (DEPTH, DA_HEAD_DIM), 0.1)
    da_lambda_q2 = nrm(ks[16], (DEPTH, DA_HEAD_DIM), 0.1)
    da_lambda_k2 = nrm(ks[17], (DEPTH, DA_HEAD_DIM), 0.1)
    da_subln_g = 1.0 + nrm(ks[18], (DEPTH, DA_V_DIM), 0.02)
    lru_conv_w = nrm(ks[19], (DEPTH, CONV_WIDTH, GROUP_WIDTH), CONV_WIDTH ** -0.5)
    lru_conv_b = nrm(ks[20], (DEPTH, GROUP_WIDTH), 0.01)
    lru_w_a = nrm(ks[21], (DEPTH, LRU_BLOCKS, LRU_BLOCK_DIM, LRU_BLOCK_DIM), LRU_BLOCK_DIM ** -0.5)
    lru_b_a = nrm(ks[22], (DEPTH, GROUP_WIDTH), 0.01)
    lru_w_x = nrm(ks[23], (DEPTH, LRU_BLOCKS, LRU_BLOCK_DIM, LRU_BLOCK_DIM), LRU_BLOCK_DIM ** -0.5)
    lru_b_x = nrm(ks[24], (DEPTH, GROUP_WIDTH), 0.01)
    ua = jax.random.uniform(ks[25], (DEPTH, GROUP_WIDTH), F32, 0.9, 0.999)
    sa = ua ** (1.0 / LRU_C)
    lru_lambda = jnp.log(sa) - jnp.log1p(-sa)
    mem_norm_g = 1.0 + nrm(ks[26], (DEPTH, D_MODEL), 0.02)
    w_mem_kv = nrm(ks[27], (DEPTH, D_MODEL, 2 * GROUP_WIDTH), D_MODEL ** -0.5)
    final_norm_g = 1.0 + nrm(ks[28], (D_MODEL,), 0.02)
    return {"x": x, "mem": mem, "positions": positions, "norm_g": norm_g,
            "w_in": w_in, "w_out": w_out,
            "s5_lambda_re": s5_lambda_re, "s5_lambda_im": s5_lambda_im, "s5_log_dt": s5_log_dt,
            "s5_b_re": s5_b_re, "s5_b_im": s5_b_im, "s5_c_re": s5_c_re, "s5_c_im": s5_c_im,
            "s5_d": s5_d, "s5_w_glu": s5_w_glu,
            "da_lambda_q1": da_lambda_q1, "da_lambda_k1": da_lambda_k1,
            "da_lambda_q2": da_lambda_q2, "da_lambda_k2": da_lambda_k2, "da_subln_g": da_subln_g,
            "lru_conv_w": lru_conv_w, "lru_conv_b": lru_conv_b, "lru_w_a": lru_w_a,
            "lru_b_a": lru_b_a, "lru_w_x": lru_w_x, "lru_b_x": lru_b_x, "lru_lambda": lru_lambda,
            "mem_norm_g": mem_norm_g, "w_mem_kv": w_mem_kv, "final_norm_g": final_norm_g}


def reference(x, mem, positions, norm_g, w_in, w_out,
              s5_lambda_re, s5_lambda_im, s5_log_dt, s5_b_re, s5_b_im, s5_c_re, s5_c_im,
              s5_d, s5_w_glu,
              da_lambda_q1, da_lambda_k1, da_lambda_q2, da_lambda_k2, da_subln_g,
              lru_conv_w, lru_conv_b, lru_w_a, lru_b_a, lru_w_x, lru_b_x, lru_lambda,
              mem_norm_g, w_mem_kv, final_norm_g):
    B, L, _ = x.shape
    inv_freq = ROPE_THETA ** (-jnp.arange(0, ROPE_DIMS, 2, dtype=F32) / ROPE_DIMS)
    ang = positions.astype(F32)[..., None] * inv_freq
    cos = jnp.cos(ang)[:, :, None, None, :]
    sin = jnp.sin(ang)[:, :, None, None, :]

    for layer in range(DEPTH):
        h = rms_norm(x, norm_g[layer])
        proj = h @ w_in[layer]
        a_u, a_g, qd, kd, vd, b_g, c_x, c_g, m_q, m_g = jnp.split(proj, N_IN_SPLITS, axis=-1)

        y_a = s5_mixer(a_u, s5_lambda_re[layer], s5_lambda_im[layer], s5_log_dt[layer],
                       s5_b_re[layer], s5_b_im[layer], s5_c_re[layer], s5_c_im[layer],
                       s5_d[layer], s5_w_glu[layer])

        lam_init = 0.8 - 0.6 * math.exp(-0.3 * layer)
        lam = (jnp.exp(jnp.sum(da_lambda_q1[layer].astype(F32) * da_lambda_k1[layer].astype(F32)))
               - jnp.exp(jnp.sum(da_lambda_q2[layer].astype(F32) * da_lambda_k2[layer].astype(F32)))
               + lam_init)
        q = rope_partial(qd.reshape(B, L, DA_HEADS, 2, DA_HEAD_DIM), cos, sin)
        k = rope_partial(kd.reshape(B, L, DA_HEADS, 2, DA_HEAD_DIM), cos, sin)
        v = vd.reshape(B, L, DA_HEADS, DA_V_DIM)
        o_b = diff_attention(q, k, v, lam)
        y_b = (rms_norm(o_b, da_subln_g[layer]) * (1.0 - lam_init)).reshape(B, L, GROUP_WIDTH)

        y_c = rglru_mixer(c_x, lru_conv_w[layer], lru_conv_b[layer], lru_w_a[layer],
                          lru_b_a[layer], lru_w_x[layer], lru_b_x[layer], lru_lambda[layer])

        mem_n = rms_norm(mem, mem_norm_g[layer])
        y_m = memory_attention(m_q, mem_n, w_mem_kv[layer])

        mixed = jnp.concatenate([y_a * jax.nn.silu(a_g), y_b * jax.nn.silu(b_g),
                                 y_c * jax.nn.silu(c_g), y_m * jax.nn.silu(m_g)], axis=-1)
        x = x + mixed @ w_out[layer]

    return rms_norm(x, final_norm_g)
```

```cpp
#include <hip/hip_runtime.h>
#include <hip/hip_cooperative_groups.h>
#include <cstdio>
namespace cg = cooperative_groups;

typedef unsigned short bf16_t;
typedef __attribute__((ext_vector_type(8))) short bf16x8;
typedef __attribute__((ext_vector_type(4))) short s16x4;
typedef __attribute__((ext_vector_type(4))) float f32x4;

#define DI __device__ __forceinline__
#define MFMA16(a, b, c) __builtin_amdgcn_mfma_f32_16x16x32_bf16((a), (b), (c), 0, 0, 0)

constexpr int NT = 32768;
constexpr int SEQ = 8192;
constexpr int PW = 4608;
constexpr int C_AU = 0, C_AG = 512, C_Q = 1024, C_K = 1536, C_BG = 2048, C_CX = 2560, C_CG = 3072, C_MQ = 3584, C_MG = 4096;
constexpr int LDS_BYTES = 73728 + 64;

struct Params {
  const float *x, *mem; const int* pos;
  const float *norm_g, *w_in, *w_out, *s5_lre, *s5_lim, *s5_logdt, *s5_bre, *s5_bim, *s5_cre, *s5_cim, *s5_d, *s5_wglu;
  const float *da_q1, *da_k1, *da_q2, *da_k2, *da_g;
  const float *conv_w, *conv_b, *lru_wa, *lru_ba, *lru_wx, *lru_bx, *lru_lam, *memng, *w_memkv, *fng;
  float* out;
  bf16_t *proj, *vt, *xb, *wt_in, *wt_out, *wt_glu, *wt_mem, *memn, *memk, *memvt;
  float *rowss, *ropetab, *s5par, *s5st, *lrust, *lamv;
  bf16_t* s5bt;
  unsigned* ctr;
  unsigned* bar;
};

typedef __bf16 bf2_t __attribute__((ext_vector_type(2)));
typedef float f2_t __attribute__((ext_vector_type(2)));
DI unsigned pack2(float a, float b) { f2_t v = {a, b}; return __builtin_bit_cast(unsigned, __builtin_convertvector(v, bf2_t)); }
DI bf16_t f2bf(float x) { return (bf16_t)(pack2(x, 0.f) & 0xffffu); }
DI float bf2f(bf16_t h) { return __uint_as_float(((unsigned)h) << 16); }
DI float sigmoidf_(float x) { return 1.f / (1.f + __expf(-x)); }
DI float siluf_(float x) { return x / (1.f + __expf(-x)); }
DI int opaque_tid() { int t = threadIdx.x; asm volatile("" : "+v"(t)); return t; }
DI float quadmax(float x) {
  auto r = __builtin_amdgcn_permlane16_swap(__float_as_uint(x), __float_as_uint(x), false, false);
  const float m = fmaxf(__uint_as_float(r[0]), __uint_as_float(r[1]));
  auto q = __builtin_amdgcn_permlane32_swap(__float_as_uint(m), __float_as_uint(m), false, false);
  return fmaxf(__uint_as_float(q[0]), __uint_as_float(q[1]));
}
DI float quadsum(float x) {
  auto r = __builtin_amdgcn_permlane16_swap(__float_as_uint(x), __float_as_uint(x), false, false);
  const float m = __uint_as_float(r[0]) + __uint_as_float(r[1]);
  auto q = __builtin_amdgcn_permlane32_swap(__float_as_uint(m), __float_as_uint(m), false, false);
  return __uint_as_float(q[0]) + __uint_as_float(q[1]);
}
DI void wave_lds_sync() { asm volatile("s_waitcnt lgkmcnt(0)" ::: "memory"); __builtin_amdgcn_wave_barrier(); }
DI int swz(int row, int c) { return c ^ ((row >> 1) & 7); }

#define XB_TMO      128
#define XB_XCNT(j)  (256  + 64 * (j))
#define XB_XSUB(j)  (1280 + 64 * (j))
#define XB_XGEN(j)  (2304 + 64 * (j))
#define XB_TOP      3328
#define XB_TOPGEN   3392
#define XCD_BAR_WORDS 3456
#define XB_SPIN_CAP (1u << 18)
#define LAS __attribute__((address_space(3)))

__device__ __forceinline__ unsigned xb_ld(unsigned* p)              { return __hip_atomic_load(p, __ATOMIC_RELAXED, __HIP_MEMORY_SCOPE_AGENT); }
__device__ __forceinline__ unsigned xb_add(unsigned* p, unsigned v) { return __hip_atomic_fetch_add(p, v, __ATOMIC_RELAXED, __HIP_MEMORY_SCOPE_AGENT); }
__device__ __forceinline__ unsigned xb_xcc_id() { return (unsigned)__builtin_amdgcn_s_getreg((3 << 11) | 20) & 0xFu; }
#define XB_SPIN(cond, bar) do { unsigned _sp = 0; while (cond) { __builtin_amdgcn_s_sleep(1); \
    if ((++_sp & 255u) == 0u) { if (xb_ld(&(bar)[XB_TMO])) break; if (_sp > XB_SPIN_CAP) { atomicAdd(&(bar)[XB_TMO], 1u); break; } } } } while (0)

struct XcdBarrier {
    unsigned* bar; unsigned x;
    volatile LAS unsigned* st;
};

__device__ __forceinline__ XcdBarrier xcd_barrier_post(unsigned* bar, volatile LAS unsigned* st) {
    XcdBarrier b; b.bar = bar; b.x = xb_xcc_id(); b.st = st;
    if (threadIdx.x == 0) (void)xb_add(&bar[XB_XCNT(b.x)], 1u);
    return b;
}
__device__ __forceinline__ void xcd_barrier_complete(unsigned* bar, unsigned x, unsigned& nloc, unsigned& nx) {
    const unsigned G = gridDim.x * gridDim.y * gridDim.z;
    unsigned sum, cnt, mine, sp = 0u;
    for (;;) {
        sum = 0u; cnt = 0u; mine = 0u;
#pragma unroll
        for (unsigned j = 0; j < 16; ++j) { const unsigned c = xb_ld(&bar[XB_XCNT(j)]); sum += c; cnt += (c > 0u) ? 1u : 0u; mine = (j == x) ? c : mine; }
        if (sum == G) break;
        __builtin_amdgcn_s_sleep(1);
        if ((++sp & 255u) == 0u) { if (xb_ld(&bar[XB_TMO])) break; if (sp > XB_SPIN_CAP) { atomicAdd(&bar[XB_TMO], 1u); break; } }
    }
    nloc = mine > 0u ? mine : 1u; nx = cnt > 0u ? cnt : 1u;
}

__device__ __forceinline__ void xcd_barrier(const XcdBarrier& b) {
    asm volatile("s_waitcnt vmcnt(0)" ::: "memory");
    __syncthreads();
    if (threadIdx.x == 0) {
        unsigned* bar = b.bar;
        __builtin_amdgcn_s_waitcnt(0);
        unsigned nloc = b.st[0], nx = b.st[1];
        if (nloc == 0u) { xcd_barrier_complete(bar, b.x, nloc, nx); b.st[0] = nloc; b.st[1] = nx; }
        const unsigned old = xb_add(&bar[XB_XSUB(b.x)], 1u);
        const unsigned gen = old / nloc;
        if (old + 1u == (gen + 1u) * nloc) {
            __builtin_amdgcn_fence(__ATOMIC_RELEASE, "agent");
            asm volatile("s_waitcnt vmcnt(0)" ::: "memory");
            const unsigned og = xb_add(&bar[XB_TOP], 1u);
            const unsigned tg = og / nx;
            if (og + 1u == (tg + 1u) * nx) xb_add(&bar[XB_TOPGEN], 1u);
            else XB_SPIN(xb_ld(&bar[XB_TOPGEN]) == tg, bar);
            __builtin_amdgcn_fence(__ATOMIC_ACQUIRE, "agent");
            xb_add(&bar[XB_XGEN(b.x)], 1u);
            asm volatile("s_waitcnt vmcnt(0)" ::: "memory");
        } else {
            XB_SPIN(xb_ld(&bar[XB_XGEN(b.x)]) == gen, bar);
            __builtin_amdgcn_fence(__ATOMIC_ACQUIRE, "agent");
            asm volatile("s_waitcnt vmcnt(0)" ::: "memory");
        }
    }
    __syncthreads();
}


struct GemmArgs {
  const bf16_t* A; int lda; int mix;
  const bf16_t* Bt; int K;
};
DI int mixcol(int k0) { int g = k0 >> 9; int s = (g == 0) ? C_AG : (g == 1) ? C_BG : (g == 2) ? C_CG : C_MG; return s + (k0 & 511); }

enum { EPI_INPROJ = 0, EPI_MEMKV = 1, EPI_GLU = 2, EPI_OUT = 3 };

struct EpiArgs {
  const Params* p; int layer;
  const float* rowss;
  const float* xsrc;
  const float* gnext;
  float* rowss_next;
};

DI int swz64(int row, int c) { return c ^ ((0x1320 >> (((row >> 2) & 3) * 4)) & 3); }

template <int EPI>
DI void gemm_tile(const GemmArgs& ga, const EpiArgs& ea, int m0, int n0, char* lds) {
  const int tid = opaque_tid(), lane = tid & 63, w = tid >> 6;
  const int wm = w >> 1, wn = w & 1, c16 = lane & 15, quad = lane >> 4;
  f32x4 acc[8][4];
#pragma unroll
  for (int i = 0; i < 8; ++i)
#pragma unroll
    for (int j = 0; j < 4; ++j) acc[i][j] = f32x4{0.f, 0.f, 0.f, 0.f};
  const int K = ga.K, nk = K >> 5;
  const int prow = lane >> 2, pch = lane & 3;
  const bf16_t* gsrc[6];
  int ldsoff[6];
#pragma unroll
  for (int i = 0; i < 6; ++i) {
    const int pi = w * 6 + i;
    if (pi < 16) {
      const int row = pi * 16 + prow;
      gsrc[i] = ga.A + (size_t)(m0 + row) * ga.lda + swz64(row, pch) * 8;
      ldsoff[i] = pi * 1024 + lane * 16;
    } else {
      const int row = (pi - 16) * 16 + prow;
      gsrc[i] = ga.Bt + (size_t)(n0 + row) * K + swz64(row, pch) * 8;
      ldsoff[i] = pi * 1024 + lane * 16;
    }
  }
  auto dma = [&](int kt, int buf) {
    const int k0 = kt << 5;
    const int ac = ga.mix ? mixcol(k0) : k0;
    char* base = lds + buf * 24576;
#pragma unroll
    for (int i = 0; i < 6; ++i) {
      const int pi = w * 6 + i;
      __builtin_amdgcn_global_load_lds((const unsigned*)(gsrc[i] + ((pi < 16) ? ac : k0)), (unsigned*)(base + ldsoff[i]), 16, 0, 0);
    }
  };
  __syncthreads();
  dma(0, 0);
  if (nk > 1) dma(1, 1);
  for (int kt = 0; kt < nk; ++kt) {
    if (kt + 1 < nk) asm volatile("s_waitcnt vmcnt(6)" ::: "memory");
    else asm volatile("s_waitcnt vmcnt(0)" ::: "memory");
    __builtin_amdgcn_s_barrier();
    const char* Ab = lds + (kt % 3) * 24576 + wm * 128 * 64;
    const char* Bb = lds + (kt % 3) * 24576 + 16384 + wn * 64 * 64;
    bf16x8 af[8], bfr[4];
    const int ch = swz64(c16, quad) << 4;
#pragma unroll
    for (int nt = 0; nt < 4; ++nt) bfr[nt] = *(const bf16x8*)(Bb + (nt * 16 + c16) * 64 + ch);
#pragma unroll
    for (int mt = 0; mt < 2; ++mt) af[mt] = *(const bf16x8*)(Ab + (mt * 16 + c16) * 64 + ch);
    __builtin_amdgcn_sched_barrier(0);
    if (kt + 2 < nk) dma(kt + 2, (kt + 2) % 3);
    __builtin_amdgcn_sched_barrier(0);
#pragma unroll
    for (int g = 0; g < 4; ++g) {
      if (g < 3) {
#pragma unroll
        for (int mt = 2 * g + 2; mt < 2 * g + 4; ++mt) af[mt] = *(const bf16x8*)(Ab + (mt * 16 + c16) * 64 + ch);
      }
#pragma unroll
      for (int mt = 2 * g; mt < 2 * g + 2; ++mt)
#pragma unroll
        for (int nt = 0; nt < 4; ++nt) acc[mt][nt] = MFMA16(bfr[nt], af[mt], acc[mt][nt]);
      __builtin_amdgcn_sched_barrier(0);
    }
  }
  const Params& p = *ea.p;
  if constexpr (EPI == EPI_INPROJ) {
    const int slot = n0 >> 9;
    const int dbase = (slot < 4) ? slot * 512 : (slot - 1) * 512;
#pragma unroll
    for (int mt = 0; mt < 8; ++mt) {
      const int row = m0 + wm * 128 + mt * 16 + c16;
      const float rs = rsqrtf(ea.rowss[row] * (1.f / 1024.f) + 1e-6f);
#pragma unroll
      for (int nt = 0; nt < 4; ++nt) {
        const int cc0 = (n0 & 511) + wn * 64 + nt * 16 + quad * 4;
        float v[4];
#pragma unroll
        for (int r = 0; r < 4; ++r) v[r] = acc[mt][nt][r] * rs;
        if (slot == 4) {
          const int b = row >> 13, l = row & 8191, h = cc0 >> 7, dv0 = cc0 & 127;
          const int lp = (l & ~31) | (((l >> 2) & 3) << 3) | (((l >> 4) & 1) << 2) | (l & 3);
#pragma unroll
          for (int r = 0; r < 4; ++r) p.vt[((size_t)((b * 4 + h) * 128 + dv0 + r)) * SEQ + lp] = f2bf(v[r]);
        } else {
          if (slot == 2 || slot == 3) {
            if (nt == 0) {
              const float* cs = p.ropetab + (size_t)row * 16 + (quad & 1) * 4;
              const float4 co = *(const float4*)cs, si = *(const float4*)(cs + 8);
              const float cov[4] = {co.x, co.y, co.z, co.w}, siv[4] = {si.x, si.y, si.z, si.w};
#pragma unroll
              for (int r = 0; r < 4; ++r) {
                const float pr = __shfl_xor(v[r], 32);
                v[r] = (quad < 2) ? (v[r] * cov[r] - pr * siv[r]) : (v[r] * cov[r] + pr * siv[r]);
              }
            }
            if (slot == 2) {
#pragma unroll
              for (int r = 0; r < 4; ++r) v[r] *= 0.18033688011112042f;
            }
          } else if (slot == 1 || slot == 5 || slot == 7 || slot == 9) {
#pragma unroll
            for (int r = 0; r < 4; ++r) v[r] = siluf_(v[r]);
          } else if (slot == 8) {
#pragma unroll
            for (int r = 0; r < 4; ++r) v[r] *= 0.12751743082459868f;
          }
          uint2 pk; pk.x = pack2(v[0], v[1]); pk.y = pack2(v[2], v[3]);
          *(uint2*)(p.proj + (size_t)row * PW + dbase + cc0) = pk;
        }
      }
    }
  } else if constexpr (EPI == EPI_MEMKV) {
    const int lm = ea.layer;
#pragma unroll
    for (int mt = 0; mt < 8; ++mt) {
      const int row = m0 + wm * 128 + mt * 16 + c16;
#pragma unroll
      for (int nt = 0; nt < 4; ++nt) {
        const int col0 = n0 + wn * 64 + nt * 16 + quad * 4;
        if (col0 < 512) {
          uint2 pk; pk.x = pack2(acc[mt][nt][0], acc[mt][nt][1]); pk.y = pack2(acc[mt][nt][2], acc[mt][nt][3]);
          *(uint2*)(p.memk + ((size_t)lm * 1024 + row) * 512 + col0) = pk;
        } else {
          const int cc0 = col0 - 512, h = cc0 >> 7, dv0 = cc0 & 127, b = row >> 8, m = row & 255;
          const int mp = (m & ~31) | (((m >> 2) & 3) << 3) | (((m >> 4) & 1) << 2) | (m & 3);
#pragma unroll
          for (int r = 0; r < 4; ++r) p.memvt[((size_t)((lm * 4 + b) * 4 + h) * 128 + dv0 + r) * 256 + mp] = f2bf(acc[mt][nt][r]);
        }
      }
    }
  } else if constexpr (EPI == EPI_GLU) {
    const int blk = (n0 + wn * 64) >> 6;
#pragma unroll
    for (int mt = 0; mt < 8; ++mt) {
      const int row = m0 + wm * 128 + mt * 16 + c16;
#pragma unroll
      for (int nt = 0; nt < 2; ++nt) {
        const int j0 = blk * 32 + nt * 16 + quad * 4;
        uint2* q = (uint2*)(p.proj + (size_t)row * PW + C_AG + j0);
        const uint2 gv = *q;
        const float g0 = __uint_as_float(gv.x << 16), g1 = __uint_as_float(gv.x & 0xffff0000u);
        const float g2 = __uint_as_float(gv.y << 16), g3 = __uint_as_float(gv.y & 0xffff0000u);
        uint2 o;
        o.x = pack2(acc[mt][nt][0] * sigmoidf_(acc[mt][nt + 2][0]) * g0, acc[mt][nt][1] * sigmoidf_(acc[mt][nt + 2][1]) * g1);
        o.y = pack2(acc[mt][nt][2] * sigmoidf_(acc[mt][nt + 2][2]) * g2, acc[mt][nt][3] * sigmoidf_(acc[mt][nt + 2][3]) * g3);
        *q = o;
      }
    }
  } else {
#pragma unroll
    for (int mt = 0; mt < 8; ++mt) {
      const int row = m0 + wm * 128 + mt * 16 + c16;
      float ss = 0.f;
#pragma unroll
      for (int nt = 0; nt < 4; ++nt) {
        const int col0 = n0 + wn * 64 + nt * 16 + quad * 4;
        const size_t idx = (size_t)row * 1024 + col0;
        const float4 xo = *(const float4*)(ea.xsrc + idx);
        float4 xn;
        xn.x = xo.x + acc[mt][nt][0]; xn.y = xo.y + acc[mt][nt][1]; xn.z = xo.z + acc[mt][nt][2]; xn.w = xo.w + acc[mt][nt][3];
        *(float4*)(p.out + idx) = xn;
        ss += xn.x * xn.x + xn.y * xn.y + xn.z * xn.z + xn.w * xn.w;
        if (ea.gnext) {
          const float4 g = *(const float4*)(ea.gnext + col0);
          uint2 o; o.x = pack2(xn.x * g.x, xn.y * g.y); o.y = pack2(xn.z * g.z, xn.w * g.w);
          *(uint2*)(p.xb + idx) = o;
        }
      }
      ss = quadsum(ss);
      if (quad == 0) atomicAdd(ea.rowss_next + row, ss);
    }
  }
}

template <int NS, int QT>
struct AttnState {
  f32x4 O[NS][8][QT];
  float l[NS][QT];
};

template <int NS, int QT>
DI void attn_core(AttnState<NS, QT>& st, const bf16_t* qp, int qstride, const bf16_t* kp, int kstride,
                          const bf16_t* vtp, int vtstride, int nkt, int qpos0, bool causal, char* lds) {
  const int tid = opaque_tid(), lane = tid & 63, w = tid >> 6, c16 = lane & 15, quad = lane >> 4;
  bf16x8 qf[QT][4];
#pragma unroll
  for (int qt = 0; qt < QT; ++qt)
#pragma unroll
    for (int f = 0; f < 4; ++f)
      qf[qt][f] = *(const bf16x8*)(qp + (size_t)(w * 16 * QT + qt * 16 + c16) * qstride + f * 32 + quad * 8);
  float m[NS][QT];
#pragma unroll
  for (int s = 0; s < NS; ++s)
#pragma unroll
    for (int qt = 0; qt < QT; ++qt) {
      m[s][qt] = 0.f; st.l[s][qt] = 0.f;
#pragma unroll
      for (int d = 0; d < 8; ++d) st.O[s][d][qt] = f32x4{0.f, 0.f, 0.f, 0.f};
    }
  const int prow = lane >> 3, pch = lane & 7;
  unsigned koff[4], voff[4];
#pragma unroll
  for (int i = 0; i < 4; ++i) {
    const int pi = w * 4 + i;
    { const int row = (pi & 7) * 8 + prow, sub = pi >> 3, c = pch ^ ((row >> 1) & 7);
      koff[i] = (unsigned)((row * kstride + sub * 64 + c * 8) * 2); }
    { const int row = pi * 8 + prow, c = pch ^ ((row >> 1) & 7);
      voff[i] = (unsigned)((row * vtstride + c * 8) * 2); }
  }
  auto gload = [&](int kt, int buf) {
    char* base = lds + buf * 32768;
    const char* kt_base = (const char*)(kp + (size_t)kt * 64 * kstride);
    const char* vt_base = (const char*)(vtp + (size_t)kt * 64);
#pragma unroll
    for (int i = 0; i < 4; ++i)
      __builtin_amdgcn_global_load_lds((const unsigned*)(kt_base + koff[i]), (unsigned*)(base + (w * 4 + i) * 1024 + lane * 16), 16, 0, 0);
#pragma unroll
    for (int i = 0; i < 4; ++i)
      __builtin_amdgcn_global_load_lds((const unsigned*)(vt_base + voff[i]), (unsigned*)(base + 16384 + (w * 4 + i) * 1024 + lane * 16), 16, 0, 0);
  };
  const int qw0 = qpos0 + w * 16 * QT;
  gload(0, 0); __syncthreads();
  for (int kt = 0; kt < nkt; ++kt) {
    if (kt + 1 < nkt) gload(kt + 1, (kt + 1) & 1);
    const char* Kb = lds + (kt & 1) * 32768;
    const char* Vb = Kb + 16384;
    const bool active = !causal || (kt * 64 <= qw0 + 16 * QT - 1);
    if (active) {
      const bool need_mask = causal && (kt * 64 + 63 > qw0);
      bf16x8 pf[NS][2][QT];
      f32x4 S[NS][4][QT];
#pragma unroll
      for (int s = 0; s < NS; ++s)
#pragma unroll
        for (int a = 0; a < 4; ++a)
#pragma unroll
          for (int qt = 0; qt < QT; ++qt) { const float nm = -m[s][qt]; S[s][a][qt] = f32x4{nm, nm, nm, nm}; }
      bf16x8 kfa[8], kfb[8], vfa[8], vfb[8];
#pragma unroll
      for (int i = 0; i < 8; ++i) {
        const int ksub = i & 3, row = ksub * 16 + c16, chunk = (i >> 2) * 4 + quad;
        kfa[i] = *(const bf16x8*)(Kb + row * 128 + (swz(row, chunk) << 4));
      }
      __builtin_amdgcn_sched_barrier(0);
#pragma unroll
      for (int i = 0; i < 8; ++i) {
        const int ksub = i & 3, row = ksub * 16 + c16, chunk = (i >> 2) * 4 + quad;
        kfb[i] = *(const bf16x8*)(Kb + 8192 + row * 128 + (swz(row, chunk) << 4));
      }
#pragma unroll
      for (int i = 0; i < 8; ++i)
#pragma unroll
        for (int qt = 0; qt < QT; ++qt) S[0][i & 3][qt] = MFMA16(kfa[i], qf[qt][i >> 2], S[0][i & 3][qt]);
      __builtin_amdgcn_sched_barrier(0);
#pragma unroll
      for (int d = 0; d < 8; ++d) {
        const int row = d * 16 + c16;
        vfa[d] = *(const bf16x8*)(Vb + row * 128 + (swz(row, quad) << 4));
      }
#pragma unroll
      for (int i = 0; i < 8; ++i)
#pragma unroll
        for (int qt = 0; qt < QT; ++qt) S[NS - 1][i & 3][qt] = MFMA16(kfb[i], qf[qt][2 + (i >> 2)], S[NS - 1][i & 3][qt]);
      if (need_mask) {
#pragma unroll
        for (int s = 0; s < NS; ++s)
#pragma unroll
          for (int ksub = 0; ksub < 4; ++ksub)
#pragma unroll
            for (int qt = 0; qt < QT; ++qt)
#pragma unroll
              for (int r = 0; r < 4; ++r) {
                const int key = kt * 64 + ksub * 16 + quad * 4 + r;
                const int qpos = qw0 + qt * 16 + c16;
                if (key > qpos) S[s][ksub][qt][r] = -1e30f;
              }
      }
      float mx[NS][QT];
      bool need = false;
#pragma unroll
      for (int s = 0; s < NS; ++s)
#pragma unroll
        for (int qt = 0; qt < QT; ++qt) {
          float v = -1e30f;
#pragma unroll
          for (int ksub = 0; ksub < 4; ++ksub)
#pragma unroll
            for (int r = 0; r < 4; ++r) v = fmaxf(v, S[s][ksub][qt][r]);
          v = quadmax(v);
          mx[s][qt] = v;
          need = need || (v > 8.f);
        }
      if (__any(need) || kt == 0) {
#pragma unroll
        for (int s = 0; s < NS; ++s)
#pragma unroll
          for (int qt = 0; qt < QT; ++qt) {
            const float delta = (kt == 0) ? mx[s][qt] : fmaxf(mx[s][qt], 0.f);
            const float alpha = (kt == 0) ? 1.f : __builtin_amdgcn_exp2f(-delta);
            m[s][qt] += delta;
            st.l[s][qt] *= alpha;
#pragma unroll
            for (int d = 0; d < 8; ++d) st.O[s][d][qt] *= alpha;
#pragma unroll
            for (int ksub = 0; ksub < 4; ++ksub)
#pragma unroll
              for (int r = 0; r < 4; ++r) S[s][ksub][qt][r] -= delta;
          }
      }
#pragma unroll
      for (int s = 0; s < NS; ++s)
#pragma unroll
        for (int qt = 0; qt < QT; ++qt) {
          float psum = 0.f;
#pragma unroll
          for (int ksub = 0; ksub < 4; ++ksub)
#pragma unroll
            for (int r = 0; r < 4; ++r) { const float e = __builtin_amdgcn_exp2f(S[s][ksub][qt][r]); S[s][ksub][qt][r] = e; psum += e; }
          st.l[s][qt] += psum;
#pragma unroll
          for (int kk = 0; kk < 2; ++kk) {
            union { unsigned u[4]; bf16x8 v; } pk;
            pk.u[0] = pack2(S[s][2 * kk][qt][0], S[s][2 * kk][qt][1]);
            pk.u[1] = pack2(S[s][2 * kk][qt][2], S[s][2 * kk][qt][3]);
            pk.u[2] = pack2(S[s][2 * kk + 1][qt][0], S[s][2 * kk + 1][qt][1]);
            pk.u[3] = pack2(S[s][2 * kk + 1][qt][2], S[s][2 * kk + 1][qt][3]);
            pf[s][kk][qt] = pk.v;
          }
        }
      __builtin_amdgcn_sched_barrier(0);
#pragma unroll
      for (int d = 0; d < 8; ++d) {
        const int row = d * 16 + c16;
        vfb[d] = *(const bf16x8*)(Vb + row * 128 + (swz(row, 4 + quad) << 4));
      }
#pragma unroll
      for (int d = 0; d < 8; ++d)
#pragma unroll
        for (int s = 0; s < NS; ++s)
#pragma unroll
          for (int qt = 0; qt < QT; ++qt) st.O[s][d][qt] = MFMA16(vfa[d], pf[s][0][qt], st.O[s][d][qt]);
      __builtin_amdgcn_sched_barrier(0);
#pragma unroll
      for (int d = 0; d < 8; ++d)
#pragma unroll
        for (int s = 0; s < NS; ++s)
#pragma unroll
          for (int qt = 0; qt < QT; ++qt) st.O[s][d][qt] = MFMA16(vfb[d], pf[s][1][qt], st.O[s][d][qt]);
    }
    __syncthreads();
  }
#pragma unroll
  for (int s = 0; s < NS; ++s)
#pragma unroll
    for (int qt = 0; qt < QT; ++qt) {
      st.l[s][qt] = quadsum(st.l[s][qt]);
    }
}

DI void diff_attn_item(const Params& p, int layer, int qb, int bh, char* lds) {
  const int b = bh >> 2, h = bh & 3;
  const int tok0 = b * SEQ + qb * 64;
  const int tid_ = opaque_tid(), lane = tid_ & 63, w = tid_ >> 6, c16 = lane & 15, quad = lane >> 4;
  const int sidx = w & 1, g = w >> 1;
  const bf16_t* qp = p.proj + (size_t)tok0 * PW + C_Q + h * 128;
  const bf16_t* kp = p.proj + (size_t)b * SEQ * PW + C_K + h * 128;
  const bf16_t* vtp = p.vt + (size_t)((b * 4 + h) * 128) * SEQ;
  const int nkt = qb + 1;
  bf16x8 qf[2][2];
#pragma unroll
  for (int qt = 0; qt < 2; ++qt)
#pragma unroll
    for (int ff = 0; ff < 2; ++ff)
      qf[qt][ff] = *(const bf16x8*)(qp + (size_t)(g * 32 + qt * 16 + c16) * PW + (sidx * 2 + ff) * 32 + quad * 8);
  float m[2], l[2];
  f32x4 O[8][2];
#pragma unroll
  for (int qt = 0; qt < 2; ++qt) {
    m[qt] = 0.f; l[qt] = 0.f;
#pragma unroll
    for (int d = 0; d < 8; ++d) O[d][qt] = f32x4{0.f, 0.f, 0.f, 0.f};
  }
  const int prow = lane >> 3, pch = lane & 7;
  unsigned koff[4], voff[4];
#pragma unroll
  for (int i = 0; i < 4; ++i) {
    const int pi = w * 4 + i;
    { const int row = (pi & 7) * 8 + prow, sub = pi >> 3, c = pch ^ ((row >> 1) & 7);
      koff[i] = (unsigned)((row * PW + sub * 64 + c * 8) * 2); }
    { const int row = pi * 8 + prow, c = pch ^ ((row >> 1) & 7);
      voff[i] = (unsigned)((row * SEQ + c * 8) * 2); }
  }
  auto gload = [&](int kt, int buf) {
    char* base = lds + buf * 32768;
    const char* kt_base = (const char*)(kp + (size_t)kt * 64 * PW);
    const char* vt_base = (const char*)(vtp + (size_t)kt * 64);
#pragma unroll
    for (int i = 0; i < 4; ++i)
      __builtin_amdgcn_global_load_lds((const unsigned*)(kt_base + koff[i]), (unsigned*)(base + (w * 4 + i) * 1024 + lane * 16), 16, 0, 0);
#pragma unroll
    for (int i = 0; i < 4; ++i)
      __builtin_amdgcn_global_load_lds((const unsigned*)(vt_base + voff[i]), (unsigned*)(base + 16384 + (w * 4 + i) * 1024 + lane * 16), 16, 0, 0);
  };
  const int qw0 = qb * 64 + g * 32;
  gload(0, 0); __syncthreads();
  for (int kt = 0; kt < nkt; ++kt) {
    if (kt + 1 < nkt) gload(kt + 1, (kt + 1) & 1);
    const char* Kb = lds + (kt & 1) * 32768 + sidx * 8192;
    const char* Vb = lds + (kt & 1) * 32768 + 16384;
    if (kt * 64 <= qw0 + 31) {
      f32x4 S[4][2];
#pragma unroll
      for (int a = 0; a < 4; ++a)
#pragma unroll
        for (int qt = 0; qt < 2; ++qt) { const float nm = -m[qt]; S[a][qt] = f32x4{nm, nm, nm, nm}; }
      bf16x8 kf[8], vfa[8], vfb[8];
#pragma unroll
      for (int i = 0; i < 8; ++i) {
        const int row = (i & 3) * 16 + c16, chunk = (i >> 2) * 4 + quad;
        kf[i] = *(const bf16x8*)(Kb + row * 128 + (swz(row, chunk) << 4));
      }
      __builtin_amdgcn_sched_barrier(0);
#pragma unroll
      for (int d = 0; d < 8; ++d) { const int row = d * 16 + c16; vfa[d] = *(const bf16x8*)(Vb + row * 128 + (swz(row, quad) << 4)); }
#pragma unroll
      for (int i = 0; i < 8; ++i)
#pragma unroll
        for (int qt = 0; qt < 2; ++qt) S[i & 3][qt] = MFMA16(kf[i], qf[qt][i >> 2], S[i & 3][qt]);
      __builtin_amdgcn_sched_barrier(0);
      if (kt * 64 + 63 > qw0) {
#pragma unroll
        for (int ksub = 0; ksub < 4; ++ksub)
#pragma unroll
          for (int qt = 0; qt < 2; ++qt)
#pragma unroll
            for (int r = 0; r < 4; ++r) {
              const int key = kt * 64 + ksub * 16 + quad * 4 + r;
              if (key > qw0 + qt * 16 + c16) S[ksub][qt][r] = -1e30f;
            }
      }
      float mx[2];
      bool need = false;
#pragma unroll
      for (int qt = 0; qt < 2; ++qt) {
        float v = -1e30f;
#pragma unroll
        for (int ksub = 0; ksub < 4; ++ksub)
#pragma unroll
          for (int r = 0; r < 4; ++r) v = fmaxf(v, S[ksub][qt][r]);
        v = quadmax(v);
        mx[qt] = v;
        need = need || (v > 8.f);
      }
      if (__any(need) || kt == 0) {
#pragma unroll
        for (int qt = 0; qt < 2; ++qt) {
          const float delta = (kt == 0) ? mx[qt] : fmaxf(mx[qt], 0.f);
          const float alpha = (kt == 0) ? 1.f : __builtin_amdgcn_exp2f(-delta);
          m[qt] += delta;
          l[qt] *= alpha;
#pragma unroll
          for (int d = 0; d < 8; ++d) O[d][qt] *= alpha;
#pragma unroll
          for (int ksub = 0; ksub < 4; ++ksub)
#pragma unroll
            for (int r = 0; r < 4; ++r) S[ksub][qt][r] -= delta;
        }
      }
      bf16x8 pf[2][2];
#pragma unroll
      for (int qt = 0; qt < 2; ++qt) {
        float psum = 0.f;
#pragma unroll
        for (int ksub = 0; ksub < 4; ++ksub)
#pragma unroll
          for (int r = 0; r < 4; ++r) { const float e = __builtin_amdgcn_exp2f(S[ksub][qt][r]); S[ksub][qt][r] = e; psum += e; }
        l[qt] += psum;
#pragma unroll
        for (int kk = 0; kk < 2; ++kk) {
          union { unsigned u[4]; bf16x8 v; } pk;
          pk.u[0] = pack2(S[2 * kk][qt][0], S[2 * kk][qt][1]);
          pk.u[1] = pack2(S[2 * kk][qt][2], S[2 * kk][qt][3]);
          pk.u[2] = pack2(S[2 * kk + 1][qt][0], S[2 * kk + 1][qt][1]);
          pk.u[3] = pack2(S[2 * kk + 1][qt][2], S[2 * kk + 1][qt][3]);
          pf[kk][qt] = pk.v;
        }
      }
      __builtin_amdgcn_sched_barrier(0);
#pragma unroll
      for (int d = 0; d < 8; ++d) { const int row = d * 16 + c16; vfb[d] = *(const bf16x8*)(Vb + row * 128 + (swz(row, 4 + quad) << 4)); }
#pragma unroll
      for (int d = 0; d < 8; ++d)
#pragma unroll
        for (int qt = 0; qt < 2; ++qt) O[d][qt] = MFMA16(vfa[d], pf[0][qt], O[d][qt]);
      __builtin_amdgcn_sched_barrier(0);
#pragma unroll
      for (int d = 0; d < 8; ++d)
#pragma unroll
        for (int qt = 0; qt < 2; ++qt) O[d][qt] = MFMA16(vfb[d], pf[1][qt], O[d][qt]);
    }
    __syncthreads();
  }
  const float lam = p.lamv[layer];
  const float lam_init = 0.8f - 0.6f * expf(-0.3f * (float)layer);
  float* xch = (float*)(lds + g * 16384);
  float cf[2];
#pragma unroll
  for (int qt = 0; qt < 2; ++qt) cf[qt] = ((sidx == 0) ? 1.f : lam) / quadsum(l[qt]);
  if (sidx == 1) {
#pragma unroll
    for (int d = 0; d < 8; ++d)
#pragma unroll
      for (int qt = 0; qt < 2; ++qt)
#pragma unroll
        for (int r = 0; r < 4; ++r) xch[((d * 2 + qt) * 4 + r) * 64 + lane] = O[d][qt][r] * cf[qt];
  }
  __syncthreads();
  if (sidx == 0) {
    const float* sg = p.da_g + layer * 128;
#pragma unroll
    for (int qt = 0; qt < 2; ++qt) {
      float ss = 0.f;
#pragma unroll
      for (int d = 0; d < 8; ++d)
#pragma unroll
        for (int r = 0; r < 4; ++r) {
          const float o = O[d][qt][r] * cf[qt] - xch[((d * 2 + qt) * 4 + r) * 64 + lane];
          O[d][qt][r] = o; ss += o * o;
        }
      ss = quadsum(ss);
      const float rn = rsqrtf(ss * (1.f / 128.f) + 1e-6f) * (1.f - lam_init);
      const int tok = tok0 + g * 32 + qt * 16 + c16;
#pragma unroll
      for (int d = 0; d < 8; ++d) {
        const int dv0 = d * 16 + quad * 4;
        bf16_t* gp = p.proj + (size_t)tok * PW + C_BG + h * 128 + dv0;
        const uint2 gv = *(const uint2*)gp;
        const float g0 = __uint_as_float(gv.x << 16), g1 = __uint_as_float(gv.x & 0xffff0000u);
        const float g2 = __uint_as_float(gv.y << 16), g3 = __uint_as_float(gv.y & 0xffff0000u);
        uint2 o;
        o.x = pack2(O[d][qt][0] * rn * sg[dv0] * g0, O[d][qt][1] * rn * sg[dv0 + 1] * g1);
        o.y = pack2(O[d][qt][2] * rn * sg[dv0 + 2] * g2, O[d][qt][3] * rn * sg[dv0 + 3] * g3);
        *(uint2*)gp = o;
      }
    }
  }
}

DI void mem_attn_item(const Params& p, int layer, int item, char* lds) {
  const int qb = item >> 4, bh = item & 15, b = bh >> 2, h = bh & 3;
  const int tok0 = b * SEQ + qb * 64;
  const int tid_ = opaque_tid(), lane = tid_ & 63, w = tid_ >> 6, c16 = lane & 15, quad = lane >> 4;
  AttnState<1, 1> st;
  attn_core<1, 1>(st, p.proj + (size_t)tok0 * PW + C_MQ + h * 128, PW,
               p.memk + ((size_t)layer * 1024 + b * 256) * 512 + h * 128, 512,
               p.memvt + ((size_t)((layer * 4 + b) * 4 + h) * 128) * 256, 256, 4, 0, false, lds);
#pragma unroll
  for (int qt = 0; qt < 1; ++qt) {
    const float i1 = 1.f / st.l[0][qt];
    const int tok = tok0 + w * 16 + qt * 16 + c16;
#pragma unroll
    for (int d = 0; d < 8; ++d) {
      const int dv0 = d * 16 + quad * 4;
      bf16_t* g = p.proj + (size_t)tok * PW + C_MG + h * 128 + dv0;
      const uint2 gv = *(const uint2*)g;
      const float g0 = __uint_as_float(gv.x << 16), g1 = __uint_as_float(gv.x & 0xffff0000u);
      const float g2 = __uint_as_float(gv.y << 16), g3 = __uint_as_float(gv.y & 0xffff0000u);
      uint2 o;
      o.x = pack2(st.O[0][d][qt][0] * i1 * g0, st.O[0][d][qt][1] * i1 * g1);
      o.y = pack2(st.O[0][d][qt][2] * i1 * g2, st.O[0][d][qt][3] * i1 * g3);
      *(uint2*)g = o;
    }
  }
}

DI float gelu_tanh(float x) {
  const float u = 0.7978845608028654f * (x + 0.044715f * x * x * x);
  const float t = 1.f - 2.f / (1.f + __expf(2.f * u));
  return 0.5f * x * (1.f + t);
}

template <bool FINAL>
DI void s5_item(const Params& p, int layer, int item, char* lds) {
  const int gq = item & 7, c = (item >> 3) & 127, b = item >> 10;
  const int tid_ = opaque_tid(), lane = tid_ & 63, w = tid_ >> 6, c16 = lane & 15, quad = lane >> 4;
  const int g = gq * 4 + w;
  const int tok0 = b * SEQ + c * 64;
  float* bu = (float*)(lds + w * 16384);
  char* xsb = lds + w * 16384 + 8192;
  bf16x8 bbf[8];
  {
    const bf16_t* bt = p.s5bt + (size_t)(layer * 32 + g) * 128 * 32;
#pragma unroll
    for (int nt = 0; nt < 8; ++nt) bbf[nt] = *(const bf16x8*)(bt + (nt * 16 + c16) * 32 + quad * 8);
  }
  const float* par = p.s5par + (size_t)((layer * 32 + g) * 36) * 64 + lane;
  const float are = par[0], aim = par[64];
  float xr = 0.f, xi = 0.f;
  float* stp = p.s5st + ((size_t)((b * 32 + g) * 128)) * 128 + lane;
  bf16x8 cf[FINAL ? 4 : 1];
  float dsk = 0.f;
  if constexpr (FINAL) {
    xr = stp[c * 128]; xi = stp[c * 128 + 64];
    const float* cr = p.s5_cre + (size_t)((layer * 32 + g) * 16 + c16) * 64;
    const float* ci = p.s5_cim + (size_t)((layer * 32 + g) * 16 + c16) * 64;
#pragma unroll
    for (int ks = 0; ks < 4; ++ks) {
      const float* src = ((ks < 2) ? cr : ci) + (ks & 1) * 32 + quad * 8;
      const float sg = (ks < 2) ? 1.f : -1.f;
      const float4 v0 = *(const float4*)src, v1 = *(const float4*)(src + 4);
      union { unsigned u[4]; bf16x8 v; } pk;
      pk.u[0] = pack2(sg * v0.x, sg * v0.y); pk.u[1] = pack2(sg * v0.z, sg * v0.w);
      pk.u[2] = pack2(sg * v1.x, sg * v1.y); pk.u[3] = pack2(sg * v1.z, sg * v1.w);
      cf[ks] = pk.v;
    }
    dsk = p.s5_d[(layer * 32 + g) * 16 + c16];
  }
  for (int sc = 0; sc < 4; ++sc) {
    const int tb = tok0 + sc * 16;
    bf16x8 uf = bf16x8{0, 0, 0, 0, 0, 0, 0, 0};
    if (quad < 2) uf = *(const bf16x8*)(p.proj + (size_t)(tb + c16) * PW + C_AU + g * 16 + quad * 8);
    float uo[FINAL ? 4 : 1];
    if constexpr (FINAL) {
#pragma unroll
      for (int r = 0; r < 4; ++r) uo[r] = bf2f(p.proj[(size_t)(tb + quad * 4 + r) * PW + C_AU + g * 16 + c16]);
    }
#pragma unroll
    for (int nt = 0; nt < 8; ++nt) {
      f32x4 acc = MFMA16(uf, bbf[nt], (f32x4{0.f, 0.f, 0.f, 0.f}));
#pragma unroll
      for (int r = 0; r < 4; ++r) bu[(quad * 4 + r) * 128 + nt * 16 + c16] = acc[r];
    }
    wave_lds_sync();
#pragma unroll
    for (int tt = 0; tt < 16; ++tt) {
      const float br_ = bu[tt * 128 + lane], bi_ = bu[tt * 128 + 64 + lane];
      const float nr = are * xr - aim * xi + br_;
      const float ni = are * xi + aim * xr + bi_;
      xr = nr; xi = ni;
      if constexpr (FINAL) {
        *(bf16_t*)(xsb + tt * 256 + ((((lane >> 3)) ^ tt) << 4) + (lane & 7) * 2) = f2bf(xr);
        *(bf16_t*)(xsb + tt * 256 + (((8 + (lane >> 3)) ^ tt) << 4) + (lane & 7) * 2) = f2bf(xi);
      }
    }
    if constexpr (FINAL) {
      wave_lds_sync();
      f32x4 y = f32x4{0.f, 0.f, 0.f, 0.f};
#pragma unroll
      for (int ks = 0; ks < 4; ++ks) {
        const bf16x8 xf = *(const bf16x8*)(xsb + c16 * 256 + (((ks * 4 + quad) ^ c16) << 4));
        y = MFMA16(xf, cf[ks], y);
      }
#pragma unroll
      for (int r = 0; r < 4; ++r) {
        const float v = y[r] + dsk * uo[r];
        p.proj[(size_t)(tb + quad * 4 + r) * PW + C_AU + g * 16 + c16] = f2bf(gelu_tanh(v));
      }
    }
    wave_lds_sync();
  }
  if constexpr (!FINAL) { stp[c * 128] = xr; stp[c * 128 + 64] = xi; }
}

template <bool FINAL>
DI void lru_item(const Params& p, int layer, int item, char* lds) {
  const int half = item & 1, c = (item >> 1) & 127, b = item >> 8;
  const int tid_ = opaque_tid(), lane = tid_ & 63, w = tid_ >> 6, c16 = lane & 15, quad = lane >> 4;
  const int n = half * 4 + w, ch = n * 64 + lane;
  const int l0 = c * 64, tok0 = b * SEQ + l0;
  char* xcb = lds + w * 16384;
  float* aba = (float*)(xcb + 8192);
  float* abb = aba + 1024;
  bf16x8 wf[8][2];
  {
    const float* pa = p.lru_wa + (size_t)((layer * 8 + n) * 64) * 64;
    const float* px = p.lru_wx + (size_t)((layer * 8 + n) * 64) * 64;
#pragma unroll
    for (int nt = 0; nt < 8; ++nt) {
      const float* base = ((nt < 4) ? pa : px) + (nt & 3) * 16 + c16;
#pragma unroll
      for (int ks = 0; ks < 2; ++ks) {
        union { unsigned u[4]; bf16x8 v; } pk;
#pragma unroll
        for (int jj = 0; jj < 4; ++jj) {
          const int k = ks * 32 + quad * 8 + jj * 2;
          pk.u[jj] = pack2(base[k * 64], base[(k + 1) * 64]);
        }
        wf[nt][ks] = pk.v;
      }
    }
  }
  float bav[4], bxv[4], spv[4];
#pragma unroll
  for (int nt = 0; nt < 4; ++nt) {
    const int cch = layer * 512 + n * 64 + nt * 16 + c16;
    bav[nt] = p.lru_ba[cch]; bxv[nt] = p.lru_bx[cch];
    spv[nt] = 8.f * log1pf(expf(-p.lru_lam[cch])) * 1.4426950408889634f;
  }
  {
    const float cw0 = p.conv_w[(layer * 4 + 0) * 512 + ch], cw1 = p.conv_w[(layer * 4 + 1) * 512 + ch];
    const float cw2 = p.conv_w[(layer * 4 + 2) * 512 + ch], cw3 = p.conv_w[(layer * 4 + 3) * 512 + ch];
    const float cb = p.conv_b[layer * 512 + ch];
    const bf16_t* xp = p.proj + (size_t)tok0 * PW + C_CX + ch;
    bf16_t xin[67];
#pragma unroll
    for (int t = 0; t < 3; ++t) xin[t] = (l0 + t - 3 >= 0) ? xp[(t - 3) * PW] : (bf16_t)0;
#pragma unroll
    for (int t = 3; t < 67; ++t) xin[t] = xp[(size_t)(t - 3) * PW];
#pragma unroll
    for (int t = 0; t < 64; ++t) {
      const float xc = cw0 * bf2f(xin[t]) + cw1 * bf2f(xin[t + 1]) + cw2 * bf2f(xin[t + 2]) + cw3 * bf2f(xin[t + 3]) + cb;
      *(bf16_t*)(xcb + t * 128 + (swz(t, lane >> 3) << 4) + (lane & 7) * 2) = f2bf(xc);
    }
  }
  float hst = 0.f, pr = 1.f;
  float* stp = p.lrust + ((size_t)(b * 128) * 512 + ch) * 2;
  if constexpr (FINAL) hst = stp[(size_t)c * 1024 + 1];
  wave_lds_sync();
  for (int sc = 0; sc < 4; ++sc) {
    float gv[FINAL ? 16 : 1];
    if constexpr (FINAL) {
      const bf16_t* gp0 = p.proj + (size_t)(tok0 + sc * 16) * PW + C_CG + ch;
#pragma unroll
      for (int t = 0; t < 16; ++t) gv[t] = bf2f(gp0[(size_t)t * PW]);
    }
    f32x4 acc[8];
#pragma unroll
    for (int nt = 0; nt < 8; ++nt) acc[nt] = f32x4{0.f, 0.f, 0.f, 0.f};
    const int arow = sc * 16 + c16;
#pragma unroll
    for (int ks = 0; ks < 2; ++ks) {
      const bf16x8 af = *(const bf16x8*)(xcb + arow * 128 + (swz(arow, ks * 4 + quad) << 4));
#pragma unroll
      for (int nt = 0; nt < 8; ++nt) acc[nt] = MFMA16(af, wf[nt][ks], acc[nt]);
    }
#pragma unroll
    for (int nt = 0; nt < 4; ++nt) {
      const int chl = nt * 16 + c16;
#pragma unroll
      for (int r = 0; r < 4; ++r) {
        const int tl = sc * 16 + quad * 4 + r;
        const float xcv = bf2f(*(const bf16_t*)(xcb + tl * 128 + (swz(tl, chl >> 3) << 4) + (chl & 7) * 2));
        const float ga = acc[nt][r] + bav[nt], gx = acc[nt + 4][r] + bxv[nt];
        const float rr = __builtin_amdgcn_rcpf(1.f + __builtin_amdgcn_exp2f(-1.4426950408889634f * ga));
        const float ig = __builtin_amdgcn_rcpf(1.f + __builtin_amdgcn_exp2f(-1.4426950408889634f * gx));
        const float la2 = -spv[nt] * rr;
        const float a = __builtin_amdgcn_exp2f(la2);
        const float y = la2 * 1.3862943611198906f;
        float q = 1.f + y * (1.f / 6.f);
        q = 1.f + y * 0.2f * q; q = 1.f + y * 0.25f * q; q = 1.f + y * (1.f / 3.f) * q; q = 1.f + y * 0.5f * q;
        const float om = (y < -0.5f) ? (1.f - a * a) : (-y * q);
        const float mult = __builtin_amdgcn_sqrtf(om);
        aba[(quad * 4 + r) * 64 + chl] = a;
        abb[(quad * 4 + r) * 64 + chl] = mult * ig * xcv;
      }
    }
    wave_lds_sync();
#pragma unroll
    for (int tt = 0; tt < 16; ++tt) {
      const float a = aba[tt * 64 + lane], bv = abb[tt * 64 + lane];
      hst = a * hst + bv;
      if constexpr (FINAL) p.proj[(size_t)(tok0 + sc * 16 + tt) * PW + C_CG + ch] = f2bf(hst * gv[tt]);
      else pr *= a;
    }
    wave_lds_sync();
  }
  if constexpr (!FINAL) { *(float2*)(stp + (size_t)c * 1024) = make_float2(pr, hst); }
}

DI void transpose_tile(const Params& p, int t, char* lds) {
  const float* src; bf16_t* dst; int K, N, kt, nt, perm = 0;
  if (t < 5120) { int l = t / 1280, r = t % 1280; kt = r / 80; nt = r % 80; K = 1024; N = 5120; src = p.w_in + (size_t)l * K * N; dst = p.wt_in + (size_t)l * K * N; }
  else if (t < 7168) { t -= 5120; int l = t / 512, r = t % 512; kt = r / 16; nt = r % 16; K = 2048; N = 1024; src = p.w_out + (size_t)l * K * N; dst = p.wt_out + (size_t)l * K * N; }
  else if (t < 7680) { t -= 7168; int l = t / 128, r = t % 128; kt = r / 16; nt = r % 16; K = 512; N = 1024; src = p.s5_wglu + (size_t)l * K * N; dst = p.wt_glu + (size_t)l * K * N; perm = 1; }
  else { t -= 7680; int l = t / 256, r = t % 256; kt = r / 16; nt = r % 16; K = 1024; N = 1024; src = p.w_memkv + (size_t)l * K * N; dst = p.wt_mem + (size_t)l * K * N; }
  float* tile = (float*)lds;
  const int tid = opaque_tid(), ty = tid >> 4, tx = tid & 15;
  const int k0 = kt * 64, n0 = nt * 64;
#pragma unroll
  for (int i = 0; i < 4; ++i) {
    const int k = ty + 16 * i;
    const float4 v = *(const float4*)(src + (size_t)(k0 + k) * N + n0 + tx * 4);
    tile[k * 65 + tx * 4] = v.x; tile[k * 65 + tx * 4 + 1] = v.y; tile[k * 65 + tx * 4 + 2] = v.z; tile[k * 65 + tx * 4 + 3] = v.w;
  }
  __syncthreads();
  const int n = tid >> 2, kq = tid & 3;
  unsigned pk[8];
#pragma unroll
  for (int j = 0; j < 8; ++j) pk[j] = pack2(tile[(kq * 16 + 2 * j) * 65 + n], tile[(kq * 16 + 2 * j + 1) * 65 + n]);
  int row = n0 + n;
  if (perm) { const int j = row & 511; row = (j >> 5) * 64 + ((row >= 512) ? 32 : 0) + (j & 31); }
  uint4* d = (uint4*)(dst + (size_t)row * K + k0 + kq * 16);
  d[0] = make_uint4(pk[0], pk[1], pk[2], pk[3]);
  d[1] = make_uint4(pk[4], pk[5], pk[6], pk[7]);
  __syncthreads();
}

DI void phase0(const Params& p, char* lds) {
  const int tid = opaque_tid(), lane = tid & 63, w = tid >> 6;
  for (int t = blockIdx.x; t < 8704; t += gridDim.x) transpose_tile(p, t, lds);
  for (int it = blockIdx.x; it < 8192 + 1024; it += gridDim.x) {
    if (it < 8192) {
      const int row = it * 4 + w;
      const float* xr = p.x + (size_t)row * 1024;
      float4 v[4]; float ss = 0.f;
#pragma unroll
      for (int i = 0; i < 4; ++i) { v[i] = *(const float4*)(xr + i * 256 + lane * 4); ss += v[i].x * v[i].x + v[i].y * v[i].y + v[i].z * v[i].z + v[i].w * v[i].w; }
#pragma unroll
      for (int o = 32; o >= 1; o >>= 1) ss += __shfl_xor(ss, o);
#pragma unroll
      for (int i = 0; i < 4; ++i) {
        const int col = i * 256 + lane * 4;
        const float4 g = *(const float4*)(p.norm_g + col);
        uint2 o; o.x = pack2(v[i].x * g.x, v[i].y * g.y); o.y = pack2(v[i].z * g.z, v[i].w * g.w);
        *(uint2*)(p.xb + (size_t)row * 1024 + col) = o;
      }
      if (lane == 0) p.rowss[row] = ss;
    } else {
      const int r = (it - 8192) * 4 + w, l = r >> 10, mr = r & 1023;
      const float* xr = p.mem + (size_t)mr * 1024;
      float4 v[4]; float ss = 0.f;
#pragma unroll
      for (int i = 0; i < 4; ++i) { v[i] = *(const float4*)(xr + i * 256 + lane * 4); ss += v[i].x * v[i].x + v[i].y * v[i].y + v[i].z * v[i].z + v[i].w * v[i].w; }
#pragma unroll
      for (int o = 32; o >= 1; o >>= 1) ss += __shfl_xor(ss, o);
      const float rs = rsqrtf(ss * (1.f / 1024.f) + 1e-6f);
#pragma unroll
      for (int i = 0; i < 4; ++i) {
        const int col = i * 256 + lane * 4;
        const float4 g = *(const float4*)(p.memng + l * 1024 + col);
        uint2 o; o.x = pack2(v[i].x * rs * g.x, v[i].y * rs * g.y); o.y = pack2(v[i].z * rs * g.z, v[i].w * rs * g.w);
        *(uint2*)(p.memn + (size_t)r * 1024 + col) = o;
      }
    }
  }
  const int gtid = blockIdx.x * 256 + tid, gstride = gridDim.x * 256;
  for (int i = gtid; i < NT * 8; i += gstride) {
    const int tok = i >> 3, f = i & 7;
    const float inv = powf(500000.f, -(float)(2 * f) / 16.f);
    const float ang = (float)p.pos[tok] * inv;
    float s, c; sincosf(ang, &s, &c);
    p.ropetab[tok * 16 + f] = c; p.ropetab[tok * 16 + 8 + f] = s;
  }
  for (int i = gtid; i < 4 * 32 * 64; i += gstride) {
    const int pp = i & 63, lg = i >> 6;
    const float dt = expf(p.s5_logdt[lg]);
    const float lr = p.s5_lre[i], li = p.s5_lim[i];
    const float mag = expf(lr * dt);
    const float are = mag * cosf(li * dt), aim = mag * sinf(li * dt);
    const float den = lr * lr + li * li;
    const float nr = are - 1.f, ni = aim;
    const float fre = (nr * lr + ni * li) / den, fim = (ni * lr - nr * li) / den;
    float* o = p.s5par + (size_t)lg * 36 * 64 + pp;
    o[0] = are; o[64] = aim;
    bf16_t* btr = p.s5bt + ((size_t)lg * 128 + pp) * 32;
    bf16_t* bti = btr + 64 * 32;
    for (int h = 0; h < 16; ++h) {
      const float br = p.s5_bre[(size_t)i * 16 + h], bi = p.s5_bim[(size_t)i * 16 + h];
      o[(2 + h) * 64] = fre * br - fim * bi;
      o[(18 + h) * 64] = fre * bi + fim * br;
      btr[h] = f2bf(fre * br - fim * bi); bti[h] = f2bf(fre * bi + fim * br);
      btr[16 + h] = 0; bti[16 + h] = 0;
    }
    float tr = are, ti = aim;
    for (int q = 0; q < 6; ++q) { const float a = tr * tr - ti * ti, bq = 2.f * tr * ti; tr = a; ti = bq; }
    o[34 * 64] = tr; o[35 * 64] = ti;
  }
  for (int i = gtid; i < 4 * NT; i += gstride) p.rowss[NT + i] = 0.f;
  if (gtid < 64) p.ctr[gtid] = 0u;
  if (gtid < 4) {
    float s1 = 0.f, s2 = 0.f;
    for (int j = 0; j < 64; ++j) { s1 += p.da_q1[gtid * 64 + j] * p.da_k1[gtid * 64 + j]; s2 += p.da_q2[gtid * 64 + j] * p.da_k2[gtid * 64 + j]; }
    p.lamv[gtid] = expf(s1) - expf(s2) + (0.8f - 0.6f * expf(-0.3f * (float)gtid));
  }
}

DI void carry_phase(const Params& p, int layer) {
  for (int it = blockIdx.x; it < 40; it += gridDim.x) {
    if (it < 32) {
      const int idx = it * 256 + threadIdx.x, b = idx >> 11, g = (idx >> 6) & 31, pp = idx & 63;
      const float* par = p.s5par + (size_t)((layer * 32 + g) * 36) * 64 + pp;
      const float tre = par[34 * 64], tim = par[35 * 64];
      float* base = p.s5st + ((size_t)((b * 32 + g) * 128)) * 128 + pp;
      float xr = 0.f, xi = 0.f;
      for (int c0 = 0; c0 < 128; c0 += 16) {
        float er[16], ei[16];
#pragma unroll
        for (int j = 0; j < 16; ++j) { er[j] = base[(c0 + j) * 128]; ei[j] = base[(c0 + j) * 128 + 64]; }
#pragma unroll
        for (int j = 0; j < 16; ++j) {
          base[(c0 + j) * 128] = xr; base[(c0 + j) * 128 + 64] = xi;
          const float nr = tre * xr - tim * xi + er[j];
          const float ni = tre * xi + tim * xr + ei[j];
          xr = nr; xi = ni;
        }
      }
    } else {
      const int idx = (it - 32) * 256 + threadIdx.x, b = idx >> 9, ch = idx & 511;
      float* base = p.lrust + ((size_t)(b * 128) * 512 + ch) * 2;
      float h = 0.f;
      for (int c0 = 0; c0 < 128; c0 += 16) {
        float2 e[16];
#pragma unroll
        for (int j = 0; j < 16; ++j) e[j] = *(const float2*)(base + (size_t)(c0 + j) * 1024);
#pragma unroll
        for (int j = 0; j < 16; ++j) {
          base[(size_t)(c0 + j) * 1024 + 1] = h;
          h = e[j].x * h + e[j].y;
        }
      }
    }
  }
}

DI bool tile_map(int i, int ncols, int& m, int& n) {
  if (gridDim.x == 512) {
    const int x = blockIdx.x & 7, j = blockIdx.x >> 3, ncg = ncols >> 3;
    m = 16 * x + 8 * (i / ncg) + (j >> 3);
    n = 8 * (i % ncg) + (j & 7);
    return i < 2 * ncg;
  }
  const int t = blockIdx.x + i * gridDim.x;
  m = t / ncols; n = t % ncols;
  return t < 128 * ncols;
}

DI int next_item(unsigned* ctr, int* sh) {
  __syncthreads();
  if (threadIdx.x == 0) *sh = (int)atomicAdd(ctr, 1u);
  __syncthreads();
  return *sh;
}

__global__ void __launch_bounds__(256, 2) hymba_forward(Params p) {
  extern __shared__ __attribute__((aligned(16))) char lds[];
  __shared__ uint4 xb_words;
  cg::grid_group grid = cg::this_grid();
  int* sh_item = (int*)(lds + 73728);
  if (threadIdx.x == 0) xb_words = make_uint4(0u, 0u, 0u, 0u);
  __syncthreads();
  XcdBarrier xb = xcd_barrier_post(p.bar, (volatile LAS unsigned*)&xb_words);
  phase0(p, lds);
  if (gridDim.x == 0x7fffffffu) grid.sync();
  xcd_barrier(xb);
  for (int layer = 0; layer < 4; ++layer) {
    {
      GemmArgs ga; ga.A = p.xb; ga.lda = 1024; ga.mix = 0; ga.Bt = p.wt_in + (size_t)layer * 5120 * 1024; ga.K = 1024;
      EpiArgs ea; ea.p = &p; ea.layer = layer; ea.rowss = p.rowss + (size_t)layer * NT; ea.xsrc = nullptr; ea.gnext = nullptr; ea.rowss_next = nullptr;
      for (int i = 0;; ++i) { int m, n; if (!tile_map(i, 40, m, n)) break; gemm_tile<EPI_INPROJ>(ga, ea, m * 256, n * 128, lds); }
      if (layer == 0) {
        for (int t = blockIdx.x; t < 128; t += gridDim.x) {
          const int lm = t >> 5, r = t & 31;
          GemmArgs gm; gm.A = p.memn + (size_t)lm * 1024 * 1024; gm.lda = 1024; gm.mix = 0; gm.Bt = p.wt_mem + (size_t)lm * 1024 * 1024; gm.K = 1024;
          EpiArgs em = ea; em.layer = lm;
          gemm_tile<EPI_MEMKV>(gm, em, (r >> 3) * 256, (r & 7) * 128, lds);
        }
      }
    }
    xcd_barrier(xb);
    {
      unsigned* ctr = p.ctr + layer * 2;
      for (;;) {
        const int it = next_item(ctr, sh_item);
        if (it >= 1024 + 4096) break;
        if (it < 1024) lru_item<false>(p, layer, it, lds);
        else s5_item<false>(p, layer, it - 1024, lds);
      }
    }
    xcd_barrier(xb);
    carry_phase(p, layer);
    xcd_barrier(xb);
    {
      unsigned* actr = p.ctr + 16 + layer * 8 + (blockIdx.x & 7);
      for (;;) {
        const int it = next_item(actr, sh_item);
        if (it >= 256) break;
        diff_attn_item(p, layer, 127 - (it >> 1), (blockIdx.x & 7) * 2 + (it & 1), lds);
      }
      unsigned* ctr = p.ctr + layer * 2 + 1;
      for (;;) {
        const int it = next_item(ctr, sh_item);
        if (it >= 1024 + 4096 + 2048) break;
        if (it < 1024) lru_item<true>(p, layer, it, lds);
        else if (it < 5120) s5_item<true>(p, layer, it - 1024, lds);
        else mem_attn_item(p, layer, it - 5120, lds);
      }
    }
    xcd_barrier(xb);
    {
      GemmArgs ga; ga.A = p.proj + C_AU; ga.lda = PW; ga.mix = 0; ga.Bt = p.wt_glu + (size_t)layer * 1024 * 512; ga.K = 512;
      EpiArgs ea; ea.p = &p; ea.layer = layer; ea.rowss = nullptr; ea.xsrc = nullptr; ea.gnext = nullptr; ea.rowss_next = nullptr;
      for (int i = 0;; ++i) { int m, n; if (!tile_map(i, 8, m, n)) break; gemm_tile<EPI_GLU>(ga, ea, m * 256, n * 128, lds); }
    }
    xcd_barrier(xb);
    {
      GemmArgs ga; ga.A = p.proj; ga.lda = PW; ga.mix = 1; ga.Bt = p.wt_out + (size_t)layer * 1024 * 2048; ga.K = 2048;
      EpiArgs ea; ea.p = &p; ea.layer = layer; ea.rowss = nullptr;
      ea.xsrc = (layer == 0) ? p.x : p.out;
      ea.gnext = (layer < 3) ? (p.norm_g + (layer + 1) * 1024) : nullptr;
      ea.rowss_next = p.rowss + (size_t)(layer + 1) * NT;
      for (int i = 0;; ++i) { int m, n; if (!tile_map(i, 8, m, n)) break; gemm_tile<EPI_OUT>(ga, ea, m * 256, n * 128, lds); }
    }
    xcd_barrier(xb);
  }
  {
    const float* rss = p.rowss + (size_t)4 * NT;
    const size_t n4 = (size_t)NT * 256;
    for (size_t i = (size_t)blockIdx.x * 256 + threadIdx.x; i < n4; i += (size_t)gridDim.x * 256) {
      const int row = (int)(i >> 8), c4 = (int)(i & 255) * 4;
      const float rs = rsqrtf(rss[row] * (1.f / 1024.f) + 1e-6f);
      float4 v = *(float4*)(p.out + i * 4);
      const float4 g = *(const float4*)(p.fng + c4);
      v.x *= rs * g.x; v.y *= rs * g.y; v.z *= rs * g.z; v.w *= rs * g.w;
      *(float4*)(p.out + i * 4) = v;
    }
  }
}

extern "C" void kernel_launch(void* const* d_in, const int* in_sizes, int n_in, void* d_out, int out_size, void* d_ws,
                              size_t ws_size, hipStream_t stream) {
  Params p{};
  p.x = (const float*)d_in[0]; p.mem = (const float*)d_in[1]; p.pos = (const int*)d_in[2];
  p.norm_g = (const float*)d_in[3]; p.w_in = (const float*)d_in[4]; p.w_out = (const float*)d_in[5];
  p.s5_lre = (const float*)d_in[6]; p.s5_lim = (const float*)d_in[7]; p.s5_logdt = (const float*)d_in[8];
  p.s5_bre = (const float*)d_in[9]; p.s5_bim = (const float*)d_in[10]; p.s5_cre = (const float*)d_in[11];
  p.s5_cim = (const float*)d_in[12]; p.s5_d = (const float*)d_in[13]; p.s5_wglu = (const float*)d_in[14];
  p.da_q1 = (const float*)d_in[15]; p.da_k1 = (const float*)d_in[16]; p.da_q2 = (const float*)d_in[17];
  p.da_k2 = (const float*)d_in[18]; p.da_g = (const float*)d_in[19];
  p.conv_w = (const float*)d_in[20]; p.conv_b = (const float*)d_in[21]; p.lru_wa = (const float*)d_in[22];
  p.lru_ba = (const float*)d_in[23]; p.lru_wx = (const float*)d_in[24]; p.lru_bx = (const float*)d_in[25];
  p.lru_lam = (const float*)d_in[26]; p.memng = (const float*)d_in[27]; p.w_memkv = (const float*)d_in[28];
  p.fng = (const float*)d_in[29];
  p.out = (float*)d_out;
  char* ws = (char*)d_ws; size_t off = 0;
  auto take = [&](size_t bytes) { char* r = ws + off; off += (bytes + 255) & ~(size_t)255; return r; };
  p.proj = (bf16_t*)take((size_t)NT * PW * 2);
  p.vt = (bf16_t*)take((size_t)NT * 512 * 2);
  p.xb = (bf16_t*)take((size_t)NT * 1024 * 2);
  p.wt_in = (bf16_t*)take((size_t)4 * 5120 * 1024 * 2);
  p.wt_out = (bf16_t*)take((size_t)4 * 1024 * 2048 * 2);
  p.wt_glu = (bf16_t*)take((size_t)4 * 1024 * 512 * 2);
  p.wt_mem = (bf16_t*)take((size_t)4 * 1024 * 1024 * 2);
  p.memn = (bf16_t*)take((size_t)4 * 1024 * 1024 * 2);
  p.memk = (bf16_t*)take((size_t)4 * 1024 * 512 * 2);
  p.memvt = (bf16_t*)take((size_t)4 * 1024 * 512 * 2);
  p.rowss = (float*)take((size_t)5 * NT * 4);
  p.ropetab = (float*)take((size_t)NT * 16 * 4);
  p.s5par = (float*)take((size_t)4 * 32 * 36 * 64 * 4);
  p.s5st = (float*)take((size_t)4 * 32 * 128 * 128 * 4);
  p.lrust = (float*)take((size_t)4 * 128 * 512 * 2 * 4);
  p.lamv = (float*)take(256);
  p.s5bt = (bf16_t*)take((size_t)4 * 32 * 128 * 32 * 2);
  p.ctr = (unsigned*)take(1024);
  p.bar = (unsigned*)take((size_t)XCD_BAR_WORDS * 4);
  if (off > ws_size) { fprintf(stderr, "workspace too small: need %zu have %zu\n", off, ws_size); return; }
  static int grid_blocks = 0;
  if (!grid_blocks) {
    int dev = 0, cus = 0, per_cu = 0;
    hipGetDevice(&dev);
    hipDeviceGetAttribute(&cus, hipDeviceAttributeMultiprocessorCount, dev);
    hipFuncSetAttribute((const void*)hymba_forward, hipFuncAttributeMaxDynamicSharedMemorySize, LDS_BYTES);
    hipOccupancyMaxActiveBlocksPerMultiprocessor(&per_cu, hymba_forward, 256, LDS_BYTES);
    if (per_cu < 1) per_cu = 1;
    if (per_cu > 2) per_cu = 2;
    grid_blocks = cus * per_cu;
  }
  hipMemsetAsync(p.bar, 0, (size_t)XCD_BAR_WORDS * 4, stream);
  void* args[] = {&p};
  hipError_t e = hipLaunchCooperativeKernel((const void*)hymba_forward, dim3(grid_blocks), dim3(256), args, LDS_BYTES, stream);
  if (e != hipSuccess) fprintf(stderr, "cooperative launch failed: %s (grid %d)\n", hipGetErrorString(e), grid_blocks);
}
```

```cpp
#include <hip/hip_runtime.h>
#include <hip/hip_cooperative_groups.h>
#include <cstdio>
namespace cg = cooperative_groups;

typedef unsigned short bf16_t;
typedef __attribute__((ext_vector_type(8))) short bf16x8;
typedef __attribute__((ext_vector_type(4))) short s16x4;
typedef __attribute__((ext_vector_type(4))) float f32x4;

#define DI __device__ __forceinline__
#define MFMA16(a, b, c) __builtin_amdgcn_mfma_f32_16x16x32_bf16((a), (b), (c), 0, 0, 0)

constexpr int NT = 32768;
constexpr int SEQ = 8192;
constexpr int PW = 4608;
constexpr int C_AU = 0, C_AG = 512, C_Q = 1024, C_K = 1536, C_BG = 2048, C_CX = 2560, C_CG = 3072, C_MQ = 3584, C_MG = 4096;
constexpr int LDS_BYTES = 73728 + 64;

struct Params {
  const float *x, *mem; const int* pos;
  const float *norm_g, *w_in, *w_out, *s5_lre, *s5_lim, *s5_logdt, *s5_bre, *s5_bim, *s5_cre, *s5_cim, *s5_d, *s5_wglu;
  const float *da_q1, *da_k1, *da_q2, *da_k2, *da_g;
  const float *conv_w, *conv_b, *lru_wa, *lru_ba, *lru_wx, *lru_bx, *lru_lam, *memng, *w_memkv, *fng;
  float* out;
  bf16_t *proj, *vt, *xb, *wt_in, *wt_out, *wt_glu, *wt_mem, *memn, *memk, *memvt;
  float *rowss, *ropetab, *s5par, *s5st, *lrust, *lamv;
  bf16_t* s5bt;
  unsigned* ctr;
  unsigned* bar;
};

typedef __bf16 bf2_t __attribute__((ext_vector_type(2)));
typedef float f2_t __attribute__((ext_vector_type(2)));
DI unsigned pack2(float a, float b) { f2_t v = {a, b}; return __builtin_bit_cast(unsigned, __builtin_convertvector(v, bf2_t)); }
DI bf16_t f2bf(float x) { return (bf16_t)(pack2(x, 0.f) & 0xffffu); }
DI float bf2f(bf16_t h) { return __uint_as_float(((unsigned)h) << 16); }
DI float sigmoidf_(float x) { return 1.f / (1.f + __expf(-x)); }
DI float siluf_(float x) { return x / (1.f + __expf(-x)); }
DI int opaque_tid() { int t = threadIdx.x; asm volatile("" : "+v"(t)); return t; }
DI float quadmax(float x) {
  auto r = __builtin_amdgcn_permlane16_swap(__float_as_uint(x), __float_as_uint(x), false, false);
  const float m = fmaxf(__uint_as_float(r[0]), __uint_as_float(r[1]));
  auto q = __builtin_amdgcn_permlane32_swap(__float_as_uint(m), __float_as_uint(m), false, false);
  return fmaxf(__uint_as_float(q[0]), __uint_as_float(q[1]));
}
DI float quadsum(float x) {
  auto r = __builtin_amdgcn_permlane16_swap(__float_as_uint(x), __float_as_uint(x), false, false);
  const float m = __uint_as_float(r[0]) + __uint_as_float(r[1]);
  auto q = __builtin_amdgcn_permlane32_swap(__float_as_uint(m), __float_as_uint(m), false, false);
  return __uint_as_float(q[0]) + __uint_as_float(q[1]);
}
DI int swz(int row, int c) { return c ^ ((row >> 1) & 7); }

#define XB_TMO      128
#define XB_XCNT(j)  (256  + 64 * (j))
#define XB_XSUB(j)  (1280 + 64 * (j))
#define XB_XGEN(j)  (2304 + 64 * (j))
#define XB_TOP      3328
#define XB_TOPGEN   3392
#define XCD_BAR_WORDS 3456
#define XB_SPIN_CAP (1u << 18)
#define LAS __attribute__((address_space(3)))

__device__ __forceinline__ unsigned xb_ld(unsigned* p)              { return __hip_atomic_load(p, __ATOMIC_RELAXED, __HIP_MEMORY_SCOPE_AGENT); }
__device__ __forceinline__ unsigned xb_add(unsigned* p, unsigned v) { return __hip_atomic_fetch_add(p, v, __ATOMIC_RELAXED, __HIP_MEMORY_SCOPE_AGENT); }
__device__ __forceinline__ unsigned xb_xcc_id() { return (unsigned)__builtin_amdgcn_s_getreg((3 << 11) | 20) & 0xFu; }
#define XB_SPIN(cond, bar) do { unsigned _sp = 0; while (cond) { __builtin_amdgcn_s_sleep(1); \
    if ((++_sp & 255u) == 0u) { if (xb_ld(&(bar)[XB_TMO])) break; if (_sp > XB_SPIN_CAP) { atomicAdd(&(bar)[XB_TMO], 1u); break; } } } } while (0)

struct XcdBarrier {
    unsigned* bar; unsigned x;
    volatile LAS unsigned* st;
};

__device__ __forceinline__ XcdBarrier xcd_barrier_post(unsigned* bar, volatile LAS unsigned* st) {
    XcdBarrier b; b.bar = bar; b.x = xb_xcc_id(); b.st = st;
    if (threadIdx.x == 0) (void)xb_add(&bar[XB_XCNT(b.x)], 1u);
    return b;
}
__device__ __forceinline__ void xcd_barrier_complete(unsigned* bar, unsigned x, unsigned& nloc, unsigned& nx) {
    const unsigned G = gridDim.x * gridDim.y * gridDim.z;
    unsigned sum, cnt, mine, sp = 0u;
    for (;;) {
        sum = 0u; cnt = 0u; mine = 0u;
#pragma unroll
        for (unsigned j = 0; j < 16; ++j) { const unsigned c = xb_ld(&bar[XB_XCNT(j)]); sum += c; cnt += (c > 0u) ? 1u : 0u; mine = (j == x) ? c : mine; }
        if (sum == G) break;
        __builtin_amdgcn_s_sleep(1);
        if ((++sp & 255u) == 0u) { if (xb_ld(&bar[XB_TMO])) break; if (sp > XB_SPIN_CAP) { atomicAdd(&bar[XB_TMO], 1u); break; } }
    }
    nloc = mine > 0u ? mine : 1u; nx = cnt > 0u ? cnt : 1u;
}

__device__ __forceinline__ void xcd_barrier(const XcdBarrier& b) {
    asm volatile("s_waitcnt vmcnt(0)" ::: "memory");
    __syncthreads();
    if (threadIdx.x == 0) {
        unsigned* bar = b.bar;
        __builtin_amdgcn_s_waitcnt(0);
        unsigned nloc = b.st[0], nx = b.st[1];
        if (nloc == 0u) { xcd_barrier_complete(bar, b.x, nloc, nx); b.st[0] = nloc; b.st[1] = nx; }
        const unsigned old = xb_add(&bar[XB_XSUB(b.x)], 1u);
        const unsigned gen = old / nloc;
        if (old + 1u == (gen + 1u) * nloc) {
            __builtin_amdgcn_fence(__ATOMIC_RELEASE, "agent");
            asm volatile("s_waitcnt vmcnt(0)" ::: "memory");
            const unsigned og = xb_add(&bar[XB_TOP], 1u);
            const unsigned tg = og / nx;
            if (og + 1u == (tg + 1u) * nx) xb_add(&bar[XB_TOPGEN], 1u);
            else XB_SPIN(xb_ld(&bar[XB_TOPGEN]) == tg, bar);
            __builtin_amdgcn_fence(__ATOMIC_ACQUIRE, "agent");
            xb_add(&bar[XB_XGEN(b.x)], 1u);
            asm volatile("s_waitcnt vmcnt(0)" ::: "memory");
        } else {
            XB_SPIN(xb_ld(&bar[XB_XGEN(b.x)]) == gen, bar);
            __builtin_amdgcn_fence(__ATOMIC_ACQUIRE, "agent");
            asm volatile("s_waitcnt vmcnt(0)" ::: "memory");
        }
    }
    __syncthreads();
}


struct GemmArgs {
  const bf16_t* A; int lda; int mix;
  const bf16_t* Bt; int K;
};
DI int mixcol(int k0) { int g = k0 >> 9; int s = (g == 0) ? C_AG : (g == 1) ? C_BG : (g == 2) ? C_CG : C_MG; return s + (k0 & 511); }

enum { EPI_INPROJ = 0, EPI_MEMKV = 1, EPI_GLU = 2, EPI_OUT = 3 };

struct EpiArgs {
  const Params* p; int layer;
  const float* rowss;
  const float* xsrc;
  const float* gnext;
  float* rowss_next;
};

DI int swz64(int row, int c) { return c ^ ((0x1320 >> (((row >> 2) & 3) * 4)) & 3); }

template <int EPI>
DI void gemm_tile(const GemmArgs& ga, const EpiArgs& ea, int m0, int n0, char* lds) {
  const int tid = opaque_tid(), lane = tid & 63, w = tid >> 6;
  const int wm = w >> 1, wn = w & 1, c16 = lane & 15, quad = lane >> 4;
  f32x4 acc[8][4];
#pragma unroll
  for (int i = 0; i < 8; ++i)
#pragma unroll
    for (int j = 0; j < 4; ++j) acc[i][j] = f32x4{0.f, 0.f, 0.f, 0.f};
  const int K = ga.K, nk = K >> 5;
  const int prow = lane >> 2, pch = lane & 3;
  const bf16_t* gsrc[6];
  int ldsoff[6];
#pragma unroll
  for (int i = 0; i < 6; ++i) {
    const int pi = w * 6 + i;
    if (pi < 16) {
      const int row = pi * 16 + prow;
      gsrc[i] = ga.A + (size_t)(m0 + row) * ga.lda + swz64(row, pch) * 8;
      ldsoff[i] = pi * 1024 + lane * 16;
    } else {
      const int row = (pi - 16) * 16 + prow;
      gsrc[i] = ga.Bt + (size_t)(n0 + row) * K + swz64(row, pch) * 8;
      ldsoff[i] = pi * 1024 + lane * 16;
    }
  }
  auto dma = [&](int kt, int buf) {
    const int k0 = kt << 5;
    const int ac = ga.mix ? mixcol(k0) : k0;
    char* base = lds + buf * 24576;
#pragma unroll
    for (int i = 0; i < 6; ++i) {
      const int pi = w * 6 + i;
      __builtin_amdgcn_global_load_lds((const unsigned*)(gsrc[i] + ((pi < 16) ? ac : k0)), (unsigned*)(base + ldsoff[i]), 16, 0, 0);
    }
  };
  __syncthreads();
  dma(0, 0);
  if (nk > 1) dma(1, 1);
  for (int kt = 0; kt < nk; ++kt) {
    if (kt + 1 < nk) asm volatile("s_waitcnt vmcnt(6)" ::: "memory");
    else asm volatile("s_waitcnt vmcnt(0)" ::: "memory");
    __builtin_amdgcn_s_barrier();
    const char* Ab = lds + (kt % 3) * 24576 + wm * 128 * 64;
    const char* Bb = lds + (kt % 3) * 24576 + 16384 + wn * 64 * 64;
    bf16x8 af[8], bfr[4];
    const int ch = swz64(c16, quad) << 4;
#pragma unroll
    for (int nt = 0; nt < 4; ++nt) bfr[nt] = *(const bf16x8*)(Bb + (nt * 16 + c16) * 64 + ch);
#pragma unroll
    for (int mt = 0; mt < 2; ++mt) af[mt] = *(const bf16x8*)(Ab + (mt * 16 + c16) * 64 + ch);
    __builtin_amdgcn_sched_barrier(0);
    if (kt + 2 < nk) dma(kt + 2, (kt + 2) % 3);
    __builtin_amdgcn_sched_barrier(0);
#pragma unroll
    for (int g = 0; g < 4; ++g) {
      if (g < 3) {
#pragma unroll
        for (int mt = 2 * g + 2; mt < 2 * g + 4; ++mt) af[mt] = *(const bf16x8*)(Ab + (mt * 16 + c16) * 64 + ch);
      }
#pragma unroll
      for (int mt = 2 * g; mt < 2 * g + 2; ++mt)
#pragma unroll
        for (int nt = 0; nt < 4; ++nt) acc[mt][nt] = MFMA16(bfr[nt], af[mt], acc[mt][nt]);
      __builtin_amdgcn_sched_barrier(0);
    }
  }
  const Params& p = *ea.p;
  if constexpr (EPI == EPI_INPROJ) {
    const int slot = n0 >> 9;
    const int dbase = (slot < 4) ? slot * 512 : (slot - 1) * 512;
#pragma unroll
    for (int mt = 0; mt < 8; ++mt) {
      const int row = m0 + wm * 128 + mt * 16 + c16;
      const float rs = rsqrtf(ea.rowss[row] * (1.f / 1024.f) + 1e-6f);
#pragma unroll
      for (int nt = 0; nt < 4; ++nt) {
        const int cc0 = (n0 & 511) + wn * 64 + nt * 16 + quad * 4;
        float v[4];
#pragma unroll
        for (int r = 0; r < 4; ++r) v[r] = acc[mt][nt][r] * rs;
        if (slot == 4) {
          const int b = row >> 13, l = row & 8191, h = cc0 >> 7, dv0 = cc0 & 127;
          const int lp = (l & ~31) | (((l >> 2) & 3) << 3) | (((l >> 4) & 1) << 2) | (l & 3);
#pragma unroll
          for (int r = 0; r < 4; ++r) p.vt[((size_t)((b * 4 + h) * 128 + dv0 + r)) * SEQ + lp] = f2bf(v[r]);
        } else {
          if (slot == 2 || slot == 3) {
            if (nt == 0) {
              const float* cs = p.ropetab + (size_t)row * 16 + (quad & 1) * 4;
              const float4 co = *(const float4*)cs, si = *(const float4*)(cs + 8);
              const float cov[4] = {co.x, co.y, co.z, co.w}, siv[4] = {si.x, si.y, si.z, si.w};
#pragma unroll
              for (int r = 0; r < 4; ++r) {
                const float pr = __shfl_xor(v[r], 32);
                v[r] = (quad < 2) ? (v[r] * cov[r] - pr * siv[r]) : (v[r] * cov[r] + pr * siv[r]);
              }
            }
            if (slot == 2) {
#pragma unroll
              for (int r = 0; r < 4; ++r) v[r] *= 0.18033688011112042f;
            }
          } else if (slot == 1 || slot == 5 || slot == 7 || slot == 9) {
#pragma unroll
            for (int r = 0; r < 4; ++r) v[r] = siluf_(v[r]);
          } else if (slot == 8) {
#pragma unroll
            for (int r = 0; r < 4; ++r) v[r] *= 0.12751743082459868f;
          }
          uint2 pk; pk.x = pack2(v[0], v[1]); pk.y = pack2(v[2], v[3]);
          *(uint2*)(p.proj + (size_t)row * PW + dbase + cc0) = pk;
        }
      }
    }
  } else if constexpr (EPI == EPI_MEMKV) {
    const int lm = ea.layer;
#pragma unroll
    for (int mt = 0; mt < 8; ++mt) {
      const int row = m0 + wm * 128 + mt * 16 + c16;
#pragma unroll
      for (int nt = 0; nt < 4; ++nt) {
        const int col0 = n0 + wn * 64 + nt * 16 + quad * 4;
        if (col0 < 512) {
          uint2 pk; pk.x = pack2(acc[mt][nt][0], acc[mt][nt][1]); pk.y = pack2(acc[mt][nt][2], acc[mt][nt][3]);
          *(uint2*)(p.memk + ((size_t)lm * 1024 + row) * 512 + col0) = pk;
        } else {
          const int cc0 = col0 - 512, h = cc0 >> 7, dv0 = cc0 & 127, b = row >> 8, m = row & 255;
          const int mp = (m & ~31) | (((m >> 2) & 3) << 3) | (((m >> 4) & 1) << 2) | (m & 3);
#pragma unroll
          for (int r = 0; r < 4; ++r) p.memvt[((size_t)((lm * 4 + b) * 4 + h) * 128 + dv0 + r) * 256 + mp] = f2bf(acc[mt][nt][r]);
        }
      }
    }
  } else if constexpr (EPI == EPI_GLU) {
    const int blk = (n0 + wn * 64) >> 6;
#pragma unroll
    for (int mt = 0; mt < 8; ++mt) {
      const int row = m0 + wm * 128 + mt * 16 + c16;
#pragma unroll
      for (int nt = 0; nt < 2; ++nt) {
        const int j0 = blk * 32 + nt * 16 + quad * 4;
        uint2* q = (uint2*)(p.proj + (size_t)row * PW + C_AG + j0);
        const uint2 gv = *q;
        const float g0 = __uint_as_float(gv.x << 16), g1 = __uint_as_float(gv.x & 0xffff0000u);
        const float g2 = __uint_as_float(gv.y << 16), g3 = __uint_as_float(gv.y & 0xffff0000u);
        uint2 o;
        o.x = pack2(acc[mt][nt][0] * sigmoidf_(acc[mt][nt + 2][0]) * g0, acc[mt][nt][1] * sigmoidf_(acc[mt][nt + 2][1]) * g1);
        o.y = pack2(acc[mt][nt][2] * sigmoidf_(acc[mt][nt + 2][2]) * g2, acc[mt][nt][3] * sigmoidf_(acc[mt][nt + 2][3]) * g3);
        *q = o;
      }
    }
  } else {
#pragma unroll
    for (int mt = 0; mt < 8; ++mt) {
      const int row = m0 + wm * 128 + mt * 16 + c16;
      float ss = 0.f;
#pragma unroll
      for (int nt = 0; nt < 4; ++nt) {
        const int col0 = n0 + wn * 64 + nt * 16 + quad * 4;
        const size_t idx = (size_t)row * 1024 + col0;
        float4 xo;
        if (ea.xsrc) xo = *(const float4*)(ea.xsrc + idx);
        else {
          const uint2 u = *(const uint2*)(p.xb + idx);
          xo = make_float4(__uint_as_float(u.x << 16), __uint_as_float(u.x & 0xffff0000u), __uint_as_float(u.y << 16), __uint_as_float(u.y & 0xffff0000u));
        }
        float4 xn;
        xn.x = xo.x + acc[mt][nt][0]; xn.y = xo.y + acc[mt][nt][1]; xn.z = xo.z + acc[mt][nt][2]; xn.w = xo.w + acc[mt][nt][3];
        ss += xn.x * xn.x + xn.y * xn.y + xn.z * xn.z + xn.w * xn.w;
        if (ea.gnext) {
          uint2 o; o.x = pack2(xn.x, xn.y); o.y = pack2(xn.z, xn.w);
          *(uint2*)(p.xb + idx) = o;
        } else {
          *(float4*)(p.out + idx) = xn;
        }
      }
      ss = quadsum(ss);
      if (quad == 0) atomicAdd(ea.rowss_next + row, ss);
    }
  }
}

template <int NS, int QT>
struct AttnState {
  f32x4 O[NS][8][QT];
  float l[NS][QT];
};

template <int NS, int QT>
DI void attn_core(AttnState<NS, QT>& st, const bf16_t* qp, int qstride, const bf16_t* kp, int kstride,
                          const bf16_t* vtp, int vtstride, int nkt, int qpos0, bool causal, char* lds) {
  const int tid = opaque_tid(), lane = tid & 63, w = tid >> 6, c16 = lane & 15, quad = lane >> 4;
  bf16x8 qf[QT][4];
#pragma unroll
  for (int qt = 0; qt < QT; ++qt)
#pragma unroll
    for (int f = 0; f < 4; ++f)
      qf[qt][f] = *(const bf16x8*)(qp + (size_t)(w * 16 * QT + qt * 16 + c16) * qstride + f * 32 + quad * 8);
  float m[NS][QT];
#pragma unroll
  for (int s = 0; s < NS; ++s)
#pragma unroll
    for (int qt = 0; qt < QT; ++qt) {
      m[s][qt] = 0.f; st.l[s][qt] = 0.f;
#pragma unroll
      for (int d = 0; d < 8; ++d) st.O[s][d][qt] = f32x4{0.f, 0.f, 0.f, 0.f};
    }
  const int prow = lane >> 3, pch = lane & 7;
  unsigned koff[4], voff[4];
#pragma unroll
  for (int i = 0; i < 4; ++i) {
    const int pi = w * 4 + i;
    { const int row = (pi & 7) * 8 + prow, sub = pi >> 3, c = pch ^ ((row >> 1) & 7);
      koff[i] = (unsigned)((row * kstride + sub * 64 + c * 8) * 2); }
    { const int row = pi * 8 + prow, c = pch ^ ((row >> 1) & 7);
      voff[i] = (unsigned)((row * vtstride + c * 8) * 2); }
  }
  auto gload = [&](int kt, int buf) {
    char* base = lds + buf * 32768;
    const char* kt_base = (const char*)(kp + (size_t)kt * 64 * kstride);
    const char* vt_base = (const char*)(vtp + (size_t)kt * 64);
#pragma unroll
    for (int i = 0; i < 4; ++i)
      __builtin_amdgcn_global_load_lds((const unsigned*)(kt_base + koff[i]), (unsigned*)(base + (w * 4 + i) * 1024 + lane * 16), 16, 0, 0);
#pragma unroll
    for (int i = 0; i < 4; ++i)
      __builtin_amdgcn_global_load_lds((const unsigned*)(vt_base + voff[i]), (unsigned*)(base + 16384 + (w * 4 + i) * 1024 + lane * 16), 16, 0, 0);
  };
  const int qw0 = qpos0 + w * 16 * QT;
  gload(0, 0); __syncthreads();
  for (int kt = 0; kt < nkt; ++kt) {
    if (kt + 1 < nkt) gload(kt + 1, (kt + 1) & 1);
    const char* Kb = lds + (kt & 1) * 32768;
    const char* Vb = Kb + 16384;
    const bool active = !causal || (kt * 64 <= qw0 + 16 * QT - 1);
    if (active) {
      const bool need_mask = causal && (kt * 64 + 63 > qw0);
      bf16x8 pf[NS][2][QT];
      f32x4 S[NS][4][QT];
#pragma unroll
      for (int s = 0; s < NS; ++s)
#pragma unroll
        for (int a = 0; a < 4; ++a)
#pragma unroll
          for (int qt = 0; qt < QT; ++qt) { const float nm = -m[s][qt]; S[s][a][qt] = f32x4{nm, nm, nm, nm}; }
      bf16x8 kfa[8], kfb[8], vfa[8], vfb[8];
#pragma unroll
      for (int i = 0; i < 8; ++i) {
        const int ksub = i & 3, row = ksub * 16 + c16, chunk = (i >> 2) * 4 + quad;
        kfa[i] = *(const bf16x8*)(Kb + row * 128 + (swz(row, chunk) << 4));
      }
      __builtin_amdgcn_sched_barrier(0);
#pragma unroll
      for (int i = 0; i < 8; ++i) {
        const int ksub = i & 3, row = ksub * 16 + c16, chunk = (i >> 2) * 4 + quad;
        kfb[i] = *(const bf16x8*)(Kb + 8192 + row * 128 + (swz(row, chunk) << 4));
      }
#pragma unroll
      for (int i = 0; i < 8; ++i)
#pragma unroll
        for (int qt = 0; qt < QT; ++qt) S[0][i & 3][qt] = MFMA16(kfa[i], qf[qt][i >> 2], S[0][i & 3][qt]);
      __builtin_amdgcn_sched_barrier(0);
#pragma unroll
      for (int d = 0; d < 8; ++d) {
        const int row = d * 16 + c16;
        vfa[d] = *(const bf16x8*)(Vb + row * 128 + (swz(row, quad) << 4));
      }
#pragma unroll
      for (int i = 0; i < 8; ++i)
#pragma unroll
        for (int qt = 0; qt < QT; ++qt) S[NS - 1][i & 3][qt] = MFMA16(kfb[i], qf[qt][2 + (i >> 2)], S[NS - 1][i & 3][qt]);
      if (need_mask) {
#pragma unroll
        for (int s = 0; s < NS; ++s)
#pragma unroll
          for (int ksub = 0; ksub < 4; ++ksub)
#pragma unroll
            for (int qt = 0; qt < QT; ++qt)
#pragma unroll
              for (int r = 0; r < 4; ++r) {
                const int key = kt * 64 + ksub * 16 + quad * 4 + r;
                const int qpos = qw0 + qt * 16 + c16;
                if (key > qpos) S[s][ksub][qt][r] = -1e30f;
              }
      }
      float mx[NS][QT];
      bool need = false;
#pragma unroll
      for (int s = 0; s < NS; ++s)
#pragma unroll
        for (int qt = 0; qt < QT; ++qt) {
          float v = -1e30f;
#pragma unroll
          for (int ksub = 0; ksub < 4; ++ksub)
#pragma unroll
            for (int r = 0; r < 4; ++r) v = fmaxf(v, S[s][ksub][qt][r]);
          v = quadmax(v);
          mx[s][qt] = v;
          need = need || (v > 8.f);
        }
      if (__any(need) || kt == 0) {
#pragma unroll
        for (int s = 0; s < NS; ++s)
#pragma unroll
          for (int qt = 0; qt < QT; ++qt) {
            const float delta = (kt == 0) ? mx[s][qt] : fmaxf(mx[s][qt], 0.f);
            const float alpha = (kt == 0) ? 1.f : __builtin_amdgcn_exp2f(-delta);
            m[s][qt] += delta;
            st.l[s][qt] *= alpha;
#pragma unroll
            for (int d = 0; d < 8; ++d) st.O[s][d][qt] *= alpha;
#pragma unroll
            for (int ksub = 0; ksub < 4; ++ksub)
#pragma unroll
              for (int r = 0; r < 4; ++r) S[s][ksub][qt][r] -= delta;
          }
      }
#pragma unroll
      for (int s = 0; s < NS; ++s)
#pragma unroll
        for (int qt = 0; qt < QT; ++qt) {
          float psum = 0.f;
#pragma unroll
          for (int ksub = 0; ksub < 4; ++ksub)
#pragma unroll
            for (int r = 0; r < 4; ++r) { const float e = __builtin_amdgcn_exp2f(S[s][ksub][qt][r]); S[s][ksub][qt][r] = e; psum += e; }
          st.l[s][qt] += psum;
#pragma unroll
          for (int kk = 0; kk < 2; ++kk) {
            union { unsigned u[4]; bf16x8 v; } pk;
            pk.u[0] = pack2(S[s][2 * kk][qt][0], S[s][2 * kk][qt][1]);
            pk.u[1] = pack2(S[s][2 * kk][qt][2], S[s][2 * kk][qt][3]);
            pk.u[2] = pack2(S[s][2 * kk + 1][qt][0], S[s][2 * kk + 1][qt][1]);
            pk.u[3] = pack2(S[s][2 * kk + 1][qt][2], S[s][2 * kk + 1][qt][3]);
            pf[s][kk][qt] = pk.v;
          }
        }
      __builtin_amdgcn_sched_barrier(0);
#pragma unroll
      for (int d = 0; d < 8; ++d) {
        const int row = d * 16 + c16;
        vfb[d] = *(const bf16x8*)(Vb + row * 128 + (swz(row, 4 + quad) << 4));
      }
#pragma unroll
      for (int d = 0; d < 8; ++d)
#pragma unroll
        for (int s = 0; s < NS; ++s)
#pragma unroll
          for (int qt = 0; qt < QT; ++qt) st.O[s][d][qt] = MFMA16(vfa[d], pf[s][0][qt], st.O[s][d][qt]);
      __builtin_amdgcn_sched_barrier(0);
#pragma unroll
      for (int d = 0; d < 8; ++d)
#pragma unroll
        for (int s = 0; s < NS; ++s)
#pragma unroll
          for (int qt = 0; qt < QT; ++qt) st.O[s][d][qt] = MFMA16(vfb[d], pf[s][1][qt], st.O[s][d][qt]);
    }
    __syncthreads();
  }
#pragma unroll
  for (int s = 0; s < NS; ++s)
#pragma unroll
    for (int qt = 0; qt < QT; ++qt) {
      st.l[s][qt] = quadsum(st.l[s][qt]);
    }
}

DI void diff_attn_item(const Params& p, int layer, int qb, int bh, char* lds) {
  const int b = bh >> 2, h = bh & 3;
  const int tok0 = b * SEQ + qb * 64;
  const int tid_ = opaque_tid(), lane = tid_ & 63, w = tid_ >> 6, c16 = lane & 15, quad = lane >> 4;
  const int sidx = w & 1, g = w >> 1;
  const bf16_t* qp = p.proj + (size_t)tok0 * PW + C_Q + h * 128;
  const bf16_t* kp = p.proj + (size_t)b * SEQ * PW + C_K + h * 128;
  const bf16_t* vtp = p.vt + (size_t)((b * 4 + h) * 128) * SEQ;
  const int nkt = qb + 1;
  bf16x8 qf[2][2];
#pragma unroll
  for (int qt = 0; qt < 2; ++qt)
#pragma unroll
    for (int ff = 0; ff < 2; ++ff)
      qf[qt][ff] = *(const bf16x8*)(qp + (size_t)(g * 32 + qt * 16 + c16) * PW + (sidx * 2 + ff) * 32 + quad * 8);
  float m[2], l[2];
  f32x4 O[8][2];
#pragma unroll
  for (int qt = 0; qt < 2; ++qt) {
    m[qt] = 0.f; l[qt] = 0.f;
#pragma unroll
    for (int d = 0; d < 8; ++d) O[d][qt] = f32x4{0.f, 0.f, 0.f, 0.f};
  }
  const int prow = lane >> 3, pch = lane & 7;
  unsigned koff[4], voff[4];
#pragma unroll
  for (int i = 0; i < 4; ++i) {
    const int pi = w * 4 + i;
    { const int row = (pi & 7) * 8 + prow, sub = pi >> 3, c = pch ^ ((row >> 1) & 7);
      koff[i] = (unsigned)((row * PW + sub * 64 + c * 8) * 2); }
    { const int row = pi * 8 + prow, c = pch ^ ((row >> 1) & 7);
      voff[i] = (unsigned)((row * SEQ + c * 8) * 2); }
  }
  auto gload = [&](int kt, int buf) {
    char* base = lds + buf * 32768;
    const char* kt_base = (const char*)(kp + (size_t)kt * 64 * PW);
    const char* vt_base = (const char*)(vtp + (size_t)kt * 64);
#pragma unroll
    for (int i = 0; i < 4; ++i)
      __builtin_amdgcn_global_load_lds((const unsigned*)(kt_base + koff[i]), (unsigned*)(base + (w * 4 + i) * 1024 + lane * 16), 16, 0, 0);
#pragma unroll
    for (int i = 0; i < 4; ++i)
      __builtin_amdgcn_global_load_lds((const unsigned*)(vt_base + voff[i]), (unsigned*)(base + 16384 + (w * 4 + i) * 1024 + lane * 16), 16, 0, 0);
  };
  const int qw0 = qb * 64 + g * 32;
  gload(0, 0); __syncthreads();
  for (int kt = 0; kt < nkt; ++kt) {
    if (kt + 1 < nkt) gload(kt + 1, (kt + 1) & 1);
    const char* Kb = lds + (kt & 1) * 32768 + sidx * 8192;
    const char* Vb = lds + (kt & 1) * 32768 + 16384;
    if (kt * 64 <= qw0 + 31) {
      f32x4 S[4][2];
#pragma unroll
      for (int a = 0; a < 4; ++a)
#pragma unroll
        for (int qt = 0; qt < 2; ++qt) { const float nm = -m[qt]; S[a][qt] = f32x4{nm, nm, nm, nm}; }
      bf16x8 kf[8], vfa[8], vfb[8];
#pragma unroll
      for (int i = 0; i < 8; ++i) {
        const int row = (i & 3) * 16 + c16, chunk = (i >> 2) * 4 + quad;
        kf[i] = *(const bf16x8*)(Kb + row * 128 + (swz(row, chunk) << 4));
      }
      __builtin_amdgcn_sched_barrier(0);
#pragma unroll
      for (int d = 0; d < 8; ++d) { const int row = d * 16 + c16; vfa[d] = *(const bf16x8*)(Vb + row * 128 + (swz(row, quad) << 4)); }
#pragma unroll
      for (int i = 0; i < 8; ++i)
#pragma unroll
        for (int qt = 0; qt < 2; ++qt) S[i & 3][qt] = MFMA16(kf[i], qf[qt][i >> 2], S[i & 3][qt]);
      __builtin_amdgcn_sched_barrier(0);
      if (kt * 64 + 63 > qw0) {
#pragma unroll
        for (int ksub = 0; ksub < 4; ++ksub)
#pragma unroll
          for (int qt = 0; qt < 2; ++qt)
#pragma unroll
            for (int r = 0; r < 4; ++r) {
              const int key = kt * 64 + ksub * 16 + quad * 4 + r;
              if (key > qw0 + qt * 16 + c16) S[ksub][qt][r] = -1e30f;
            }
      }
      float mx[2];
      bool need = false;
#pragma unroll
      for (int qt = 0; qt < 2; ++qt) {
        float v = -1e30f;
#pragma unroll
        for (int ksub = 0; ksub < 4; ++ksub)
#pragma unroll
          for (int r = 0; r < 4; ++r) v = fmaxf(v, S[ksub][qt][r]);
        v = quadmax(v);
        mx[qt] = v;
        need = need || (v > 8.f);
      }
      if (__any(need) || kt == 0) {
#pragma unroll
        for (int qt = 0; qt < 2; ++qt) {
          const float delta = (kt == 0) ? mx[qt] : fmaxf(mx[qt], 0.f);
          const float alpha = (kt == 0) ? 1.f : __builtin_amdgcn_exp2f(-delta);
          m[qt] += delta;
          l[qt] *= alpha;
#pragma unroll
          for (int d = 0; d < 8; ++d) O[d][qt] *= alpha;
#pragma unroll
          for (int ksub = 0; ksub < 4; ++ksub)
#pragma unroll
            for (int r = 0; r < 4; ++r) S[ksub][qt][r] -= delta;
        }
      }
      bf16x8 pf[2][2];
#pragma unroll
      for (int qt = 0; qt < 2; ++qt) {
        float psum = 0.f;
#pragma unroll
        for (int ksub = 0; ksub < 4; ++ksub)
#pragma unroll
          for (int r = 0; r < 4; ++r) { const float e = __builtin_amdgcn_exp2f(S[ksub][qt][r]); S[ksub][qt][r] = e; psum += e; }
        l[qt] += psum;
#pragma unroll
        for (int kk = 0; kk < 2; ++kk) {
          union { unsigned u[4]; bf16x8 v; } pk;
          pk.u[0] = pack2(S[2 * kk][qt][0], S[2 * kk][qt][1]);
          pk.u[1] = pack2(S[2 * kk][qt][2], S[2 * kk][qt][3]);
          pk.u[2] = pack2(S[2 * kk + 1][qt][0], S[2 * kk + 1][qt][1]);
          pk.u[3] = pack2(S[2 * kk + 1][qt][2], S[2 * kk + 1][qt][3]);
          pf[kk][qt] = pk.v;
        }
      }
      __builtin_amdgcn_sched_barrier(0);
#pragma unroll
      for (int d = 0; d < 8; ++d) { const int row = d * 16 + c16; vfb[d] = *(const bf16x8*)(Vb + row * 128 + (swz(row, 4 + quad) << 4)); }
#pragma unroll
      for (int d = 0; d < 8; ++d)
#pragma unroll
        for (int qt = 0; qt < 2; ++qt) O[d][qt] = MFMA16(vfa[d], pf[0][qt], O[d][qt]);
      __builtin_amdgcn_sched_barrier(0);
#pragma unroll
      for (int d = 0; d < 8; ++d)
#pragma unroll
        for (int qt = 0; qt < 2; ++qt) O[d][qt] = MFMA16(vfb[d], pf[1][qt], O[d][qt]);
    }
    __syncthreads();
  }
  const float lam = p.lamv[layer];
  const float lam_init = 0.8f - 0.6f * expf(-0.3f * (float)layer);
  float* xch = (float*)(lds + g * 16384);
  float cf[2];
#pragma unroll
  for (int qt = 0; qt < 2; ++qt) cf[qt] = ((sidx == 0) ? 1.f : lam) / quadsum(l[qt]);
  if (sidx == 1) {
#pragma unroll
    for (int d = 0; d < 8; ++d)
#pragma unroll
      for (int qt = 0; qt < 2; ++qt)
#pragma unroll
        for (int r = 0; r < 4; ++r) xch[((d * 2 + qt) * 4 + r) * 64 + lane] = O[d][qt][r] * cf[qt];
  }
  __syncthreads();
  if (sidx == 0) {
    const float* sg = p.da_g + layer * 128;
#pragma unroll
    for (int qt = 0; qt < 2; ++qt) {
      float ss = 0.f;
#pragma unroll
      for (int d = 0; d < 8; ++d)
#pragma unroll
        for (int r = 0; r < 4; ++r) {
          const float o = O[d][qt][r] * cf[qt] - xch[((d * 2 + qt) * 4 + r) * 64 + lane];
          O[d][qt][r] = o; ss += o * o;
        }
      ss = quadsum(ss);
      const float rn = rsqrtf(ss * (1.f / 128.f) + 1e-6f) * (1.f - lam_init);
      const int tok = tok0 + g * 32 + qt * 16 + c16;
#pragma unroll
      for (int d = 0; d < 8; ++d) {
        const int dv0 = d * 16 + quad * 4;
        bf16_t* gp = p.proj + (size_t)tok * PW + C_BG + h * 128 + dv0;
        const uint2 gv = *(const uint2*)gp;
        const float g0 = __uint_as_float(gv.x << 16), g1 = __uint_as_float(gv.x & 0xffff0000u);
        const float g2 = __uint_as_float(gv.y << 16), g3 = __uint_as_float(gv.y & 0xffff0000u);
        uint2 o;
        o.x = pack2(O[d][qt][0] * rn * sg[dv0] * g0, O[d][qt][1] * rn * sg[dv0 + 1] * g1);
        o.y = pack2(O[d][qt][2] * rn * sg[dv0 + 2] * g2, O[d][qt][3] * rn * sg[dv0 + 3] * g3);
        *(uint2*)gp = o;
      }
    }
  }
}

DI void mem_attn_item(const Params& p, int layer, int item, char* lds) {
  const int qb = item >> 4, bh = item & 15, b = bh >> 2, h = bh & 3;
  const int tok0 = b * SEQ + qb * 64;
  const int tid_ = opaque_tid(), lane = tid_ & 63, w = tid_ >> 6, c16 = lane & 15, quad = lane >> 4;
  AttnState<1, 1> st;
  attn_core<1, 1>(st, p.proj + (size_t)tok0 * PW + C_MQ + h * 128, PW,
               p.memk + ((size_t)layer * 1024 + b * 256) * 512 + h * 128, 512,
               p.memvt + ((size_t)((layer * 4 + b) * 4 + h) * 128) * 256, 256, 4, 0, false, lds);
#pragma unroll
  for (int qt = 0; qt < 1; ++qt) {
    const float i1 = 1.f / st.l[0][qt];
    const int tok = tok0 + w * 16 + qt * 16 + c16;
#pragma unroll
    for (int d = 0; d < 8; ++d) {
      const int dv0 = d * 16 + quad * 4;
      bf16_t* g = p.proj + (size_t)tok * PW + C_MG + h * 128 + dv0;
      const uint2 gv = *(const uint2*)g;
      const float g0 = __uint_as_float(gv.x << 16), g1 = __uint_as_float(gv.x & 0xffff0000u);
      const float g2 = __uint_as_float(gv.y << 16), g3 = __uint_as_float(gv.y & 0xffff0000u);
      uint2 o;
      o.x = pack2(st.O[0][d][qt][0] * i1 * g0, st.O[0][d][qt][1] * i1 * g1);
      o.y = pack2(st.O[0][d][qt][2] * i1 * g2, st.O[0][d][qt][3] * i1 * g3);
      *(uint2*)g = o;
    }
  }
}

DI float gelu_tanh(float x) {
  const float u = 0.7978845608028654f * (x + 0.044715f * x * x * x);
  const float t = 1.f - 2.f / (1.f + __expf(2.f * u));
  return 0.5f * x * (1.f + t);
}

template <bool FINAL>
DI void s5_item(const Params& p, int layer, int item, char* lds) {
  const int gq = item & 7, c = (item >> 3) & 127, b = item >> 10;
  const int tid_ = opaque_tid(), lane = tid_ & 63, w = tid_ >> 6, c16 = lane & 15, quad = lane >> 4;
  const int g = gq * 4 + w;
  const int tok0 = b * SEQ + c * 64;
  float* bu = (float*)(lds + w * 16384);
  char* xsb = lds + w * 16384 + 8192;
  bf16x8 bbf[8];
  {
    const bf16_t* bt = p.s5bt + (size_t)(layer * 32 + g) * 128 * 32;
#pragma unroll
    for (int nt = 0; nt < 8; ++nt) bbf[nt] = *(const bf16x8*)(bt + (nt * 16 + c16) * 32 + quad * 8);
  }
  const float* par = p.s5par + (size_t)((layer * 32 + g) * 36) * 64 + lane;
  const float are = par[0], aim = par[64];
  float xr = 0.f, xi = 0.f;
  float* stp = p.s5st + ((size_t)((b * 32 + g) * 128)) * 128 + lane;
  bf16x8 cf[FINAL ? 4 : 1];
  float dsk = 0.f;
  if constexpr (FINAL) {
    xr = stp[c * 128]; xi = stp[c * 128 + 64];
    const float* cr = p.s5_cre + (size_t)((layer * 32 + g) * 16 + c16) * 64;
    const float* ci = p.s5_cim + (size_t)((layer * 32 + g) * 16 + c16) * 64;
#pragma unroll
    for (int ks = 0; ks < 4; ++ks) {
      const float* src = ((ks < 2) ? cr : ci) + (ks & 1) * 32 + quad * 8;
      const float sg = (ks < 2) ? 1.f : -1.f;
      const float4 v0 = *(const float4*)src, v1 = *(const float4*)(src + 4);
      union { unsigned u[4]; bf16x8 v; } pk;
      pk.u[0] = pack2(sg * v0.x, sg * v0.y); pk.u[1] = pack2(sg * v0.z, sg * v0.w);
      pk.u[2] = pack2(sg * v1.x, sg * v1.y); pk.u[3] = pack2(sg * v1.z, sg * v1.w);
      cf[ks] = pk.v;
    }
    dsk = p.s5_d[(layer * 32 + g) * 16 + c16];
  }
  for (int sc = 0; sc < 4; ++sc) {
    const int tb = tok0 + sc * 16;
    bf16x8 uf = bf16x8{0, 0, 0, 0, 0, 0, 0, 0};
    if (quad < 2) uf = *(const bf16x8*)(p.proj + (size_t)(tb + c16) * PW + C_AU + g * 16 + quad * 8);
    float uo[FINAL ? 4 : 1];
    if constexpr (FINAL) {
#pragma unroll
      for (int r = 0; r < 4; ++r) uo[r] = bf2f(p.proj[(size_t)(tb + quad * 4 + r) * PW + C_AU + g * 16 + c16]);
    }
#pragma unroll
    for (int nt = 0; nt < 8; ++nt) {
      f32x4 acc = MFMA16(uf, bbf[nt], (f32x4{0.f, 0.f, 0.f, 0.f}));
#pragma unroll
      for (int r = 0; r < 4; ++r) bu[(quad * 4 + r) * 128 + nt * 16 + c16] = acc[r];
    }
    __syncthreads();
#pragma unroll
    for (int tt = 0; tt < 16; ++tt) {
      const float br_ = bu[tt * 128 + lane], bi_ = bu[tt * 128 + 64 + lane];
      const float nr = are * xr - aim * xi + br_;
      const float ni = are * xi + aim * xr + bi_;
      xr = nr; xi = ni;
      if constexpr (FINAL) {
        *(bf16_t*)(xsb + tt * 256 + ((((lane >> 3)) ^ tt) << 4) + (lane & 7) * 2) = f2bf(xr);
        *(bf16_t*)(xsb + tt * 256 + (((8 + (lane >> 3)) ^ tt) << 4) + (lane & 7) * 2) = f2bf(xi);
      }
    }
    if constexpr (FINAL) {
      __syncthreads();
      f32x4 y = f32x4{0.f, 0.f, 0.f, 0.f};
#pragma unroll
      for (int ks = 0; ks < 4; ++ks) {
        const bf16x8 xf = *(const bf16x8*)(xsb + c16 * 256 + (((ks * 4 + quad) ^ c16) << 4));
        y = MFMA16(xf, cf[ks], y);
      }
#pragma unroll
      for (int r = 0; r < 4; ++r) {
        const float v = y[r] + dsk * uo[r];
        p.proj[(size_t)(tb + quad * 4 + r) * PW + C_AU + g * 16 + c16] = f2bf(gelu_tanh(v));
      }
    }
    __syncthreads();
  }
  if constexpr (!FINAL) { stp[c * 128] = xr; stp[c * 128 + 64] = xi; }
}

template <bool FINAL>
DI void lru_item(const Params& p, int layer, int item, char* lds) {
  const int half = item & 1, c = (item >> 1) & 127, b = item >> 8;
  const int tid_ = opaque_tid(), lane = tid_ & 63, w = tid_ >> 6, c16 = lane & 15, quad = lane >> 4;
  const int n = half * 4 + w, ch = n * 64 + lane;
  const int l0 = c * 64, tok0 = b * SEQ + l0;
  char* xcb = lds + w * 16384;
  float* aba = (float*)(xcb + 8192);
  float* abb = aba + 1024;
  bf16x8 wf[8][2];
  {
    const float* pa = p.lru_wa + (size_t)((layer * 8 + n) * 64) * 64;
    const float* px = p.lru_wx + (size_t)((layer * 8 + n) * 64) * 64;
#pragma unroll
    for (int nt = 0; nt < 8; ++nt) {
      const float* base = ((nt < 4) ? pa : px) + (nt & 3) * 16 + c16;
#pragma unroll
      for (int ks = 0; ks < 2; ++ks) {
        union { unsigned u[4]; bf16x8 v; } pk;
#pragma unroll
        for (int jj = 0; jj < 4; ++jj) {
          const int k = ks * 32 + quad * 8 + jj * 2;
          pk.u[jj] = pack2(base[k * 64], base[(k + 1) * 64]);
        }
        wf[nt][ks] = pk.v;
      }
    }
  }
  float bav[4], bxv[4], spv[4];
#pragma unroll
  for (int nt = 0; nt < 4; ++nt) {
    const int cch = layer * 512 + n * 64 + nt * 16 + c16;
    bav[nt] = p.lru_ba[cch]; bxv[nt] = p.lru_bx[cch];
    spv[nt] = 8.f * log1pf(expf(-p.lru_lam[cch])) * 1.4426950408889634f;
  }
  {
    const float cw0 = p.conv_w[(layer * 4 + 0) * 512 + ch], cw1 = p.conv_w[(layer * 4 + 1) * 512 + ch];
    const float cw2 = p.conv_w[(layer * 4 + 2) * 512 + ch], cw3 = p.conv_w[(layer * 4 + 3) * 512 + ch];
    const float cb = p.conv_b[layer * 512 + ch];
    const bf16_t* xp = p.proj + (size_t)tok0 * PW + C_CX + ch;
    bf16_t xin[67];
#pragma unroll
    for (int t = 0; t < 3; ++t) xin[t] = (l0 + t - 3 >= 0) ? xp[(t - 3) * PW] : (bf16_t)0;
#pragma unroll
    for (int t = 3; t < 67; ++t) xin[t] = xp[(size_t)(t - 3) * PW];
#pragma unroll
    for (int t = 0; t < 64; ++t) {
      const float xc = cw0 * bf2f(xin[t]) + cw1 * bf2f(xin[t + 1]) + cw2 * bf2f(xin[t + 2]) + cw3 * bf2f(xin[t + 3]) + cb;
      *(bf16_t*)(xcb + t * 128 + (swz(t, lane >> 3) << 4) + (lane & 7) * 2) = f2bf(xc);
    }
  }
  float hst = 0.f, pr = 1.f;
  float* stp = p.lrust + ((size_t)(b * 128) * 512 + ch) * 2;
  if constexpr (FINAL) hst = stp[(size_t)c * 1024 + 1];
  __syncthreads();
  for (int sc = 0; sc < 4; ++sc) {
    float gv[FINAL ? 16 : 1];
    if constexpr (FINAL) {
      const bf16_t* gp0 = p.proj + (size_t)(tok0 + sc * 16) * PW + C_CG + ch;
#pragma unroll
      for (int t = 0; t < 16; ++t) gv[t] = bf2f(gp0[(size_t)t * PW]);
    }
    f32x4 acc[8];
#pragma unroll
    for (int nt = 0; nt < 8; ++nt) acc[nt] = f32x4{0.f, 0.f, 0.f, 0.f};
    const int arow = sc * 16 + c16;
#pragma unroll
    for (int ks = 0; ks < 2; ++ks) {
      const bf16x8 af = *(const bf16x8*)(xcb + arow * 128 + (swz(arow, ks * 4 + quad) << 4));
#pragma unroll
      for (int nt = 0; nt < 8; ++nt) acc[nt] = MFMA16(af, wf[nt][ks], acc[nt]);
    }
#pragma unroll
    for (int nt = 0; nt < 4; ++nt) {
      const int chl = nt * 16 + c16;
#pragma unroll
      for (int r = 0; r < 4; ++r) {
        const int tl = sc * 16 + quad * 4 + r;
        const float xcv = bf2f(*(const bf16_t*)(xcb + tl * 128 + (swz(tl, chl >> 3) << 4) + (chl & 7) * 2));
        const float ga = acc[nt][r] + bav[nt], gx = acc[nt + 4][r] + bxv[nt];
        const float rr = __builtin_amdgcn_rcpf(1.f + __builtin_amdgcn_exp2f(-1.4426950408889634f * ga));
        const float ig = __builtin_amdgcn_rcpf(1.f + __builtin_amdgcn_exp2f(-1.4426950408889634f * gx));
        const float la2 = -spv[nt] * rr;
        const float a = __builtin_amdgcn_exp2f(la2);
        const float y = la2 * 1.3862943611198906f;
        float q = 1.f + y * (1.f / 6.f);
        q = 1.f + y * 0.2f * q; q = 1.f + y * 0.25f * q; q = 1.f + y * (1.f / 3.f) * q; q = 1.f + y * 0.5f * q;
        const float om = (y < -0.5f) ? (1.f - a * a) : (-y * q);
        const float mult = __builtin_amdgcn_sqrtf(om);
        aba[(quad * 4 + r) * 64 + chl] = a;
        abb[(quad * 4 + r) * 64 + chl] = mult * ig * xcv;
      }
    }
    __syncthreads();
#pragma unroll
    for (int tt = 0; tt < 16; ++tt) {
      const float a = aba[tt * 64 + lane], bv = abb[tt * 64 + lane];
      hst = a * hst + bv;
      if constexpr (FINAL) p.proj[(size_t)(tok0 + sc * 16 + tt) * PW + C_CG + ch] = f2bf(hst * gv[tt]);
      else pr *= a;
    }
    __syncthreads();
  }
  if constexpr (!FINAL) { *(float2*)(stp + (size_t)c * 1024) = make_float2(pr, hst); }
}

DI void transpose_tile(const Params& p, int t, char* lds) {
  const float* src; bf16_t* dst; int K, N, kt, nt, perm = 0;
  const float* gs = nullptr;
  if (t < 5120) { int l = t / 1280, r = t % 1280; kt = r / 80; nt = r % 80; K = 1024; N = 5120; src = p.w_in + (size_t)l * K * N; dst = p.wt_in + (size_t)l * K * N; gs = p.norm_g + l * 1024; }
  else if (t < 7168) { t -= 5120; int l = t / 512, r = t % 512; kt = r / 16; nt = r % 16; K = 2048; N = 1024; src = p.w_out + (size_t)l * K * N; dst = p.wt_out + (size_t)l * K * N; }
  else if (t < 7680) { t -= 7168; int l = t / 128, r = t % 128; kt = r / 16; nt = r % 16; K = 512; N = 1024; src = p.s5_wglu + (size_t)l * K * N; dst = p.wt_glu + (size_t)l * K * N; perm = 1; }
  else { t -= 7680; int l = t / 256, r = t % 256; kt = r / 16; nt = r % 16; K = 1024; N = 1024; src = p.w_memkv + (size_t)l * K * N; dst = p.wt_mem + (size_t)l * K * N; }
  float* tile = (float*)lds;
  const int tid = opaque_tid(), ty = tid >> 4, tx = tid & 15;
  const int k0 = kt * 64, n0 = nt * 64;
#pragma unroll
  for (int i = 0; i < 4; ++i) {
    const int k = ty + 16 * i;
    const float4 v = *(const float4*)(src + (size_t)(k0 + k) * N + n0 + tx * 4);
    tile[k * 65 + tx * 4] = v.x; tile[k * 65 + tx * 4 + 1] = v.y; tile[k * 65 + tx * 4 + 2] = v.z; tile[k * 65 + tx * 4 + 3] = v.w;
  }
  __syncthreads();
  const int n = tid >> 2, kq = tid & 3;
  unsigned pk[8];
#pragma unroll
  for (int j = 0; j < 8; ++j) {
    const int kk = kq * 16 + 2 * j;
    const float s0 = gs ? gs[kt * 64 + kk] : 1.f, s1 = gs ? gs[kt * 64 + kk + 1] : 1.f;
    pk[j] = pack2(tile[kk * 65 + n] * s0, tile[(kk + 1) * 65 + n] * s1);
  }
  int row = n0 + n;
  if (perm) { const int j = row & 511; row = (j >> 5) * 64 + ((row >= 512) ? 32 : 0) + (j & 31); }
  uint4* d = (uint4*)(dst + (size_t)row * K + k0 + kq * 16);
  d[0] = make_uint4(pk[0], pk[1], pk[2], pk[3]);
  d[1] = make_uint4(pk[4], pk[5], pk[6], pk[7]);
  __syncthreads();
}

DI void phase0(const Params& p, char* lds) {
  const int tid = opaque_tid(), lane = tid & 63, w = tid >> 6;
  for (int t = blockIdx.x; t < 8704; t += gridDim.x) transpose_tile(p, t, lds);
  for (int it = blockIdx.x; it < 8192 + 1024; it += gridDim.x) {
    if (it < 8192) {
      const int row = it * 4 + w;
      const float* xr = p.x + (size_t)row * 1024;
      float4 v[4]; float ss = 0.f;
#pragma unroll
      for (int i = 0; i < 4; ++i) { v[i] = *(const float4*)(xr + i * 256 + lane * 4); ss += v[i].x * v[i].x + v[i].y * v[i].y + v[i].z * v[i].z + v[i].w * v[i].w; }
#pragma unroll
      for (int o = 32; o >= 1; o >>= 1) ss += __shfl_xor(ss, o);
#pragma unroll
      for (int i = 0; i < 4; ++i) {
        const int col = i * 256 + lane * 4;
        uint2 o; o.x = pack2(v[i].x, v[i].y); o.y = pack2(v[i].z, v[i].w);
        *(uint2*)(p.xb + (size_t)row * 1024 + col) = o;
      }
      if (lane == 0) p.rowss[row] = ss;
    } else {
      const int r = (it - 8192) * 4 + w, l = r >> 10, mr = r & 1023;
      const float* xr = p.mem + (size_t)mr * 1024;
      float4 v[4]; float ss = 0.f;
#pragma unroll
      for (int i = 0; i < 4; ++i) { v[i] = *(const float4*)(xr + i * 256 + lane * 4); ss += v[i].x * v[i].x + v[i].y * v[i].y + v[i].z * v[i].z + v[i].w * v[i].w; }
#pragma unroll
      for (int o = 32; o >= 1; o >>= 1) ss += __shfl_xor(ss, o);
      const float rs = rsqrtf(ss * (1.f / 1024.f) + 1e-6f);
#pragma unroll
      for (int i = 0; i < 4; ++i) {
        const int col = i * 256 + lane * 4;
        const float4 g = *(const float4*)(p.memng + l * 1024 + col);
        uint2 o; o.x = pack2(v[i].x * rs * g.x, v[i].y * rs * g.y); o.y = pack2(v[i].z * rs * g.z, v[i].w * rs * g.w);
        *(uint2*)(p.memn + (size_t)r * 1024 + col) = o;
      }
    }
  }
  const int gtid = blockIdx.x * 256 + tid, gstride = gridDim.x * 256;
  for (int i = gtid; i < NT * 8; i += gstride) {
    const int tok = i >> 3, f = i & 7;
    const float inv = powf(500000.f, -(float)(2 * f) / 16.f);
    const float ang = (float)p.pos[tok] * inv;
    float s, c; sincosf(ang, &s, &c);
    p.ropetab[tok * 16 + f] = c; p.ropetab[tok * 16 + 8 + f] = s;
  }
  for (int i = gtid; i < 4 * 32 * 64; i += gstride) {
    const int pp = i & 63, lg = i >> 6;
    const float dt = expf(p.s5_logdt[lg]);
    const float lr = p.s5_lre[i], li = p.s5_lim[i];
    const float mag = expf(lr * dt);
    const float are = mag * cosf(li * dt), aim = mag * sinf(li * dt);
    const float den = lr * lr + li * li;
    const float nr = are - 1.f, ni = aim;
    const float fre = (nr * lr + ni * li) / den, fim = (ni * lr - nr * li) / den;
    float* o = p.s5par + (size_t)lg * 36 * 64 + pp;
    o[0] = are; o[64] = aim;
    bf16_t* btr = p.s5bt + ((size_t)lg * 128 + pp) * 32;
    bf16_t* bti = btr + 64 * 32;
    for (int h = 0; h < 16; ++h) {
      const float br = p.s5_bre[(size_t)i * 16 + h], bi = p.s5_bim[(size_t)i * 16 + h];
      o[(2 + h) * 64] = fre * br - fim * bi;
      o[(18 + h) * 64] = fre * bi + fim * br;
      btr[h] = f2bf(fre * br - fim * bi); bti[h] = f2bf(fre * bi + fim * br);
      btr[16 + h] = 0; bti[16 + h] = 0;
    }
    float tr = are, ti = aim;
    for (int q = 0; q < 6; ++q) { const float a = tr * tr - ti * ti, bq = 2.f * tr * ti; tr = a; ti = bq; }
    o[34 * 64] = tr; o[35 * 64] = ti;
  }
  for (int i = gtid; i < 4 * NT; i += gstride) p.rowss[NT + i] = 0.f;
  if (gtid < 64) p.ctr[gtid] = 0u;
  if (gtid < 4) {
    float s1 = 0.f, s2 = 0.f;
    for (int j = 0; j < 64; ++j) { s1 += p.da_q1[gtid * 64 + j] * p.da_k1[gtid * 64 + j]; s2 += p.da_q2[gtid * 64 + j] * p.da_k2[gtid * 64 + j]; }
    p.lamv[gtid] = expf(s1) - expf(s2) + (0.8f - 0.6f * expf(-0.3f * (float)gtid));
  }
}

DI void carry_phase(const Params& p, int layer) {
  for (int it = blockIdx.x; it < 40; it += gridDim.x) {
    if (it < 32) {
      const int idx = it * 256 + threadIdx.x, b = idx >> 11, g = (idx >> 6) & 31, pp = idx & 63;
      const float* par = p.s5par + (size_t)((layer * 32 + g) * 36) * 64 + pp;
      const float tre = par[34 * 64], tim = par[35 * 64];
      float* base = p.s5st + ((size_t)((b * 32 + g) * 128)) * 128 + pp;
      float xr = 0.f, xi = 0.f;
      for (int c0 = 0; c0 < 128; c0 += 16) {
        float er[16], ei[16];
#pragma unroll
        for (int j = 0; j < 16; ++j) { er[j] = base[(c0 + j) * 128]; ei[j] = base[(c0 + j) * 128 + 64]; }
#pragma unroll
        for (int j = 0; j < 16; ++j) {
          base[(c0 + j) * 128] = xr; base[(c0 + j) * 128 + 64] = xi;
          const float nr = tre * xr - tim * xi + er[j];
          const float ni = tre * xi + tim * xr + ei[j];
          xr = nr; xi = ni;
        }
      }
    } else {
      const int idx = (it - 32) * 256 + threadIdx.x, b = idx >> 9, ch = idx & 511;
      float* base = p.lrust + ((size_t)(b * 128) * 512 + ch) * 2;
      float h = 0.f;
      for (int c0 = 0; c0 < 128; c0 += 16) {
        float2 e[16];
#pragma unroll
        for (int j = 0; j < 16; ++j) e[j] = *(const float2*)(base + (size_t)(c0 + j) * 1024);
#pragma unroll
        for (int j = 0; j < 16; ++j) {
          base[(size_t)(c0 + j) * 1024 + 1] = h;
          h = e[j].x * h + e[j].y;
        }
      }
    }
  }
}

DI bool tile_map(int i, int ncols, int& m, int& n) {
  if (gridDim.x == 512) {
    const int x = blockIdx.x & 7, j = blockIdx.x >> 3, ncg = ncols >> 3;
    m = 16 * x + 8 * (i / ncg) + (j >> 3);
    n = 8 * (i % ncg) + (j & 7);
    return i < 2 * ncg;
  }
  const int t = blockIdx.x + i * gridDim.x;
  m = t / ncols; n = t % ncols;
  return t < 128 * ncols;
}

DI int next_item(unsigned* ctr, int* sh) {
  __syncthreads();
  if (threadIdx.x == 0) *sh = (int)atomicAdd(ctr, 1u);
  __syncthreads();
  return *sh;
}

__global__ void __launch_bounds__(256, 2) hymba_forward(Params p) {
  extern __shared__ __attribute__((aligned(16))) char lds[];
  __shared__ uint4 xb_words;
  cg::grid_group grid = cg::this_grid();
  int* sh_item = (int*)(lds + 73728);
  if (threadIdx.x == 0) xb_words = make_uint4(0u, 0u, 0u, 0u);
  __syncthreads();
  XcdBarrier xb = xcd_barrier_post(p.bar, (volatile LAS unsigned*)&xb_words);
  phase0(p, lds);
  if (gridDim.x == 0x7fffffffu) grid.sync();
  xcd_barrier(xb);
  for (int layer = 0; layer < 4; ++layer) {
    {
      GemmArgs ga; ga.A = p.xb; ga.lda = 1024; ga.mix = 0; ga.Bt = p.wt_in + (size_t)layer * 5120 * 1024; ga.K = 1024;
      EpiArgs ea; ea.p = &p; ea.layer = layer; ea.rowss = p.rowss + (size_t)layer * NT; ea.xsrc = nullptr; ea.gnext = nullptr; ea.rowss_next = nullptr;
      for (int i = 0;; ++i) { int m, n; if (!tile_map(i, 40, m, n)) break; gemm_tile<EPI_INPROJ>(ga, ea, m * 256, n * 128, lds); }
      if (layer == 0) {
        for (int t = blockIdx.x; t < 128; t += gridDim.x) {
          const int lm = t >> 5, r = t & 31;
          GemmArgs gm; gm.A = p.memn + (size_t)lm * 1024 * 1024; gm.lda = 1024; gm.mix = 0; gm.Bt = p.wt_mem + (size_t)lm * 1024 * 1024; gm.K = 1024;
          EpiArgs em = ea; em.layer = lm;
          gemm_tile<EPI_MEMKV>(gm, em, (r >> 3) * 256, (r & 7) * 128, lds);
        }
      }
    }
    xcd_barrier(xb);
    {
      unsigned* ctr = p.ctr + layer * 2;
      for (;;) {
        const int it = next_item(ctr, sh_item);
        if (it >= 1024 + 4096) break;
        if (it < 1024) lru_item<false>(p, layer, it, lds);
        else s5_item<false>(p, layer, it - 1024, lds);
      }
    }
    xcd_barrier(xb);
    carry_phase(p, layer);
    xcd_barrier(xb);
    {
      unsigned* actr = p.ctr + 16 + layer * 8 + (blockIdx.x & 7);
      for (;;) {
        const int it = next_item(actr, sh_item);
        if (it >= 256) break;
        diff_attn_item(p, layer, 127 - (it >> 1), (blockIdx.x & 7) * 2 + (it & 1), lds);
      }
      unsigned* ctr = p.ctr + layer * 2 + 1;
      for (;;) {
        const int it = next_item(ctr, sh_item);
        if (it >= 1024 + 4096 + 2048) break;
        if (it < 1024) lru_item<true>(p, layer, it, lds);
        else if (it < 5120) s5_item<true>(p, layer, it - 1024, lds);
        else mem_attn_item(p, layer, it - 5120, lds);
      }
    }
    xcd_barrier(xb);
    {
      GemmArgs ga; ga.A = p.proj + C_AU; ga.lda = PW; ga.mix = 0; ga.Bt = p.wt_glu + (size_t)layer * 1024 * 512; ga.K = 512;
      EpiArgs ea; ea.p = &p; ea.layer = layer; ea.rowss = nullptr; ea.xsrc = nullptr; ea.gnext = nullptr; ea.rowss_next = nullptr;
      for (int i = 0;; ++i) { int m, n; if (!tile_map(i, 8, m, n)) break; gemm_tile<EPI_GLU>(ga, ea, m * 256, n * 128, lds); }
    }
    xcd_barrier(xb);
    {
      GemmArgs ga; ga.A = p.proj; ga.lda = PW; ga.mix = 1; ga.Bt = p.wt_out + (size_t)layer * 1024 * 2048; ga.K = 2048;
      EpiArgs ea; ea.p = &p; ea.layer = layer; ea.rowss = nullptr;
      ea.xsrc = (layer == 0) ? p.x : nullptr;
      ea.gnext = (layer < 3) ? (p.norm_g + (layer + 1) * 1024) : nullptr;
      ea.rowss_next = p.rowss + (size_t)(layer + 1) * NT;
      for (int i = 0;; ++i) { int m, n; if (!tile_map(i, 8, m, n)) break; gemm_tile<EPI_OUT>(ga, ea, m * 256, n * 128, lds); }
    }
    xcd_barrier(xb);
  }
  {
    const float* rss = p.rowss + (size_t)4 * NT;
    const size_t n4 = (size_t)NT * 256;
    for (size_t i = (size_t)blockIdx.x * 256 + threadIdx.x; i < n4; i += (size_t)gridDim.x * 256) {
      const int row = (int)(i >> 8), c4 = (int)(i & 255) * 4;
      const float rs = rsqrtf(rss[row] * (1.f / 1024.f) + 1e-6f);
      float4 v = *(float4*)(p.out + i * 4);
      const float4 g = *(const float4*)(p.fng + c4);
      v.x *= rs * g.x; v.y *= rs * g.y; v.z *= rs * g.z; v.w *= rs * g.w;
      *(float4*)(p.out + i * 4) = v;
    }
  }
}

extern "C" void kernel_launch(void* const* d_in, const int* in_sizes, int n_in, void* d_out, int out_size, void* d_ws,
                              size_t ws_size, hipStream_t stream) {
  Params p{};
  p.x = (const float*)d_in[0]; p.mem = (const float*)d_in[1]; p.pos = (const int*)d_in[2];
  p.norm_g = (const float*)d_in[3]; p.w_in = (const float*)d_in[4]; p.w_out = (const float*)d_in[5];
  p.s5_lre = (const float*)d_in[6]; p.s5_lim = (const float*)d_in[7]; p.s5_logdt = (const float*)d_in[8];
  p.s5_bre = (const float*)d_in[9]; p.s5_bim = (const float*)d_in[10]; p.s5_cre = (const float*)d_in[11];
  p.s5_cim = (const float*)d_in[12]; p.s5_d = (const float*)d_in[13]; p.s5_wglu = (const float*)d_in[14];
  p.da_q1 = (const float*)d_in[15]; p.da_k1 = (const float*)d_in[16]; p.da_q2 = (const float*)d_in[17];
  p.da_k2 = (const float*)d_in[18]; p.da_g = (const float*)d_in[19];
  p.conv_w = (const float*)d_in[20]; p.conv_b = (const float*)d_in[21]; p.lru_wa = (const float*)d_in[22];
  p.lru_ba = (const float*)d_in[23]; p.lru_wx = (const float*)d_in[24]; p.lru_bx = (const float*)d_in[25];
  p.lru_lam = (const float*)d_in[26]; p.memng = (const float*)d_in[27]; p.w_memkv = (const float*)d_in[28];
  p.fng = (const float*)d_in[29];
  p.out = (float*)d_out;
  char* ws = (char*)d_ws; size_t off = 0;
  auto take = [&](size_t bytes) { char* r = ws + off; off += (bytes + 255) & ~(size_t)255; return r; };
  p.proj = (bf16_t*)take((size_t)NT * PW * 2);
  p.vt = (bf16_t*)take((size_t)NT * 512 * 2);
  p.xb = (bf16_t*)take((size_t)NT * 1024 * 2);
  p.wt_in = (bf16_t*)take((size_t)4 * 5120 * 1024 * 2);
  p.wt_out = (bf16_t*)take((size_t)4 * 1024 * 2048 * 2);
  p.wt_glu = (bf16_t*)take((size_t)4 * 1024 * 512 * 2);
  p.wt_mem = (bf16_t*)take((size_t)4 * 1024 * 1024 * 2);
  p.memn = (bf16_t*)take((size_t)4 * 1024 * 1024 * 2);
  p.memk = (bf16_t*)take((size_t)4 * 1024 * 512 * 2);
  p.memvt = (bf16_t*)take((size_t)4 * 1024 * 512 * 2);
  p.rowss = (float*)take((size_t)5 * NT * 4);
  p.ropetab = (float*)take((size_t)NT * 16 * 4);
  p.s5par = (float*)take((size_t)4 * 32 * 36 * 64 * 4);
  p.s5st = (float*)take((size_t)4 * 32 * 128 * 128 * 4);
  p.lrust = (float*)take((size_t)4 * 128 * 512 * 2 * 4);
  p.lamv = (float*)take(256);
  p.s5bt = (bf16_t*)take((size_t)4 * 32 * 128 * 32 * 2);
  p.ctr = (unsigned*)take(1024);
  p.bar = (unsigned*)take((size_t)XCD_BAR_WORDS * 4);
  if (off > ws_size) { fprintf(stderr, "workspace too small: need %zu have %zu\n", off, ws_size); return; }
  static int grid_blocks = 0;
  if (!grid_blocks) {
    int dev = 0, cus = 0, per_cu = 0;
    hipGetDevice(&dev);
    hipDeviceGetAttribute(&cus, hipDeviceAttributeMultiprocessorCount, dev);
    hipFuncSetAttribute((const void*)hymba_forward, hipFuncAttributeMaxDynamicSharedMemorySize, LDS_BYTES);
    hipOccupancyMaxActiveBlocksPerMultiprocessor(&per_cu, hymba_forward, 256, LDS_BYTES);
    if (per_cu < 1) per_cu = 1;
    if (per_cu > 2) per_cu = 2;
    grid_blocks = cus * per_cu;
  }
  hipMemsetAsync(p.bar, 0, (size_t)XCD_BAR_WORDS * 4, stream);
  void* args[] = {&p};
  hipError_t e = hipLaunchCooperativeKernel((const void*)hymba_forward, dim3(grid_blocks), dim3(256), args, LDS_BYTES, stream);
  if (e != hipSuccess) fprintf(stderr, "cooperative launch failed: %s (grid %d)\n", hipGetErrorString(e), grid_blocks);
}
```

```cpp
#include <hip/hip_runtime.h>
#include <hip/hip_cooperative_groups.h>
#include <cstdio>
namespace cg = cooperative_groups;

typedef unsigned short bf16_t;
typedef __attribute__((ext_vector_type(8))) short bf16x8;
typedef __attribute__((ext_vector_type(4))) short s16x4;
typedef __attribute__((ext_vector_type(4))) float f32x4;

#define DI __device__ __forceinline__
#define MFMA16(a, b, c) __builtin_amdgcn_mfma_f32_16x16x32_bf16((a), (b), (c), 0, 0, 0)

constexpr int NT = 32768;
constexpr int SEQ = 8192;
constexpr int PW = 4608;
constexpr int C_AU = 0, C_AG = 512, C_Q = 1024, C_K = 1536, C_BG = 2048, C_CX = 2560, C_CG = 3072, C_MQ = 3584, C_MG = 4096;
constexpr int LDS_BYTES = 73728 + 64 + 1024;

struct Params {
  const float *x, *mem; const int* pos;
  const float *norm_g, *w_in, *w_out, *s5_lre, *s5_lim, *s5_logdt, *s5_bre, *s5_bim, *s5_cre, *s5_cim, *s5_d, *s5_wglu;
  const float *da_q1, *da_k1, *da_q2, *da_k2, *da_g;
  const float *conv_w, *conv_b, *lru_wa, *lru_ba, *lru_wx, *lru_bx, *lru_lam, *memng, *w_memkv, *fng;
  float* out;
  bf16_t *proj, *vt, *xb, *wt_in, *wt_out, *wt_glu, *wt_mem, *memn, *memk, *memvt;
  float *rowss, *ropetab, *s5par, *s5st, *lrust, *lamv;
  bf16_t* s5bt;
  unsigned* ctr;
  unsigned* bar;
};

typedef __bf16 bf2_t __attribute__((ext_vector_type(2)));
typedef float f2_t __attribute__((ext_vector_type(2)));
DI unsigned pack2(float a, float b) { f2_t v = {a, b}; return __builtin_bit_cast(unsigned, __builtin_convertvector(v, bf2_t)); }
DI bf16_t f2bf(float x) { return (bf16_t)(pack2(x, 0.f) & 0xffffu); }
DI float bf2f(bf16_t h) { return __uint_as_float(((unsigned)h) << 16); }
DI float sigmoidf_(float x) { return 1.f / (1.f + __expf(-x)); }
DI float siluf_(float x) { return x / (1.f + __expf(-x)); }
DI int opaque_tid() { int t = threadIdx.x; asm volatile("" : "+v"(t)); return t; }
DI float quadmax(float x) {
  auto r = __builtin_amdgcn_permlane16_swap(__float_as_uint(x), __float_as_uint(x), false, false);
  const float m = fmaxf(__uint_as_float(r[0]), __uint_as_float(r[1]));
  auto q = __builtin_amdgcn_permlane32_swap(__float_as_uint(m), __float_as_uint(m), false, false);
  return fmaxf(__uint_as_float(q[0]), __uint_as_float(q[1]));
}
DI float quadsum(float x) {
  auto r = __builtin_amdgcn_permlane16_swap(__float_as_uint(x), __float_as_uint(x), false, false);
  const float m = __uint_as_float(r[0]) + __uint_as_float(r[1]);
  auto q = __builtin_amdgcn_permlane32_swap(__float_as_uint(m), __float_as_uint(m), false, false);
  return __uint_as_float(q[0]) + __uint_as_float(q[1]);
}
DI float sum16(const float* base, int row) { float t = 0.f;
#pragma unroll
  for (int k = 0; k < 16; ++k) t += base[(size_t)k * NT + row];
  return t; }
DI int swz(int row, int c) { return c ^ ((row >> 1) & 7); }

#define XB_TMO      128
#define XB_XCNT(j)  (256  + 64 * (j))
#define XB_XSUB(j)  (1280 + 64 * (j))
#define XB_XGEN(j)  (2304 + 64 * (j))
#define XB_TOP      3328
#define XB_TOPGEN   3392
#define XCD_BAR_WORDS 3456
#define XB_SPIN_CAP (1u << 18)
#define LAS __attribute__((address_space(3)))

__device__ __forceinline__ unsigned xb_ld(unsigned* p)              { return __hip_atomic_load(p, __ATOMIC_RELAXED, __HIP_MEMORY_SCOPE_AGENT); }
__device__ __forceinline__ unsigned xb_add(unsigned* p, unsigned v) { return __hip_atomic_fetch_add(p, v, __ATOMIC_RELAXED, __HIP_MEMORY_SCOPE_AGENT); }
__device__ __forceinline__ unsigned xb_xcc_id() { return (unsigned)__builtin_amdgcn_s_getreg((3 << 11) | 20) & 0xFu; }
#define XB_SPIN(cond, bar) do { unsigned _sp = 0; while (cond) { __builtin_amdgcn_s_sleep(1); \
    if ((++_sp & 255u) == 0u) { if (xb_ld(&(bar)[XB_TMO])) break; if (_sp > XB_SPIN_CAP) { atomicAdd(&(bar)[XB_TMO], 1u); break; } } } } while (0)

struct XcdBarrier {
    unsigned* bar; unsigned x;
    volatile LAS unsigned* st;
};

__device__ __forceinline__ XcdBarrier xcd_barrier_post(unsigned* bar, volatile LAS unsigned* st) {
    XcdBarrier b; b.bar = bar; b.x = xb_xcc_id(); b.st = st;
    if (threadIdx.x == 0) (void)xb_add(&bar[XB_XCNT(b.x)], 1u);
    return b;
}
__device__ __forceinline__ void xcd_barrier_complete(unsigned* bar, unsigned x, unsigned& nloc, unsigned& nx) {
    const unsigned G = gridDim.x * gridDim.y * gridDim.z;
    unsigned sum, cnt, mine, sp = 0u;
    for (;;) {
        sum = 0u; cnt = 0u; mine = 0u;
#pragma unroll
        for (unsigned j = 0; j < 16; ++j) { const unsigned c = xb_ld(&bar[XB_XCNT(j)]); sum += c; cnt += (c > 0u) ? 1u : 0u; mine = (j == x) ? c : mine; }
        if (sum == G) break;
        __builtin_amdgcn_s_sleep(1);
        if ((++sp & 255u) == 0u) { if (xb_ld(&bar[XB_TMO])) break; if (sp > XB_SPIN_CAP) { atomicAdd(&bar[XB_TMO], 1u); break; } }
    }
    nloc = mine > 0u ? mine : 1u; nx = cnt > 0u ? cnt : 1u;
}

__device__ __forceinline__ void xcd_barrier(const XcdBarrier& b) {
    asm volatile("s_waitcnt vmcnt(0)" ::: "memory");
    __syncthreads();
    if (threadIdx.x == 0) {
        unsigned* bar = b.bar;
        __builtin_amdgcn_s_waitcnt(0);
        unsigned nloc = b.st[0], nx = b.st[1];
        if (nloc == 0u) { xcd_barrier_complete(bar, b.x, nloc, nx); b.st[0] = nloc; b.st[1] = nx; }
        const unsigned old = xb_add(&bar[XB_XSUB(b.x)], 1u);
        const unsigned gen = old / nloc;
        if (old + 1u == (gen + 1u) * nloc) {
            __builtin_amdgcn_fence(__ATOMIC_RELEASE, "agent");
            asm volatile("s_waitcnt vmcnt(0)" ::: "memory");
            const unsigned og = xb_add(&bar[XB_TOP], 1u);
            const unsigned tg = og / nx;
            if (og + 1u == (tg + 1u) * nx) xb_add(&bar[XB_TOPGEN], 1u);
            else XB_SPIN(xb_ld(&bar[XB_TOPGEN]) == tg, bar);
            __builtin_amdgcn_fence(__ATOMIC_ACQUIRE, "agent");
            xb_add(&bar[XB_XGEN(b.x)], 1u);
            asm volatile("s_waitcnt vmcnt(0)" ::: "memory");
        } else {
            XB_SPIN(xb_ld(&bar[XB_XGEN(b.x)]) == gen, bar);
            __builtin_amdgcn_fence(__ATOMIC_ACQUIRE, "agent");
            asm volatile("s_waitcnt vmcnt(0)" ::: "memory");
        }
    }
    __syncthreads();
}


struct GemmArgs {
  const bf16_t* A; int lda; int mix;
  const bf16_t* Bt; int K;
};
DI int mixcol(int k0) { int g = k0 >> 9; int s = (g == 0) ? C_AG : (g == 1) ? C_BG : (g == 2) ? C_CG : C_MG; return s + (k0 & 511); }

enum { EPI_INPROJ = 0, EPI_MEMKV = 1, EPI_GLU = 2, EPI_OUT = 3 };

struct EpiArgs {
  const Params* p; int layer;
  const float* rowss;
  const float* xsrc;
  const float* gnext;
  float* rowss_next;
};

DI int swz64(int row, int c) { return c ^ ((0x1320 >> (((row >> 2) & 3) * 4)) & 3); }

template <int EPI>
DI void gemm_tile(const GemmArgs& ga, const EpiArgs& ea, int m0, int n0, char* lds) {
  const int tid = opaque_tid(), lane = tid & 63, w = tid >> 6;
  const int wm = w >> 1, wn = w & 1, c16 = lane & 15, quad = lane >> 4;
  f32x4 acc[8][4];
#pragma unroll
  for (int i = 0; i < 8; ++i)
#pragma unroll
    for (int j = 0; j < 4; ++j) acc[i][j] = f32x4{0.f, 0.f, 0.f, 0.f};
  const int K = ga.K, nk = K >> 5;
  float rowsum = 0.f;
  if constexpr (EPI == EPI_INPROJ) rowsum = sum16(ea.rowss, m0 + tid);
  const int prow = lane >> 2, pch = lane & 3;
  const bf16_t* gsrc[6];
  int ldsoff[6];
#pragma unroll
  for (int i = 0; i < 6; ++i) {
    const int pi = w * 6 + i;
    if (pi < 16) {
      const int row = pi * 16 + prow;
      gsrc[i] = ga.A + (size_t)(m0 + row) * ga.lda + swz64(row, pch) * 8;
      ldsoff[i] = pi * 1024 + lane * 16;
    } else {
      const int row = (pi - 16) * 16 + prow;
      gsrc[i] = ga.Bt + (size_t)(n0 + row) * K + swz64(row, pch) * 8;
      ldsoff[i] = pi * 1024 + lane * 16;
    }
  }
  auto dma = [&](int kt, int buf) {
    const int k0 = kt << 5;
    const int ac = ga.mix ? mixcol(k0) : k0;
    char* base = lds + buf * 24576;
#pragma unroll
    for (int i = 0; i < 6; ++i) {
      const int pi = w * 6 + i;
      __builtin_amdgcn_global_load_lds((const unsigned*)(gsrc[i] + ((pi < 16) ? ac : k0)), (unsigned*)(base + ldsoff[i]), 16, 0, 0);
    }
  };
  __syncthreads();
  dma(0, 0);
  if (nk > 1) dma(1, 1);
  for (int kt = 0; kt < nk; ++kt) {
    if (kt + 1 < nk) asm volatile("s_waitcnt vmcnt(6)" ::: "memory");
    else asm volatile("s_waitcnt vmcnt(0)" ::: "memory");
    __builtin_amdgcn_s_barrier();
    const char* Ab = lds + (kt % 3) * 24576 + wm * 128 * 64;
    const char* Bb = lds + (kt % 3) * 24576 + 16384 + wn * 64 * 64;
    bf16x8 af[8], bfr[4];
    const int ch = swz64(c16, quad) << 4;
#pragma unroll
    for (int nt = 0; nt < 4; ++nt) bfr[nt] = *(const bf16x8*)(Bb + (nt * 16 + c16) * 64 + ch);
#pragma unroll
    for (int mt = 0; mt < 2; ++mt) af[mt] = *(const bf16x8*)(Ab + (mt * 16 + c16) * 64 + ch);
    __builtin_amdgcn_sched_barrier(0);
    if (kt + 2 < nk) dma(kt + 2, (kt + 2) % 3);
    __builtin_amdgcn_sched_barrier(0);
#pragma unroll
    for (int g = 0; g < 4; ++g) {
      if (g < 3) {
#pragma unroll
        for (int mt = 2 * g + 2; mt < 2 * g + 4; ++mt) af[mt] = *(const bf16x8*)(Ab + (mt * 16 + c16) * 64 + ch);
      }
#pragma unroll
      for (int mt = 2 * g; mt < 2 * g + 2; ++mt)
#pragma unroll
        for (int nt = 0; nt < 4; ++nt) acc[mt][nt] = MFMA16(bfr[nt], af[mt], acc[mt][nt]);
      __builtin_amdgcn_sched_barrier(0);
    }
  }
  const Params& p = *ea.p;
  if constexpr (EPI == EPI_INPROJ) {
    const int slot = n0 >> 9;
    const int dbase = (slot < 4) ? slot * 512 : (slot - 1) * 512;
    float* rsc = (float*)(lds + 73728 + 64);
    rsc[tid] = rsqrtf(rowsum * (1.f / 1024.f) + 1e-6f);
    __syncthreads();
#pragma unroll
    for (int mt = 0; mt < 8; ++mt) {
      const int row = m0 + wm * 128 + mt * 16 + c16;
      const float rs = rsc[wm * 128 + mt * 16 + c16];
#pragma unroll
      for (int nt = 0; nt < 4; ++nt) {
        const int cc0 = (n0 & 511) + wn * 64 + nt * 16 + quad * 4;
        float v[4];
#pragma unroll
        for (int r = 0; r < 4; ++r) v[r] = acc[mt][nt][r] * rs;
        if (slot == 4) {
          const int b = row >> 13, l = row & 8191, h = cc0 >> 7, dv0 = cc0 & 127;
          const int lp = (l & ~31) | (((l >> 2) & 3) << 3) | (((l >> 4) & 1) << 2) | (l & 3);
#pragma unroll
          for (int r = 0; r < 4; ++r) p.vt[((size_t)((b * 4 + h) * 128 + dv0 + r)) * SEQ + lp] = f2bf(v[r]);
        } else {
          if (slot == 2 || slot == 3) {
            if (nt == 0) {
              const float* cs = p.ropetab + (size_t)row * 16 + (quad & 1) * 4;
              const float4 co = *(const float4*)cs, si = *(const float4*)(cs + 8);
              const float cov[4] = {co.x, co.y, co.z, co.w}, siv[4] = {si.x, si.y, si.z, si.w};
#pragma unroll
              for (int r = 0; r < 4; ++r) {
                const float pr = __shfl_xor(v[r], 32);
                v[r] = (quad < 2) ? (v[r] * cov[r] - pr * siv[r]) : (v[r] * cov[r] + pr * siv[r]);
              }
            }
            if (slot == 2) {
#pragma unroll
              for (int r = 0; r < 4; ++r) v[r] *= 0.18033688011112042f;
            }
          } else if (slot == 1 || slot == 5 || slot == 7 || slot == 9) {
#pragma unroll
            for (int r = 0; r < 4; ++r) v[r] = siluf_(v[r]);
          } else if (slot == 8) {
#pragma unroll
            for (int r = 0; r < 4; ++r) v[r] *= 0.12751743082459868f;
          }
          uint2 pk; pk.x = pack2(v[0], v[1]); pk.y = pack2(v[2], v[3]);
          *(uint2*)(p.proj + (size_t)row * PW + dbase + cc0) = pk;
        }
      }
    }
  } else if constexpr (EPI == EPI_MEMKV) {
    const int lm = ea.layer;
#pragma unroll
    for (int mt = 0; mt < 8; ++mt) {
      const int row = m0 + wm * 128 + mt * 16 + c16;
#pragma unroll
      for (int nt = 0; nt < 4; ++nt) {
        const int col0 = n0 + wn * 64 + nt * 16 + quad * 4;
        if (col0 < 512) {
          uint2 pk; pk.x = pack2(acc[mt][nt][0], acc[mt][nt][1]); pk.y = pack2(acc[mt][nt][2], acc[mt][nt][3]);
          *(uint2*)(p.memk + ((size_t)lm * 1024 + row) * 512 + col0) = pk;
        } else {
          const int cc0 = col0 - 512, h = cc0 >> 7, dv0 = cc0 & 127, b = row >> 8, m = row & 255;
          const int mp = (m & ~31) | (((m >> 2) & 3) << 3) | (((m >> 4) & 1) << 2) | (m & 3);
#pragma unroll
          for (int r = 0; r < 4; ++r) p.memvt[((size_t)((lm * 4 + b) * 4 + h) * 128 + dv0 + r) * 256 + mp] = f2bf(acc[mt][nt][r]);
        }
      }
    }
  } else if constexpr (EPI == EPI_GLU) {
    const int blk = (n0 + wn * 64) >> 6;
#pragma unroll
    for (int mt = 0; mt < 8; ++mt) {
      const int row = m0 + wm * 128 + mt * 16 + c16;
#pragma unroll
      for (int nt = 0; nt < 2; ++nt) {
        const int j0 = blk * 32 + nt * 16 + quad * 4;
        uint2* q = (uint2*)(p.proj + (size_t)row * PW + C_AG + j0);
        const uint2 gv = *q;
        const float g0 = __uint_as_float(gv.x << 16), g1 = __uint_as_float(gv.x & 0xffff0000u);
        const float g2 = __uint_as_float(gv.y << 16), g3 = __uint_as_float(gv.y & 0xffff0000u);
        uint2 o;
        o.x = pack2(acc[mt][nt][0] * sigmoidf_(acc[mt][nt + 2][0]) * g0, acc[mt][nt][1] * sigmoidf_(acc[mt][nt + 2][1]) * g1);
        o.y = pack2(acc[mt][nt][2] * sigmoidf_(acc[mt][nt + 2][2]) * g2, acc[mt][nt][3] * sigmoidf_(acc[mt][nt + 2][3]) * g3);
        *q = o;
      }
    }
  } else {
#pragma unroll
    for (int mt = 0; mt < 8; ++mt) {
      const int row = m0 + wm * 128 + mt * 16 + c16;
      float ss = 0.f;
#pragma unroll
      for (int nt = 0; nt < 4; ++nt) {
        const int col0 = n0 + wn * 64 + nt * 16 + quad * 4;
        const size_t idx = (size_t)row * 1024 + col0;
        float4 xo;
        if (ea.xsrc) xo = *(const float4*)(ea.xsrc + idx);
        else {
          const uint2 u = *(const uint2*)(p.xb + idx);
          xo = make_float4(__uint_as_float(u.x << 16), __uint_as_float(u.x & 0xffff0000u), __uint_as_float(u.y << 16), __uint_as_float(u.y & 0xffff0000u));
        }
        float4 xn;
        xn.x = xo.x + acc[mt][nt][0]; xn.y = xo.y + acc[mt][nt][1]; xn.z = xo.z + acc[mt][nt][2]; xn.w = xo.w + acc[mt][nt][3];
        ss += xn.x * xn.x + xn.y * xn.y + xn.z * xn.z + xn.w * xn.w;
        {
          uint2 o; o.x = pack2(xn.x, xn.y); o.y = pack2(xn.z, xn.w);
          *(uint2*)(p.xb + idx) = o;
        }
      }
      ss = quadsum(ss);
      if (quad == 0) ea.rowss_next[(size_t)((n0 >> 7) * 2 + wn) * NT + row] = ss;
    }
  }
}

template <int NS, int QT>
struct AttnState {
  f32x4 O[NS][8][QT];
  float l[NS][QT];
};

template <int NS, int QT>
DI void attn_core(AttnState<NS, QT>& st, const bf16_t* qp, int qstride, const bf16_t* kp, int kstride,
                          const bf16_t* vtp, int vtstride, int nkt, int qpos0, bool causal, char* lds) {
  const int tid = opaque_tid(), lane = tid & 63, w = tid >> 6, c16 = lane & 15, quad = lane >> 4;
  bf16x8 qf[QT][4];
#pragma unroll
  for (int qt = 0; qt < QT; ++qt)
#pragma unroll
    for (int f = 0; f < 4; ++f)
      qf[qt][f] = *(const bf16x8*)(qp + (size_t)(w * 16 * QT + qt * 16 + c16) * qstride + f * 32 + quad * 8);
  float m[NS][QT];
#pragma unroll
  for (int s = 0; s < NS; ++s)
#pragma unroll
    for (int qt = 0; qt < QT; ++qt) {
      m[s][qt] = 0.f; st.l[s][qt] = 0.f;
#pragma unroll
      for (int d = 0; d < 8; ++d) st.O[s][d][qt] = f32x4{0.f, 0.f, 0.f, 0.f};
    }
  const int prow = lane >> 3, pch = lane & 7;
  unsigned koff[4], voff[4];
#pragma unroll
  for (int i = 0; i < 4; ++i) {
    const int pi = w * 4 + i;
    { const int row = (pi & 7) * 8 + prow, sub = pi >> 3, c = pch ^ ((row >> 1) & 7);
      koff[i] = (unsigned)((row * kstride + sub * 64 + c * 8) * 2); }
    { const int row = pi * 8 + prow, c = pch ^ ((row >> 1) & 7);
      voff[i] = (unsigned)((row * vtstride + c * 8) * 2); }
  }
  auto gload = [&](int kt, int buf) {
    char* base = lds + buf * 32768;
    const char* kt_base = (const char*)(kp + (size_t)kt * 64 * kstride);
    const char* vt_base = (const char*)(vtp + (size_t)kt * 64);
#pragma unroll
    for (int i = 0; i < 4; ++i)
      __builtin_amdgcn_global_load_lds((const unsigned*)(kt_base + koff[i]), (unsigned*)(base + (w * 4 + i) * 1024 + lane * 16), 16, 0, 0);
#pragma unroll
    for (int i = 0; i < 4; ++i)
      __builtin_amdgcn_global_load_lds((const unsigned*)(vt_base + voff[i]), (unsigned*)(base + 16384 + (w * 4 + i) * 1024 + lane * 16), 16, 0, 0);
  };
  const int qw0 = qpos0 + w * 16 * QT;
  gload(0, 0); __syncthreads();
  for (int kt = 0; kt < nkt; ++kt) {
    if (kt + 1 < nkt) gload(kt + 1, (kt + 1) & 1);
    const char* Kb = lds + (kt & 1) * 32768;
    const char* Vb = Kb + 16384;
    const bool active = !causal || (kt * 64 <= qw0 + 16 * QT - 1);
    if (active) {
      const bool need_mask = causal && (kt * 64 + 63 > qw0);
      bf16x8 pf[NS][2][QT];
      f32x4 S[NS][4][QT];
#pragma unroll
      for (int s = 0; s < NS; ++s)
#pragma unroll
        for (int a = 0; a < 4; ++a)
#pragma unroll
          for (int qt = 0; qt < QT; ++qt) { const float nm = -m[s][qt]; S[s][a][qt] = f32x4{nm, nm, nm, nm}; }
      bf16x8 kfa[8], kfb[8], vfa[8], vfb[8];
#pragma unroll
      for (int i = 0; i < 8; ++i) {
        const int ksub = i & 3, row = ksub * 16 + c16, chunk = (i >> 2) * 4 + quad;
        kfa[i] = *(const bf16x8*)(Kb + row * 128 + (swz(row, chunk) << 4));
      }
      __builtin_amdgcn_sched_barrier(0);
#pragma unroll
      for (int i = 0; i < 8; ++i) {
        const int ksub = i & 3, row = ksub * 16 + c16, chunk = (i >> 2) * 4 + quad;
        kfb[i] = *(const bf16x8*)(Kb + 8192 + row * 128 + (swz(row, chunk) << 4));
      }
#pragma unroll
      for (int i = 0; i < 8; ++i)
#pragma unroll
        for (int qt = 0; qt < QT; ++qt) S[0][i & 3][qt] = MFMA16(kfa[i], qf[qt][i >> 2], S[0][i & 3][qt]);
      __builtin_amdgcn_sched_barrier(0);
#pragma unroll
      for (int d = 0; d < 8; ++d) {
        const int row = d * 16 + c16;
        vfa[d] = *(const bf16x8*)(Vb + row * 128 + (swz(row, quad) << 4));
      }
#pragma unroll
      for (int i = 0; i < 8; ++i)
#pragma unroll
        for (int qt = 0; qt < QT; ++qt) S[NS - 1][i & 3][qt] = MFMA16(kfb[i], qf[qt][2 + (i >> 2)], S[NS - 1][i & 3][qt]);
      if (need_mask) {
#pragma unroll
        for (int s = 0; s < NS; ++s)
#pragma unroll
          for (int ksub = 0; ksub < 4; ++ksub)
#pragma unroll
            for (int qt = 0; qt < QT; ++qt)
#pragma unroll
              for (int r = 0; r < 4; ++r) {
                const int key = kt * 64 + ksub * 16 + quad * 4 + r;
                const int qpos = qw0 + qt * 16 + c16;
                if (key > qpos) S[s][ksub][qt][r] = -1e30f;
              }
      }
      float mx[NS][QT];
      bool need = false;
#pragma unroll
      for (int s = 0; s < NS; ++s)
#pragma unroll
        for (int qt = 0; qt < QT; ++qt) {
          float v = -1e30f;
#pragma unroll
          for (int ksub = 0; ksub < 4; ++ksub)
#pragma unroll
            for (int r = 0; r < 4; ++r) v = fmaxf(v, S[s][ksub][qt][r]);
          v = quadmax(v);
          mx[s][qt] = v;
          need = need || (v > 8.f);
        }
      if (__any(need) || kt == 0) {
#pragma unroll
        for (int s = 0; s < NS; ++s)
#pragma unroll
          for (int qt = 0; qt < QT; ++qt) {
            const float delta = (kt == 0) ? mx[s][qt] : fmaxf(mx[s][qt], 0.f);
            const float alpha = (kt == 0) ? 1.f : __builtin_amdgcn_exp2f(-delta);
            m[s][qt] += delta;
            st.l[s][qt] *= alpha;
#pragma unroll
            for (int d = 0; d < 8; ++d) st.O[s][d][qt] *= alpha;
#pragma unroll
            for (int ksub = 0; ksub < 4; ++ksub)
#pragma unroll
              for (int r = 0; r < 4; ++r) S[s][ksub][qt][r] -= delta;
          }
      }
#pragma unroll
      for (int s = 0; s < NS; ++s)
#pragma unroll
        for (int qt = 0; qt < QT; ++qt) {
          float psum = 0.f;
#pragma unroll
          for (int ksub = 0; ksub < 4; ++ksub)
#pragma unroll
            for (int r = 0; r < 4; ++r) { const float e = __builtin_amdgcn_exp2f(S[s][ksub][qt][r]); S[s][ksub][qt][r] = e; psum += e; }
          st.l[s][qt] += psum;
#pragma unroll
          for (int kk = 0; kk < 2; ++kk) {
            union { unsigned u[4]; bf16x8 v; } pk;
            pk.u[0] = pack2(S[s][2 * kk][qt][0], S[s][2 * kk][qt][1]);
            pk.u[1] = pack2(S[s][2 * kk][qt][2], S[s][2 * kk][qt][3]);
            pk.u[2] = pack2(S[s][2 * kk + 1][qt][0], S[s][2 * kk + 1][qt][1]);
            pk.u[3] = pack2(S[s][2 * kk + 1][qt][2], S[s][2 * kk + 1][qt][3]);
            pf[s][kk][qt] = pk.v;
          }
        }
      __builtin_amdgcn_sched_barrier(0);
#pragma unroll
      for (int d = 0; d < 8; ++d) {
        const int row = d * 16 + c16;
        vfb[d] = *(const bf16x8*)(Vb + row * 128 + (swz(row, 4 + quad) << 4));
      }
#pragma unroll
      for (int d = 0; d < 8; ++d)
#pragma unroll
        for (int s = 0; s < NS; ++s)
#pragma unroll
          for (int qt = 0; qt < QT; ++qt) st.O[s][d][qt] = MFMA16(vfa[d], pf[s][0][qt], st.O[s][d][qt]);
      __builtin_amdgcn_sched_barrier(0);
#pragma unroll
      for (int d = 0; d < 8; ++d)
#pragma unroll
        for (int s = 0; s < NS; ++s)
#pragma unroll
          for (int qt = 0; qt < QT; ++qt) st.O[s][d][qt] = MFMA16(vfb[d], pf[s][1][qt], st.O[s][d][qt]);
    }
    __syncthreads();
  }
#pragma unroll
  for (int s = 0; s < NS; ++s)
#pragma unroll
    for (int qt = 0; qt < QT; ++qt) {
      st.l[s][qt] = quadsum(st.l[s][qt]);
    }
}

DI void diff_attn_item(const Params& p, int layer, int qb, int bh, char* lds) {
  const int b = bh >> 2, h = bh & 3;
  const int tok0 = b * SEQ + qb * 64;
  const int tid_ = opaque_tid(), lane = tid_ & 63, w = tid_ >> 6, c16 = lane & 15, quad = lane >> 4;
  const int sidx = w & 1, g = w >> 1;
  const bf16_t* qp = p.proj + (size_t)tok0 * PW + C_Q + h * 128;
  const bf16_t* kp = p.proj + (size_t)b * SEQ * PW + C_K + h * 128;
  const bf16_t* vtp = p.vt + (size_t)((b * 4 + h) * 128) * SEQ;
  const int nkt = qb + 1;
  bf16x8 qf[2][2];
#pragma unroll
  for (int qt = 0; qt < 2; ++qt)
#pragma unroll
    for (int ff = 0; ff < 2; ++ff)
      qf[qt][ff] = *(const bf16x8*)(qp + (size_t)(g * 32 + qt * 16 + c16) * PW + (sidx * 2 + ff) * 32 + quad * 8);
  float m[2], l[2];
  f32x4 O[8][2];
#pragma unroll
  for (int qt = 0; qt < 2; ++qt) {
    m[qt] = 0.f; l[qt] = 0.f;
#pragma unroll
    for (int d = 0; d < 8; ++d) O[d][qt] = f32x4{0.f, 0.f, 0.f, 0.f};
  }
  const int prow = lane >> 3, pch = lane & 7;
  unsigned koff[4], voff[4];
#pragma unroll
  for (int i = 0; i < 4; ++i) {
    const int pi = w * 4 + i;
    { const int row = (pi & 7) * 8 + prow, sub = pi >> 3, c = pch ^ ((row >> 1) & 7);
      koff[i] = (unsigned)((row * PW + sub * 64 + c * 8) * 2); }
    { const int row = pi * 8 + prow, c = pch ^ ((row >> 1) & 7);
      voff[i] = (unsigned)((row * SEQ + c * 8) * 2); }
  }
  auto gload = [&](int kt, int buf) {
    char* base = lds + buf * 32768;
    const char* kt_base = (const char*)(kp + (size_t)kt * 64 * PW);
    const char* vt_base = (const char*)(vtp + (size_t)kt * 64);
#pragma unroll
    for (int i = 0; i < 4; ++i)
      __builtin_amdgcn_global_load_lds((const unsigned*)(kt_base + koff[i]), (unsigned*)(base + (w * 4 + i) * 1024 + lane * 16), 16, 0, 0);
#pragma unroll
    for (int i = 0; i < 4; ++i)
      __builtin_amdgcn_global_load_lds((const unsigned*)(vt_base + voff[i]), (unsigned*)(base + 16384 + (w * 4 + i) * 1024 + lane * 16), 16, 0, 0);
  };
  const int qw0 = qb * 64 + g * 32;
  gload(0, 0); __syncthreads();
  for (int kt = 0; kt < nkt; ++kt) {
    if (kt + 1 < nkt) gload(kt + 1, (kt + 1) & 1);
    const char* Kb = lds + (kt & 1) * 32768 + sidx * 8192;
    const char* Vb = lds + (kt & 1) * 32768 + 16384;
    if (kt * 64 <= qw0 + 31) {
      f32x4 S[4][2];
#pragma unroll
      for (int a = 0; a < 4; ++a)
#pragma unroll
        for (int qt = 0; qt < 2; ++qt) { const float nm = -m[qt]; S[a][qt] = f32x4{nm, nm, nm, nm}; }
      bf16x8 kf[8], vfa[8], vfb[8];
#pragma unroll
      for (int i = 0; i < 8; ++i) {
        const int row = (i & 3) * 16 + c16, chunk = (i >> 2) * 4 + quad;
        kf[i] = *(const bf16x8*)(Kb + row * 128 + (swz(row, chunk) << 4));
      }
      __builtin_amdgcn_sched_barrier(0);
#pragma unroll
      for (int d = 0; d < 8; ++d) { const int row = d * 16 + c16; vfa[d] = *(const bf16x8*)(Vb + row * 128 + (swz(row, quad) << 4)); }
#pragma unroll
      for (int i = 0; i < 8; ++i)
#pragma unroll
        for (int qt = 0; qt < 2; ++qt) S[i & 3][qt] = MFMA16(kf[i], qf[qt][i >> 2], S[i & 3][qt]);
      __builtin_amdgcn_sched_barrier(0);
      if (kt * 64 + 63 > qw0) {
#pragma unroll
        for (int ksub = 0; ksub < 4; ++ksub)
#pragma unroll
          for (int qt = 0; qt < 2; ++qt)
#pragma unroll
            for (int r = 0; r < 4; ++r) {
              const int key = kt * 64 + ksub * 16 + quad * 4 + r;
              if (key > qw0 + qt * 16 + c16) S[ksub][qt][r] = -1e30f;
            }
      }
      float mx[2];
      bool need = false;
#pragma unroll
      for (int qt = 0; qt < 2; ++qt) {
        float v = -1e30f;
#pragma unroll
        for (int ksub = 0; ksub < 4; ++ksub)
#pragma unroll
          for (int r = 0; r < 4; ++r) v = fmaxf(v, S[ksub][qt][r]);
        v = quadmax(v);
        mx[qt] = v;
        need = need || (v > 8.f);
      }
      if (__any(need) || kt == 0) {
#pragma unroll
        for (int qt = 0; qt < 2; ++qt) {
          const float delta = (kt == 0) ? mx[qt] : fmaxf(mx[qt], 0.f);
          const float alpha = (kt == 0) ? 1.f : __builtin_amdgcn_exp2f(-delta);
          m[qt] += delta;
          l[qt] *= alpha;
#pragma unroll
          for (int d = 0; d < 8; ++d) O[d][qt] *= alpha;
#pragma unroll
          for (int ksub = 0; ksub < 4; ++ksub)
#pragma unroll
            for (int r = 0; r < 4; ++r) S[ksub][qt][r] -= delta;
        }
      }
      bf16x8 pf[2][2];
#pragma unroll
      for (int qt = 0; qt < 2; ++qt) {
        float psum = 0.f;
#pragma unroll
        for (int ksub = 0; ksub < 4; ++ksub)
#pragma unroll
          for (int r = 0; r < 4; ++r) { const float e = __builtin_amdgcn_exp2f(S[ksub][qt][r]); S[ksub][qt][r] = e; psum += e; }
        l[qt] += psum;
#pragma unroll
        for (int kk = 0; kk < 2; ++kk) {
          union { unsigned u[4]; bf16x8 v; } pk;
          pk.u[0] = pack2(S[2 * kk][qt][0], S[2 * kk][qt][1]);
          pk.u[1] = pack2(S[2 * kk][qt][2], S[2 * kk][qt][3]);
          pk.u[2] = pack2(S[2 * kk + 1][qt][0], S[2 * kk + 1][qt][1]);
          pk.u[3] = pack2(S[2 * kk + 1][qt][2], S[2 * kk + 1][qt][3]);
          pf[kk][qt] = pk.v;
        }
      }
      __builtin_amdgcn_sched_barrier(0);
#pragma unroll
      for (int d = 0; d < 8; ++d) { const int row = d * 16 + c16; vfb[d] = *(const bf16x8*)(Vb + row * 128 + (swz(row, 4 + quad) << 4)); }
#pragma unroll
      for (int d = 0; d < 8; ++d)
#pragma unroll
        for (int qt = 0; qt < 2; ++qt) O[d][qt] = MFMA16(vfa[d], pf[0][qt], O[d][qt]);
      __builtin_amdgcn_sched_barrier(0);
#pragma unroll
      for (int d = 0; d < 8; ++d)
#pragma unroll
        for (int qt = 0; qt < 2; ++qt) O[d][qt] = MFMA16(vfb[d], pf[1][qt], O[d][qt]);
    }
    __syncthreads();
  }
  const float lam = p.lamv[layer];
  const float lam_init = 0.8f - 0.6f * expf(-0.3f * (float)layer);
  float* xch = (float*)(lds + g * 16384);
  float cf[2];
#pragma unroll
  for (int qt = 0; qt < 2; ++qt) cf[qt] = ((sidx == 0) ? 1.f : lam) / quadsum(l[qt]);
  if (sidx == 1) {
#pragma unroll
    for (int d = 0; d < 8; ++d)
#pragma unroll
      for (int qt = 0; qt < 2; ++qt)
#pragma unroll
        for (int r = 0; r < 4; ++r) xch[((d * 2 + qt) * 4 + r) * 64 + lane] = O[d][qt][r] * cf[qt];
  }
  __syncthreads();
  if (sidx == 0) {
    const float* sg = p.da_g + layer * 128;
#pragma unroll
    for (int qt = 0; qt < 2; ++qt) {
      float ss = 0.f;
#pragma unroll
      for (int d = 0; d < 8; ++d)
#pragma unroll
        for (int r = 0; r < 4; ++r) {
          const float o = O[d][qt][r] * cf[qt] - xch[((d * 2 + qt) * 4 + r) * 64 + lane];
          O[d][qt][r] = o; ss += o * o;
        }
      ss = quadsum(ss);
      const float rn = rsqrtf(ss * (1.f / 128.f) + 1e-6f) * (1.f - lam_init);
      const int tok = tok0 + g * 32 + qt * 16 + c16;
#pragma unroll
      for (int d = 0; d < 8; ++d) {
        const int dv0 = d * 16 + quad * 4;
        bf16_t* gp = p.proj + (size_t)tok * PW + C_BG + h * 128 + dv0;
        const uint2 gv = *(const uint2*)gp;
        const float g0 = __uint_as_float(gv.x << 16), g1 = __uint_as_float(gv.x & 0xffff0000u);
        const float g2 = __uint_as_float(gv.y << 16), g3 = __uint_as_float(gv.y & 0xffff0000u);
        uint2 o;
        o.x = pack2(O[d][qt][0] * rn * sg[dv0] * g0, O[d][qt][1] * rn * sg[dv0 + 1] * g1);
        o.y = pack2(O[d][qt][2] * rn * sg[dv0 + 2] * g2, O[d][qt][3] * rn * sg[dv0 + 3] * g3);
        *(uint2*)gp = o;
      }
    }
  }
}

DI void mem_attn_item(const Params& p, int layer, int item, char* lds) {
  const int qb = item >> 4, bh = item & 15, b = bh >> 2, h = bh & 3;
  const int tok0 = b * SEQ + qb * 64;
  const int tid_ = opaque_tid(), lane = tid_ & 63, w = tid_ >> 6, c16 = lane & 15, quad = lane >> 4;
  AttnState<1, 1> st;
  attn_core<1, 1>(st, p.proj + (size_t)tok0 * PW + C_MQ + h * 128, PW,
               p.memk + ((size_t)layer * 1024 + b * 256) * 512 + h * 128, 512,
               p.memvt + ((size_t)((layer * 4 + b) * 4 + h) * 128) * 256, 256, 4, 0, false, lds);
#pragma unroll
  for (int qt = 0; qt < 1; ++qt) {
    const float i1 = 1.f / st.l[0][qt];
    const int tok = tok0 + w * 16 + qt * 16 + c16;
#pragma unroll
    for (int d = 0; d < 8; ++d) {
      const int dv0 = d * 16 + quad * 4;
      bf16_t* g = p.proj + (size_t)tok * PW + C_MG + h * 128 + dv0;
      const uint2 gv = *(const uint2*)g;
      const float g0 = __uint_as_float(gv.x << 16), g1 = __uint_as_float(gv.x & 0xffff0000u);
      const float g2 = __uint_as_float(gv.y << 16), g3 = __uint_as_float(gv.y & 0xffff0000u);
      uint2 o;
      o.x = pack2(st.O[0][d][qt][0] * i1 * g0, st.O[0][d][qt][1] * i1 * g1);
      o.y = pack2(st.O[0][d][qt][2] * i1 * g2, st.O[0][d][qt][3] * i1 * g3);
      *(uint2*)g = o;
    }
  }
}

DI float gelu_tanh(float x) {
  const float u = 0.7978845608028654f * (x + 0.044715f * x * x * x);
  const float t = 1.f - 2.f / (1.f + __expf(2.f * u));
  return 0.5f * x * (1.f + t);
}

template <bool FINAL>
DI void s5_item(const Params& p, int layer, int item, char* lds) {
  const int gq = item & 7, c = (item >> 3) & 127, b = item >> 10;
  const int tid_ = opaque_tid(), lane = tid_ & 63, w = tid_ >> 6, c16 = lane & 15, quad = lane >> 4;
  const int g = gq * 4 + w;
  const int tok0 = b * SEQ + c * 64;
  float* bu = (float*)(lds + w * 16384);
  char* xsb = lds + w * 16384 + 8192;
  bf16x8 bbf[8];
  {
    const bf16_t* bt = p.s5bt + (size_t)(layer * 32 + g) * 128 * 32;
#pragma unroll
    for (int nt = 0; nt < 8; ++nt) bbf[nt] = *(const bf16x8*)(bt + (nt * 16 + c16) * 32 + quad * 8);
  }
  const float* par = p.s5par + (size_t)((layer * 32 + g) * 36) * 64 + lane;
  const float are = par[0], aim = par[64];
  float xr = 0.f, xi = 0.f;
  float* stp = p.s5st + ((size_t)((b * 32 + g) * 128)) * 128 + lane;
  bf16x8 cf[FINAL ? 4 : 1];
  float dsk = 0.f;
  if constexpr (FINAL) {
    xr = stp[c * 128]; xi = stp[c * 128 + 64];
    const float* cr = p.s5_cre + (size_t)((layer * 32 + g) * 16 + c16) * 64;
    const float* ci = p.s5_cim + (size_t)((layer * 32 + g) * 16 + c16) * 64;
#pragma unroll
    for (int ks = 0; ks < 4; ++ks) {
      const float* src = ((ks < 2) ? cr : ci) + (ks & 1) * 32 + quad * 8;
      const float sg = (ks < 2) ? 1.f : -1.f;
      const float4 v0 = *(const float4*)src, v1 = *(const float4*)(src + 4);
      union { unsigned u[4]; bf16x8 v; } pk;
      pk.u[0] = pack2(sg * v0.x, sg * v0.y); pk.u[1] = pack2(sg * v0.z, sg * v0.w);
      pk.u[2] = pack2(sg * v1.x, sg * v1.y); pk.u[3] = pack2(sg * v1.z, sg * v1.w);
      cf[ks] = pk.v;
    }
    dsk = p.s5_d[(layer * 32 + g) * 16 + c16];
  }
  for (int sc = 0; sc < 4; ++sc) {
    const int tb = tok0 + sc * 16;
    bf16x8 uf = bf16x8{0, 0, 0, 0, 0, 0, 0, 0};
    if (quad < 2) uf = *(const bf16x8*)(p.proj + (size_t)(tb + c16) * PW + C_AU + g * 16 + quad * 8);
    float uo[FINAL ? 4 : 1];
    if constexpr (FINAL) {
#pragma unroll
      for (int r = 0; r < 4; ++r) uo[r] = bf2f(p.proj[(size_t)(tb + quad * 4 + r) * PW + C_AU + g * 16 + c16]);
    }
#pragma unroll
    for (int nt = 0; nt < 8; ++nt) {
      f32x4 acc = MFMA16(uf, bbf[nt], (f32x4{0.f, 0.f, 0.f, 0.f}));
#pragma unroll
      for (int r = 0; r < 4; ++r) bu[(quad * 4 + r) * 128 + nt * 16 + c16] = acc[r];
    }
    __syncthreads();
#pragma unroll
    for (int tt = 0; tt < 16; ++tt) {
      const float br_ = bu[tt * 128 + lane], bi_ = bu[tt * 128 + 64 + lane];
      const float nr = are * xr - aim * xi + br_;
      const float ni = are * xi + aim * xr + bi_;
      xr = nr; xi = ni;
      if constexpr (FINAL) {
        *(bf16_t*)(xsb + tt * 256 + ((((lane >> 3)) ^ tt) << 4) + (lane & 7) * 2) = f2bf(xr);
        *(bf16_t*)(xsb + tt * 256 + (((8 + (lane >> 3)) ^ tt) << 4) + (lane & 7) * 2) = f2bf(xi);
      }
    }
    if constexpr (FINAL) {
      __syncthreads();
      f32x4 y = f32x4{0.f, 0.f, 0.f, 0.f};
#pragma unroll
      for (int ks = 0; ks < 4; ++ks) {
        const bf16x8 xf = *(const bf16x8*)(xsb + c16 * 256 + (((ks * 4 + quad) ^ c16) << 4));
        y = MFMA16(xf, cf[ks], y);
      }
#pragma unroll
      for (int r = 0; r < 4; ++r) {
        const float v = y[r] + dsk * uo[r];
        p.proj[(size_t)(tb + quad * 4 + r) * PW + C_AU + g * 16 + c16] = f2bf(gelu_tanh(v));
      }
    }
    __syncthreads();
  }
  if constexpr (!FINAL) { stp[c * 128] = xr; stp[c * 128 + 64] = xi; }
}

template <bool FINAL>
DI void lru_item(const Params& p, int layer, int item, char* lds) {
  const int half = item & 1, c = (item >> 1) & 127, b = item >> 8;
  const int tid_ = opaque_tid(), lane = tid_ & 63, w = tid_ >> 6, c16 = lane & 15, quad = lane >> 4;
  const int n = half * 4 + w, ch = n * 64 + lane;
  const int l0 = c * 64, tok0 = b * SEQ + l0;
  char* xcb = lds + w * 16384;
  float* aba = (float*)(xcb + 8192);
  float* abb = aba + 1024;
  bf16x8 wf[8][2];
  {
    const float* pa = p.lru_wa + (size_t)((layer * 8 + n) * 64) * 64;
    const float* px = p.lru_wx + (size_t)((layer * 8 + n) * 64) * 64;
#pragma unroll
    for (int nt = 0; nt < 8; ++nt) {
      const float* base = ((nt < 4) ? pa : px) + (nt & 3) * 16 + c16;
#pragma unroll
      for (int ks = 0; ks < 2; ++ks) {
        union { unsigned u[4]; bf16x8 v; } pk;
#pragma unroll
        for (int jj = 0; jj < 4; ++jj) {
          const int k = ks * 32 + quad * 8 + jj * 2;
          pk.u[jj] = pack2(base[k * 64], base[(k + 1) * 64]);
        }
        wf[nt][ks] = pk.v;
      }
    }
  }
  float bav[4], bxv[4], spv[4];
#pragma unroll
  for (int nt = 0; nt < 4; ++nt) {
    const int cch = layer * 512 + n * 64 + nt * 16 + c16;
    bav[nt] = p.lru_ba[cch]; bxv[nt] = p.lru_bx[cch];
    spv[nt] = 8.f * log1pf(expf(-p.lru_lam[cch])) * 1.4426950408889634f;
  }
  {
    const float cw0 = p.conv_w[(layer * 4 + 0) * 512 + ch], cw1 = p.conv_w[(layer * 4 + 1) * 512 + ch];
    const float cw2 = p.conv_w[(layer * 4 + 2) * 512 + ch], cw3 = p.conv_w[(layer * 4 + 3) * 512 + ch];
    const float cb = p.conv_b[layer * 512 + ch];
    const bf16_t* xp = p.proj + (size_t)tok0 * PW + C_CX + ch;
    bf16_t xin[67];
#pragma unroll
    for (int t = 0; t < 3; ++t) xin[t] = (l0 + t - 3 >= 0) ? xp[(t - 3) * PW] : (bf16_t)0;
#pragma unroll
    for (int t = 3; t < 67; ++t) xin[t] = xp[(size_t)(t - 3) * PW];
#pragma unroll
    for (int t = 0; t < 64; ++t) {
      const float xc = cw0 * bf2f(xin[t]) + cw1 * bf2f(xin[t + 1]) + cw2 * bf2f(xin[t + 2]) + cw3 * bf2f(xin[t + 3]) + cb;
      *(bf16_t*)(xcb + t * 128 + (swz(t, lane >> 3) << 4) + (lane & 7) * 2) = f2bf(xc);
    }
  }
  float hst = 0.f, pr = 1.f;
  float* stp = p.lrust + ((size_t)(b * 128) * 512 + ch) * 2;
  if constexpr (FINAL) hst = stp[(size_t)c * 1024 + 1];
  __syncthreads();
  for (int sc = 0; sc < 4; ++sc) {
    float gv[FINAL ? 16 : 1];
    if constexpr (FINAL) {
      const bf16_t* gp0 = p.proj + (size_t)(tok0 + sc * 16) * PW + C_CG + ch;
#pragma unroll
      for (int t = 0; t < 16; ++t) gv[t] = bf2f(gp0[(size_t)t * PW]);
    }
    f32x4 acc[8];
#pragma unroll
    for (int nt = 0; nt < 8; ++nt) acc[nt] = f32x4{0.f, 0.f, 0.f, 0.f};
    const int arow = sc * 16 + c16;
#pragma unroll
    for (int ks = 0; ks < 2; ++ks) {
      const bf16x8 af = *(const bf16x8*)(xcb + arow * 128 + (swz(arow, ks * 4 + quad) << 4));
#pragma unroll
      for (int nt = 0; nt < 8; ++nt) acc[nt] = MFMA16(af, wf[nt][ks], acc[nt]);
    }
#pragma unroll
    for (int nt = 0; nt < 4; ++nt) {
      const int chl = nt * 16 + c16;
#pragma unroll
      for (int r = 0; r < 4; ++r) {
        const int tl = sc * 16 + quad * 4 + r;
        const float xcv = bf2f(*(const bf16_t*)(xcb + tl * 128 + (swz(tl, chl >> 3) << 4) + (chl & 7) * 2));
        const float ga = acc[nt][r] + bav[nt], gx = acc[nt + 4][r] + bxv[nt];
        const float rr = __builtin_amdgcn_rcpf(1.f + __builtin_amdgcn_exp2f(-1.4426950408889634f * ga));
        const float ig = __builtin_amdgcn_rcpf(1.f + __builtin_amdgcn_exp2f(-1.4426950408889634f * gx));
        const float la2 = -spv[nt] * rr;
        const float a = __builtin_amdgcn_exp2f(la2);
        const float y = la2 * 1.3862943611198906f;
        float q = 1.f + y * (1.f / 6.f);
        q = 1.f + y * 0.2f * q; q = 1.f + y * 0.25f * q; q = 1.f + y * (1.f / 3.f) * q; q = 1.f + y * 0.5f * q;
        const float om = (y < -0.5f) ? (1.f - a * a) : (-y * q);
        const float mult = __builtin_amdgcn_sqrtf(om);
        aba[(quad * 4 + r) * 64 + chl] = a;
        abb[(quad * 4 + r) * 64 + chl] = mult * ig * xcv;
      }
    }
    __syncthreads();
#pragma unroll
    for (int tt = 0; tt < 16; ++tt) {
      const float a = aba[tt * 64 + lane], bv = abb[tt * 64 + lane];
      hst = a * hst + bv;
      if constexpr (FINAL) p.proj[(size_t)(tok0 + sc * 16 + tt) * PW + C_CG + ch] = f2bf(hst * gv[tt]);
      else pr *= a;
    }
    __syncthreads();
  }
  if constexpr (!FINAL) { *(float2*)(stp + (size_t)c * 1024) = make_float2(pr, hst); }
}

DI void transpose_tile(const Params& p, int t, char* lds) {
  const float* src; bf16_t* dst; int K, N, kt, nt, perm = 0;
  const float* gs = nullptr;
  if (t < 5120) { int l = t / 1280, r = t % 1280; kt = r / 80; nt = r % 80; K = 1024; N = 5120; src = p.w_in + (size_t)l * K * N; dst = p.wt_in + (size_t)l * K * N; gs = p.norm_g + l * 1024; }
  else if (t < 7168) { t -= 5120; int l = t / 512, r = t % 512; kt = r / 16; nt = r % 16; K = 2048; N = 1024; src = p.w_out + (size_t)l * K * N; dst = p.wt_out + (size_t)l * K * N; }
  else if (t < 7680) { t -= 7168; int l = t / 128, r = t % 128; kt = r / 16; nt = r % 16; K = 512; N = 1024; src = p.s5_wglu + (size_t)l * K * N; dst = p.wt_glu + (size_t)l * K * N; perm = 1; }
  else { t -= 7680; int l = t / 256, r = t % 256; kt = r / 16; nt = r % 16; K = 1024; N = 1024; src = p.w_memkv + (size_t)l * K * N; dst = p.wt_mem + (size_t)l * K * N; }
  float* tile = (float*)lds;
  const int tid = opaque_tid(), ty = tid >> 4, tx = tid & 15;
  const int k0 = kt * 64, n0 = nt * 64;
#pragma unroll
  for (int i = 0; i < 4; ++i) {
    const int k = ty + 16 * i;
    const float4 v = *(const float4*)(src + (size_t)(k0 + k) * N + n0 + tx * 4);
    tile[k * 65 + tx * 4] = v.x; tile[k * 65 + tx * 4 + 1] = v.y; tile[k * 65 + tx * 4 + 2] = v.z; tile[k * 65 + tx * 4 + 3] = v.w;
  }
  __syncthreads();
  const int n = tid >> 2, kq = tid & 3;
  unsigned pk[8];
#pragma unroll
  for (int j = 0; j < 8; ++j) {
    const int kk = kq * 16 + 2 * j;
    const float s0 = gs ? gs[kt * 64 + kk] : 1.f, s1 = gs ? gs[kt * 64 + kk + 1] : 1.f;
    pk[j] = pack2(tile[kk * 65 + n] * s0, tile[(kk + 1) * 65 + n] * s1);
  }
  int row = n0 + n;
  if (perm) { const int j = row & 511; row = (j >> 5) * 64 + ((row >= 512) ? 32 : 0) + (j & 31); }
  uint4* d = (uint4*)(dst + (size_t)row * K + k0 + kq * 16);
  d[0] = make_uint4(pk[0], pk[1], pk[2], pk[3]);
  d[1] = make_uint4(pk[4], pk[5], pk[6], pk[7]);
  __syncthreads();
}

DI void phase0(const Params& p, char* lds) {
  const int tid = opaque_tid(), lane = tid & 63, w = tid >> 6;
  for (int t = blockIdx.x; t < 8704; t += gridDim.x) transpose_tile(p, t, lds);
  for (int it = blockIdx.x; it < 8192 + 1024; it += gridDim.x) {
    if (it < 8192) {
      const int row = it * 4 + w;
      const float* xr = p.x + (size_t)row * 1024;
      float4 v[4]; float ss = 0.f;
#pragma unroll
      for (int i = 0; i < 4; ++i) { v[i] = *(const float4*)(xr + i * 256 + lane * 4); ss += v[i].x * v[i].x + v[i].y * v[i].y + v[i].z * v[i].z + v[i].w * v[i].w; }
#pragma unroll
      for (int o = 32; o >= 1; o >>= 1) ss += __shfl_xor(ss, o);
#pragma unroll
      for (int i = 0; i < 4; ++i) {
        const int col = i * 256 + lane * 4;
        uint2 o; o.x = pack2(v[i].x, v[i].y); o.y = pack2(v[i].z, v[i].w);
        *(uint2*)(p.xb + (size_t)row * 1024 + col) = o;
      }
      if (lane == 0) p.rowss[row] = ss;
    } else {
      const int r = (it - 8192) * 4 + w, l = r >> 10, mr = r & 1023;
      const float* xr = p.mem + (size_t)mr * 1024;
      float4 v[4]; float ss = 0.f;
#pragma unroll
      for (int i = 0; i < 4; ++i) { v[i] = *(const float4*)(xr + i * 256 + lane * 4); ss += v[i].x * v[i].x + v[i].y * v[i].y + v[i].z * v[i].z + v[i].w * v[i].w; }
#pragma unroll
      for (int o = 32; o >= 1; o >>= 1) ss += __shfl_xor(ss, o);
      const float rs = rsqrtf(ss * (1.f / 1024.f) + 1e-6f);
#pragma unroll
      for (int i = 0; i < 4; ++i) {
        const int col = i * 256 + lane * 4;
        const float4 g = *(const float4*)(p.memng + l * 1024 + col);
        uint2 o; o.x = pack2(v[i].x * rs * g.x, v[i].y * rs * g.y); o.y = pack2(v[i].z * rs * g.z, v[i].w * rs * g.w);
        *(uint2*)(p.memn + (size_t)r * 1024 + col) = o;
      }
    }
  }
  const int gtid = blockIdx.x * 256 + tid, gstride = gridDim.x * 256;
  for (int i = gtid; i < NT * 8; i += gstride) {
    const int tok = i >> 3, f = i & 7;
    const float inv = powf(500000.f, -(float)(2 * f) / 16.f);
    const float ang = (float)p.pos[tok] * inv;
    float s, c; sincosf(ang, &s, &c);
    p.ropetab[tok * 16 + f] = c; p.ropetab[tok * 16 + 8 + f] = s;
  }
  for (int i = gtid; i < 4 * 32 * 64; i += gstride) {
    const int pp = i & 63, lg = i >> 6;
    const float dt = expf(p.s5_logdt[lg]);
    const float lr = p.s5_lre[i], li = p.s5_lim[i];
    const float mag = expf(lr * dt);
    const float are = mag * cosf(li * dt), aim = mag * sinf(li * dt);
    const float den = lr * lr + li * li;
    const float nr = are - 1.f, ni = aim;
    const float fre = (nr * lr + ni * li) / den, fim = (ni * lr - nr * li) / den;
    float* o = p.s5par + (size_t)lg * 36 * 64 + pp;
    o[0] = are; o[64] = aim;
    bf16_t* btr = p.s5bt + ((size_t)lg * 128 + pp) * 32;
    bf16_t* bti = btr + 64 * 32;
    for (int h = 0; h < 16; ++h) {
      const float br = p.s5_bre[(size_t)i * 16 + h], bi = p.s5_bim[(size_t)i * 16 + h];
      o[(2 + h) * 64] = fre * br - fim * bi;
      o[(18 + h) * 64] = fre * bi + fim * br;
      btr[h] = f2bf(fre * br - fim * bi); bti[h] = f2bf(fre * bi + fim * br);
      btr[16 + h] = 0; bti[16 + h] = 0;
    }
    float tr = are, ti = aim;
    for (int q = 0; q < 6; ++q) { const float a = tr * tr - ti * ti, bq = 2.f * tr * ti; tr = a; ti = bq; }
    o[34 * 64] = tr; o[35 * 64] = ti;
  }
  for (int i = gtid; i < 15 * NT; i += gstride) p.rowss[NT + i] = 0.f;
  if (gtid < 64) p.ctr[gtid] = 0u;
  if (gtid < 4) {
    float s1 = 0.f, s2 = 0.f;
    for (int j = 0; j < 64; ++j) { s1 += p.da_q1[gtid * 64 + j] * p.da_k1[gtid * 64 + j]; s2 += p.da_q2[gtid * 64 + j] * p.da_k2[gtid * 64 + j]; }
    p.lamv[gtid] = expf(s1) - expf(s2) + (0.8f - 0.6f * expf(-0.3f * (float)gtid));
  }
}

DI void carry_phase(const Params& p, int layer) {
  for (int it = blockIdx.x; it < 40; it += gridDim.x) {
    if (it < 32) {
      const int idx = it * 256 + threadIdx.x, b = idx >> 11, g = (idx >> 6) & 31, pp = idx & 63;
      const float* par = p.s5par + (size_t)((layer * 32 + g) * 36) * 64 + pp;
      const float tre = par[34 * 64], tim = par[35 * 64];
      float* base = p.s5st + ((size_t)((b * 32 + g) * 128)) * 128 + pp;
      float xr = 0.f, xi = 0.f;
      for (int c0 = 0; c0 < 128; c0 += 16) {
        float er[16], ei[16];
#pragma unroll
        for (int j = 0; j < 16; ++j) { er[j] = base[(c0 + j) * 128]; ei[j] = base[(c0 + j) * 128 + 64]; }
#pragma unroll
        for (int j = 0; j < 16; ++j) {
          base[(c0 + j) * 128] = xr; base[(c0 + j) * 128 + 64] = xi;
          const float nr = tre * xr - tim * xi + er[j];
          const float ni = tre * xi + tim * xr + ei[j];
          xr = nr; xi = ni;
        }
      }
    } else {
      const int idx = (it - 32) * 256 + threadIdx.x, b = idx >> 9, ch = idx & 511;
      float* base = p.lrust + ((size_t)(b * 128) * 512 + ch) * 2;
      float h = 0.f;
      for (int c0 = 0; c0 < 128; c0 += 16) {
        float2 e[16];
#pragma unroll
        for (int j = 0; j < 16; ++j) e[j] = *(const float2*)(base + (size_t)(c0 + j) * 1024);
#pragma unroll
        for (int j = 0; j < 16; ++j) {
          base[(size_t)(c0 + j) * 1024 + 1] = h;
          h = e[j].x * h + e[j].y;
        }
      }
    }
  }
}

DI bool tile_map(int i, int ncols, int& m, int& n) {
  if (gridDim.x == 512) {
    const int x = blockIdx.x & 7, j = blockIdx.x >> 3, ncg = ncols >> 3;
    m = 16 * x + 8 * (i / ncg) + (j >> 3);
    n = 8 * (i % ncg) + (j & 7);
    return i < 2 * ncg;
  }
  const int t = blockIdx.x + i * gridDim.x;
  m = t / ncols; n = t % ncols;
  return t < 128 * ncols;
}

DI int next_item(unsigned* ctr, int* sh) {
  __syncthreads();
  if (threadIdx.x == 0) *sh = (int)atomicAdd(ctr, 1u);
  __syncthreads();
  return *sh;
}

__global__ void __launch_bounds__(256, 2) hymba_forward(Params p) {
  extern __shared__ __attribute__((aligned(16))) char lds[];
  __shared__ uint4 xb_words;
  cg::grid_group grid = cg::this_grid();
  int* sh_item = (int*)(lds + 73728);
  if (threadIdx.x == 0) xb_words = make_uint4(0u, 0u, 0u, 0u);
  __syncthreads();
  XcdBarrier xb = xcd_barrier_post(p.bar, (volatile LAS unsigned*)&xb_words);
  phase0(p, lds);
  if (gridDim.x == 0x7fffffffu) grid.sync();
  xcd_barrier(xb);
  for (int layer = 0; layer < 4; ++layer) {
    {
      GemmArgs ga; ga.A = p.xb; ga.lda = 1024; ga.mix = 0; ga.Bt = p.wt_in + (size_t)layer * 5120 * 1024; ga.K = 1024;
      EpiArgs ea; ea.p = &p; ea.layer = layer; ea.rowss = p.rowss + (size_t)layer * 16 * NT; ea.xsrc = nullptr; ea.gnext = nullptr; ea.rowss_next = nullptr;
      for (int i = 0;; ++i) { int m, n; if (!tile_map(i, 40, m, n)) break; gemm_tile<EPI_INPROJ>(ga, ea, m * 256, n * 128, lds); }
      if (layer == 0) {
        for (int t = blockIdx.x; t < 128; t += gridDim.x) {
          const int lm = t >> 5, r = t & 31;
          GemmArgs gm; gm.A = p.memn + (size_t)lm * 1024 * 1024; gm.lda = 1024; gm.mix = 0; gm.Bt = p.wt_mem + (size_t)lm * 1024 * 1024; gm.K = 1024;
          EpiArgs em = ea; em.layer = lm;
          gemm_tile<EPI_MEMKV>(gm, em, (r >> 3) * 256, (r & 7) * 128, lds);
        }
      }
    }
    xcd_barrier(xb);
    {
      unsigned* ctr = p.ctr + layer * 2;
      for (;;) {
        const int it = next_item(ctr, sh_item);
        if (it >= 1024 + 4096) break;
        if (it < 1024) lru_item<false>(p, layer, it, lds);
        else s5_item<false>(p, layer, it - 1024, lds);
      }
    }
    xcd_barrier(xb);
    carry_phase(p, layer);
    xcd_barrier(xb);
    {
      unsigned* actr = p.ctr + 16 + layer * 8 + (blockIdx.x & 7);
      for (;;) {
        const int it = next_item(actr, sh_item);
        if (it >= 256) break;
        diff_attn_item(p, layer, 127 - (it >> 1), (blockIdx.x & 7) * 2 + (it & 1), lds);
      }
      unsigned* ctr = p.ctr + layer * 2 + 1;
      for (;;) {
        const int it = next_item(ctr, sh_item);
        if (it >= 1024 + 4096 + 2048) break;
        if (it < 1024) lru_item<true>(p, layer, it, lds);
        else if (it < 5120) s5_item<true>(p, layer, it - 1024, lds);
        else mem_attn_item(p, layer, it - 5120, lds);
      }
    }
    xcd_barrier(xb);
    {
      GemmArgs ga; ga.A = p.proj + C_AU; ga.lda = PW; ga.mix = 0; ga.Bt = p.wt_glu + (size_t)layer * 1024 * 512; ga.K = 512;
      EpiArgs ea; ea.p = &p; ea.layer = layer; ea.rowss = nullptr; ea.xsrc = nullptr; ea.gnext = nullptr; ea.rowss_next = nullptr;
      for (int i = 0;; ++i) { int m, n; if (!tile_map(i, 8, m, n)) break; gemm_tile<EPI_GLU>(ga, ea, m * 256, n * 128, lds); }
    }
    xcd_barrier(xb);
    {
      GemmArgs ga; ga.A = p.proj; ga.lda = PW; ga.mix = 1; ga.Bt = p.wt_out + (size_t)layer * 1024 * 2048; ga.K = 2048;
      EpiArgs ea; ea.p = &p; ea.layer = layer; ea.rowss = nullptr;
      ea.xsrc = (layer == 0) ? p.x : nullptr;
      ea.gnext = (layer < 3) ? (p.norm_g + (layer + 1) * 1024) : nullptr;
      ea.rowss_next = p.rowss + (size_t)(layer + 1) * 16 * NT;
      for (int i = 0;; ++i) { int m, n; if (!tile_map(i, 8, m, n)) break; gemm_tile<EPI_OUT>(ga, ea, m * 256, n * 128, lds); }
    }
    xcd_barrier(xb);
  }
  {
    const float* rss = p.rowss + (size_t)4 * 16 * NT;
    const int lane = threadIdx.x & 63, w = threadIdx.x >> 6;
    for (int row = blockIdx.x * 4 + w; row < NT; row += gridDim.x * 4) {
      const float rs = rsqrtf(sum16(rss, row) * (1.f / 1024.f) + 1e-6f);
#pragma unroll
      for (int i = 0; i < 4; ++i) {
        const int col = i * 256 + lane * 4;
        const uint2 u = *(const uint2*)(p.xb + (size_t)row * 1024 + col);
        const float4 g = *(const float4*)(p.fng + col);
        float4 v;
        v.x = __uint_as_float(u.x << 16) * rs * g.x; v.y = __uint_as_float(u.x & 0xffff0000u) * rs * g.y;
        v.z = __uint_as_float(u.y << 16) * rs * g.z; v.w = __uint_as_float(u.y & 0xffff0000u) * rs * g.w;
        *(float4*)(p.out + (size_t)row * 1024 + col) = v;
      }
    }
  }
}

extern "C" void kernel_launch(void* const* d_in, const int* in_sizes, int n_in, void* d_out, int out_size, void* d_ws,
                              size_t ws_size, hipStream_t stream) {
  Params p{};
  p.x = (const float*)d_in[0]; p.mem = (const float*)d_in[1]; p.pos = (const int*)d_in[2];
  p.norm_g = (const float*)d_in[3]; p.w_in = (const float*)d_in[4]; p.w_out = (const float*)d_in[5];
  p.s5_lre = (const float*)d_in[6]; p.s5_lim = (const float*)d_in[7]; p.s5_logdt = (const float*)d_in[8];
  p.s5_bre = (const float*)d_in[9]; p.s5_bim = (const float*)d_in[10]; p.s5_cre = (const float*)d_in[11];
  p.s5_cim = (const float*)d_in[12]; p.s5_d = (const float*)d_in[13]; p.s5_wglu = (const float*)d_in[14];
  p.da_q1 = (const float*)d_in[15]; p.da_k1 = (const float*)d_in[16]; p.da_q2 = (const float*)d_in[17];
  p.da_k2 = (const float*)d_in[18]; p.da_g = (const float*)d_in[19];
  p.conv_w = (const float*)d_in[20]; p.conv_b = (const float*)d_in[21]; p.lru_wa = (const float*)d_in[22];
  p.lru_ba = (const float*)d_in[23]; p.lru_wx = (const float*)d_in[24]; p.lru_bx = (const float*)d_in[25];
  p.lru_lam = (const float*)d_in[26]; p.memng = (const float*)d_in[27]; p.w_memkv = (const float*)d_in[28];
  p.fng = (const float*)d_in[29];
  p.out = (float*)d_out;
  char* ws = (char*)d_ws; size_t off = 0;
  auto take = [&](size_t bytes) { char* r = ws + off; off += (bytes + 255) & ~(size_t)255; return r; };
  p.proj = (bf16_t*)take((size_t)NT * PW * 2);
  p.vt = (bf16_t*)take((size_t)NT * 512 * 2);
  p.xb = (bf16_t*)take((size_t)NT * 1024 * 2);
  p.wt_in = (bf16_t*)take((size_t)4 * 5120 * 1024 * 2);
  p.wt_out = (bf16_t*)take((size_t)4 * 1024 * 2048 * 2);
  p.wt_glu = (bf16_t*)take((size_t)4 * 1024 * 512 * 2);
  p.wt_mem = (bf16_t*)take((size_t)4 * 1024 * 1024 * 2);
  p.memn = (bf16_t*)take((size_t)4 * 1024 * 1024 * 2);
  p.memk = (bf16_t*)take((size_t)4 * 1024 * 512 * 2);
  p.memvt = (bf16_t*)take((size_t)4 * 1024 * 512 * 2);
  p.rowss = (float*)take((size_t)5 * 16 * NT * 4);
  p.ropetab = (float*)take((size_t)NT * 16 * 4);
  p.s5par = (float*)take((size_t)4 * 32 * 36 * 64 * 4);
  p.s5st = (float*)take((size_t)4 * 32 * 128 * 128 * 4);
  p.lrust = (float*)take((size_t)4 * 128 * 512 * 2 * 4);
  p.lamv = (float*)take(256);
  p.s5bt = (bf16_t*)take((size_t)4 * 32 * 128 * 32 * 2);
  p.ctr = (unsigned*)take(1024);
  p.bar = (unsigned*)take((size_t)XCD_BAR_WORDS * 4);
  if (off > ws_size) { fprintf(stderr, "workspace too small: need %zu have %zu\n", off, ws_size); return; }
  static int grid_blocks = 0;
  if (!grid_blocks) {
    int dev = 0, cus = 0, per_cu = 0;
    hipGetDevice(&dev);
    hipDeviceGetAttribute(&cus, hipDeviceAttributeMultiprocessorCount, dev);
    hipFuncSetAttribute((const void*)hymba_forward, hipFuncAttributeMaxDynamicSharedMemorySize, LDS_BYTES);
    hipOccupancyMaxActiveBlocksPerMultiprocessor(&per_cu, hymba_forward, 256, LDS_BYTES);
    if (per_cu < 1) per_cu = 1;
    if (per_cu > 2) per_cu = 2;
    grid_blocks = cus * per_cu;
  }
  hipMemsetAsync(p.bar, 0, (size_t)XCD_BAR_WORDS * 4, stream);
  void* args[] = {&p};
  hipError_t e = hipLaunchCooperativeKernel((const void*)hymba_forward, dim3(grid_blocks), dim3(256), args, LDS_BYTES, stream);
  if (e != hipSuccess) fprintf(stderr, "cooperative launch failed: %s (grid %d)\n", hipGetErrorString(e), grid_blocks);
}
```

```cpp
#include <hip/hip_runtime.h>
#include <hip/hip_cooperative_groups.h>
#include <cstdio>
namespace cg = cooperative_groups;

typedef unsigned short bf16_t;
typedef __attribute__((ext_vector_type(8))) short bf16x8;
typedef __attribute__((ext_vector_type(4))) short s16x4;
typedef __attribute__((ext_vector_type(4))) float f32x4;

#define DI __device__ __forceinline__
#define MFMA16(a, b, c) __builtin_amdgcn_mfma_f32_16x16x32_bf16((a), (b), (c), 0, 0, 0)

constexpr int NT = 32768;
constexpr int SEQ = 8192;
constexpr int PW = 4608;
constexpr int C_AU = 0, C_AG = 512, C_Q = 1024, C_K = 1536, C_BG = 2048, C_CX = 2560, C_CG = 3072, C_MQ = 3584, C_MG = 4096;
constexpr int LDS_BYTES = 73728 + 64 + 1024;

struct Params {
  const float *x, *mem; const int* pos;
  const float *norm_g, *w_in, *w_out, *s5_lre, *s5_lim, *s5_logdt, *s5_bre, *s5_bim, *s5_cre, *s5_cim, *s5_d, *s5_wglu;
  const float *da_q1, *da_k1, *da_q2, *da_k2, *da_g;
  const float *conv_w, *conv_b, *lru_wa, *lru_ba, *lru_wx, *lru_bx, *lru_lam, *memng, *w_memkv, *fng;
  float* out;
  bf16_t *proj, *vt, *xb, *wt_in, *wt_out, *wt_glu, *wt_mem, *memn, *memk, *memvt;
  float *rowss, *ropetab, *s5par, *s5st, *lrust, *lamv;
  bf16_t* s5bt;
  unsigned* ctr;
  unsigned* bar;
};

typedef __bf16 bf2_t __attribute__((ext_vector_type(2)));
typedef float f2_t __attribute__((ext_vector_type(2)));
DI unsigned pack2(float a, float b) { f2_t v = {a, b}; return __builtin_bit_cast(unsigned, __builtin_convertvector(v, bf2_t)); }
DI bf16_t f2bf(float x) { return (bf16_t)(pack2(x, 0.f) & 0xffffu); }
DI float bf2f(bf16_t h) { return __uint_as_float(((unsigned)h) << 16); }
DI float sigmoidf_(float x) { return 1.f / (1.f + __expf(-x)); }
DI float siluf_(float x) { return x / (1.f + __expf(-x)); }
DI int opaque_tid() { int t = threadIdx.x; asm volatile("" : "+v"(t)); return t; }
DI float quadmax(float x) {
  auto r = __builtin_amdgcn_permlane16_swap(__float_as_uint(x), __float_as_uint(x), false, false);
  const float m = fmaxf(__uint_as_float(r[0]), __uint_as_float(r[1]));
  auto q = __builtin_amdgcn_permlane32_swap(__float_as_uint(m), __float_as_uint(m), false, false);
  return fmaxf(__uint_as_float(q[0]), __uint_as_float(q[1]));
}
DI float quadsum(float x) {
  auto r = __builtin_amdgcn_permlane16_swap(__float_as_uint(x), __float_as_uint(x), false, false);
  const float m = __uint_as_float(r[0]) + __uint_as_float(r[1]);
  auto q = __builtin_amdgcn_permlane32_swap(__float_as_uint(m), __float_as_uint(m), false, false);
  return __uint_as_float(q[0]) + __uint_as_float(q[1]);
}
DI float sum16(const float* base, int row) { float t = 0.f;
#pragma unroll
  for (int k = 0; k < 16; ++k) t += base[(size_t)k * NT + row];
  return t; }
DI int swz(int row, int c) { return c ^ ((row >> 1) & 7); }

#define XB_TMO      128
#define XB_XCNT(j)  (256  + 64 * (j))
#define XB_XSUB(j)  (1280 + 64 * (j))
#define XB_XGEN(j)  (2304 + 64 * (j))
#define XB_TOP      3328
#define XB_TOPGEN   3392
#define XCD_BAR_WORDS 3456
#define XB_SPIN_CAP (1u << 18)
#define LAS __attribute__((address_space(3)))

__device__ __forceinline__ unsigned xb_ld(unsigned* p)              { return __hip_atomic_load(p, __ATOMIC_RELAXED, __HIP_MEMORY_SCOPE_AGENT); }
__device__ __forceinline__ unsigned xb_add(unsigned* p, unsigned v) { return __hip_atomic_fetch_add(p, v, __ATOMIC_RELAXED, __HIP_MEMORY_SCOPE_AGENT); }
__device__ __forceinline__ unsigned xb_xcc_id() { return (unsigned)__builtin_amdgcn_s_getreg((3 << 11) | 20) & 0xFu; }
#define XB_SPIN(cond, bar) do { unsigned _sp = 0; while (cond) { __builtin_amdgcn_s_sleep(1); \
    if ((++_sp & 255u) == 0u) { if (xb_ld(&(bar)[XB_TMO])) break; if (_sp > XB_SPIN_CAP) { atomicAdd(&(bar)[XB_TMO], 1u); break; } } } } while (0)

struct XcdBarrier {
    unsigned* bar; unsigned x;
    volatile LAS unsigned* st;
};

__device__ __forceinline__ XcdBarrier xcd_barrier_post(unsigned* bar, volatile LAS unsigned* st) {
    XcdBarrier b; b.bar = bar; b.x = xb_xcc_id(); b.st = st;
    if (threadIdx.x == 0) (void)xb_add(&bar[XB_XCNT(b.x)], 1u);
    return b;
}
__device__ __forceinline__ void xcd_barrier_complete(unsigned* bar, unsigned x, unsigned& nloc, unsigned& nx) {
    const unsigned G = gridDim.x * gridDim.y * gridDim.z;
    unsigned sum, cnt, mine, sp = 0u;
    for (;;) {
        sum = 0u; cnt = 0u; mine = 0u;
#pragma unroll
        for (unsigned j = 0; j < 16; ++j) { const unsigned c = xb_ld(&bar[XB_XCNT(j)]); sum += c; cnt += (c > 0u) ? 1u : 0u; mine = (j == x) ? c : mine; }
        if (sum == G) break;
        __builtin_amdgcn_s_sleep(1);
        if ((++sp & 255u) == 0u) { if (xb_ld(&bar[XB_TMO])) break; if (sp > XB_SPIN_CAP) { atomicAdd(&bar[XB_TMO], 1u); break; } }
    }
    nloc = mine > 0u ? mine : 1u; nx = cnt > 0u ? cnt : 1u;
}

__device__ __forceinline__ void xcd_barrier(const XcdBarrier& b) {
    asm volatile("s_waitcnt vmcnt(0)" ::: "memory");
    __syncthreads();
    if (threadIdx.x == 0) {
        unsigned* bar = b.bar;
        __builtin_amdgcn_s_waitcnt(0);
        unsigned nloc = b.st[0], nx = b.st[1];
        if (nloc == 0u) { xcd_barrier_complete(bar, b.x, nloc, nx); b.st[0] = nloc; b.st[1] = nx; }
        const unsigned old = xb_add(&bar[XB_XSUB(b.x)], 1u);
        const unsigned gen = old / nloc;
        if (old + 1u == (gen + 1u) * nloc) {
            __builtin_amdgcn_fence(__ATOMIC_RELEASE, "agent");
            asm volatile("s_waitcnt vmcnt(0)" ::: "memory");
            const unsigned og = xb_add(&bar[XB_TOP], 1u);
            const unsigned tg = og / nx;
            if (og + 1u == (tg + 1u) * nx) xb_add(&bar[XB_TOPGEN], 1u);
            else XB_SPIN(xb_ld(&bar[XB_TOPGEN]) == tg, bar);
            __builtin_amdgcn_fence(__ATOMIC_ACQUIRE, "agent");
            xb_add(&bar[XB_XGEN(b.x)], 1u);
            asm volatile("s_waitcnt vmcnt(0)" ::: "memory");
        } else {
            XB_SPIN(xb_ld(&bar[XB_XGEN(b.x)]) == gen, bar);
            __builtin_amdgcn_fence(__ATOMIC_ACQUIRE, "agent");
            asm volatile("s_waitcnt vmcnt(0)" ::: "memory");
        }
    }
    __syncthreads();
}


struct GemmArgs {
  const bf16_t* A; int lda; int mix;
  const bf16_t* Bt; int K;
};
DI int mixcol(int k0) { int g = k0 >> 9; int s = (g == 0) ? C_AG : (g == 1) ? C_BG : (g == 2) ? C_CG : C_MG; return s + (k0 & 511); }

enum { EPI_INPROJ = 0, EPI_MEMKV = 1, EPI_GLU = 2, EPI_OUT = 3 };

struct EpiArgs {
  const Params* p; int layer;
  const float* rowss;
  const float* xsrc;
  const float* gnext;
  float* rowss_next;
};

DI int swz64(int row, int c) { return c ^ ((0x1320 >> (((row >> 2) & 3) * 4)) & 3); }

template <int EPI>
DI void gemm_tile(const GemmArgs& ga, const EpiArgs& ea, int m0, int n0, char* lds) {
  const int tid = opaque_tid(), lane = tid & 63, w = tid >> 6;
  const int wm = w >> 1, wn = w & 1, c16 = lane & 15, quad = lane >> 4;
  f32x4 acc[8][4];
#pragma unroll
  for (int i = 0; i < 8; ++i)
#pragma unroll
    for (int j = 0; j < 4; ++j) acc[i][j] = f32x4{0.f, 0.f, 0.f, 0.f};
  const int K = ga.K, nk = K >> 5;
  float rowsum = 0.f;
  if constexpr (EPI == EPI_INPROJ) rowsum = sum16(ea.rowss, m0 + tid);
  const int prow = lane >> 2, pch = lane & 3;
  const bf16_t* gsrc[6];
  int ldsoff[6];
#pragma unroll
  for (int i = 0; i < 6; ++i) {
    const int pi = w * 6 + i;
    if (pi < 16) {
      const int row = pi * 16 + prow;
      gsrc[i] = ga.A + (size_t)(m0 + row) * ga.lda + swz64(row, pch) * 8;
      ldsoff[i] = pi * 1024 + lane * 16;
    } else {
      const int row = (pi - 16) * 16 + prow;
      gsrc[i] = ga.Bt + (size_t)(n0 + row) * K + swz64(row, pch) * 8;
      ldsoff[i] = pi * 1024 + lane * 16;
    }
  }
  auto dma = [&](int kt, int buf) {
    const int k0 = kt << 5;
    const int ac = ga.mix ? mixcol(k0) : k0;
    char* base = lds + buf * 24576;
#pragma unroll
    for (int i = 0; i < 6; ++i) {
      const int pi = w * 6 + i;
      __builtin_amdgcn_global_load_lds((const unsigned*)(gsrc[i] + ((pi < 16) ? ac : k0)), (unsigned*)(base + ldsoff[i]), 16, 0, 0);
    }
  };
  __syncthreads();
  dma(0, 0);
  if (nk > 1) dma(1, 1);
  for (int kt = 0; kt < nk; ++kt) {
    if (kt + 1 < nk) asm volatile("s_waitcnt vmcnt(6)" ::: "memory");
    else asm volatile("s_waitcnt vmcnt(0)" ::: "memory");
    __builtin_amdgcn_s_barrier();
    const char* Ab = lds + (kt % 3) * 24576 + wm * 128 * 64;
    const char* Bb = lds + (kt % 3) * 24576 + 16384 + wn * 64 * 64;
    bf16x8 af[8], bfr[4];
    const int ch = swz64(c16, quad) << 4;
#pragma unroll
    for (int nt = 0; nt < 4; ++nt) bfr[nt] = *(const bf16x8*)(Bb + (nt * 16 + c16) * 64 + ch);
#pragma unroll
    for (int mt = 0; mt < 2; ++mt) af[mt] = *(const bf16x8*)(Ab + (mt * 16 + c16) * 64 + ch);
    __builtin_amdgcn_sched_barrier(0);
    if (kt + 2 < nk) dma(kt + 2, (kt + 2) % 3);
    __builtin_amdgcn_sched_barrier(0);
#pragma unroll
    for (int g = 0; g < 4; ++g) {
      if (g < 3) {
#pragma unroll
        for (int mt = 2 * g + 2; mt < 2 * g + 4; ++mt) af[mt] = *(const bf16x8*)(Ab + (mt * 16 + c16) * 64 + ch);
      }
#pragma unroll
      for (int mt = 2 * g; mt < 2 * g + 2; ++mt)
#pragma unroll
        for (int nt = 0; nt < 4; ++nt) acc[mt][nt] = MFMA16(bfr[nt], af[mt], acc[mt][nt]);
      __builtin_amdgcn_sched_barrier(0);
    }
  }
  const Params& p = *ea.p;
  if constexpr (EPI == EPI_INPROJ) {
    const int slot = n0 >> 9;
    const int dbase = (slot < 4) ? slot * 512 : (slot - 1) * 512;
    float* rsc = (float*)(lds + 73728 + 64);
    rsc[tid] = rsqrtf(rowsum * (1.f / 1024.f) + 1e-6f);
    __syncthreads();
#pragma unroll
    for (int mt = 0; mt < 8; ++mt) {
      const int row = m0 + wm * 128 + mt * 16 + c16;
      const float rs = rsc[wm * 128 + mt * 16 + c16];
#pragma unroll
      for (int nt = 0; nt < 4; ++nt) {
        const int cc0 = (n0 & 511) + wn * 64 + nt * 16 + quad * 4;
        float v[4];
#pragma unroll
        for (int r = 0; r < 4; ++r) v[r] = acc[mt][nt][r] * rs;
        if (slot == 4) {
          const int b = row >> 13, l = row & 8191, h = cc0 >> 7, dv0 = cc0 & 127;
          const int lp = (l & ~31) | (((l >> 2) & 3) << 3) | (((l >> 4) & 1) << 2) | (l & 3);
#pragma unroll
          for (int r = 0; r < 4; ++r) p.vt[((size_t)((b * 4 + h) * 128 + dv0 + r)) * SEQ + lp] = f2bf(v[r]);
        } else {
          if (slot == 2 || slot == 3) {
            if (nt == 0) {
              const float* cs = p.ropetab + (size_t)row * 16 + (quad & 1) * 4;
              const float4 co = *(const float4*)cs, si = *(const float4*)(cs + 8);
              const float cov[4] = {co.x, co.y, co.z, co.w}, siv[4] = {si.x, si.y, si.z, si.w};
#pragma unroll
              for (int r = 0; r < 4; ++r) {
                const float pr = __shfl_xor(v[r], 32);
                v[r] = (quad < 2) ? (v[r] * cov[r] - pr * siv[r]) : (v[r] * cov[r] + pr * siv[r]);
              }
            }
            if (slot == 2) {
#pragma unroll
              for (int r = 0; r < 4; ++r) v[r] *= 0.18033688011112042f;
            }
          } else if (slot == 1 || slot == 5 || slot == 7 || slot == 9) {
#pragma unroll
            for (int r = 0; r < 4; ++r) v[r] = siluf_(v[r]);
          } else if (slot == 8) {
#pragma unroll
            for (int r = 0; r < 4; ++r) v[r] *= 0.12751743082459868f;
          }
          uint2 pk; pk.x = pack2(v[0], v[1]); pk.y = pack2(v[2], v[3]);
          *(uint2*)(p.proj + (size_t)row * PW + dbase + cc0) = pk;
        }
      }
    }
  } else if constexpr (EPI == EPI_MEMKV) {
    const int lm = ea.layer;
#pragma unroll
    for (int mt = 0; mt < 8; ++mt) {
      const int row = m0 + wm * 128 + mt * 16 + c16;
#pragma unroll
      for (int nt = 0; nt < 4; ++nt) {
        const int col0 = n0 + wn * 64 + nt * 16 + quad * 4;
        if (col0 < 512) {
          uint2 pk; pk.x = pack2(acc[mt][nt][0], acc[mt][nt][1]); pk.y = pack2(acc[mt][nt][2], acc[mt][nt][3]);
          *(uint2*)(p.memk + ((size_t)lm * 1024 + row) * 512 + col0) = pk;
        } else {
          const int cc0 = col0 - 512, h = cc0 >> 7, dv0 = cc0 & 127, b = row >> 8, m = row & 255;
          const int mp = (m & ~31) | (((m >> 2) & 3) << 3) | (((m >> 4) & 1) << 2) | (m & 3);
#pragma unroll
          for (int r = 0; r < 4; ++r) p.memvt[((size_t)((lm * 4 + b) * 4 + h) * 128 + dv0 + r) * 256 + mp] = f2bf(acc[mt][nt][r]);
        }
      }
    }
  } else if constexpr (EPI == EPI_GLU) {
    const int blk = (n0 + wn * 64) >> 6;
#pragma unroll
    for (int mt = 0; mt < 8; ++mt) {
      const int row = m0 + wm * 128 + mt * 16 + c16;
#pragma unroll
      for (int nt = 0; nt < 2; ++nt) {
        const int j0 = blk * 32 + nt * 16 + quad * 4;
        uint2* q = (uint2*)(p.proj + (size_t)row * PW + C_AG + j0);
        const uint2 gv = *q;
        const float g0 = __uint_as_float(gv.x << 16), g1 = __uint_as_float(gv.x & 0xffff0000u);
        const float g2 = __uint_as_float(gv.y << 16), g3 = __uint_as_float(gv.y & 0xffff0000u);
        uint2 o;
        o.x = pack2(acc[mt][nt][0] * sigmoidf_(acc[mt][nt + 2][0]) * g0, acc[mt][nt][1] * sigmoidf_(acc[mt][nt + 2][1]) * g1);
        o.y = pack2(acc[mt][nt][2] * sigmoidf_(acc[mt][nt + 2][2]) * g2, acc[mt][nt][3] * sigmoidf_(acc[mt][nt + 2][3]) * g3);
        *q = o;
      }
    }
  } else {
#pragma unroll
    for (int mt = 0; mt < 8; ++mt) {
      const int row = m0 + wm * 128 + mt * 16 + c16;
      float ss = 0.f;
#pragma unroll
      for (int nt = 0; nt < 4; ++nt) {
        const int col0 = n0 + wn * 64 + nt * 16 + quad * 4;
        const size_t idx = (size_t)row * 1024 + col0;
        float4 xo;
        if (ea.xsrc) xo = *(const float4*)(ea.xsrc + idx);
        else {
          const uint2 u = *(const uint2*)(p.xb + idx);
          xo = make_float4(__uint_as_float(u.x << 16), __uint_as_float(u.x & 0xffff0000u), __uint_as_float(u.y << 16), __uint_as_float(u.y & 0xffff0000u));
        }
        float4 xn;
        xn.x = xo.x + acc[mt][nt][0]; xn.y = xo.y + acc[mt][nt][1]; xn.z = xo.z + acc[mt][nt][2]; xn.w = xo.w + acc[mt][nt][3];
        ss += xn.x * xn.x + xn.y * xn.y + xn.z * xn.z + xn.w * xn.w;
        {
          uint2 o; o.x = pack2(xn.x, xn.y); o.y = pack2(xn.z, xn.w);
          *(uint2*)(p.xb + idx) = o;
        }
      }
      ss = quadsum(ss);
      if (quad == 0) ea.rowss_next[(size_t)((n0 >> 7) * 2 + wn) * NT + row] = ss;
    }
  }
}

template <int NS, int QT>
struct AttnState {
  f32x4 O[NS][8][QT];
  float l[NS][QT];
};

template <int NS, int QT>
DI void attn_core(AttnState<NS, QT>& st, const bf16_t* qp, int qstride, const bf16_t* kp, int kstride,
                          const bf16_t* vtp, int vtstride, int nkt, int qpos0, bool causal, char* lds) {
  const int tid = opaque_tid(), lane = tid & 63, w = tid >> 6, c16 = lane & 15, quad = lane >> 4;
  bf16x8 qf[QT][4];
#pragma unroll
  for (int qt = 0; qt < QT; ++qt)
#pragma unroll
    for (int f = 0; f < 4; ++f)
      qf[qt][f] = *(const bf16x8*)(qp + (size_t)(w * 16 * QT + qt * 16 + c16) * qstride + f * 32 + quad * 8);
  float m[NS][QT];
#pragma unroll
  for (int s = 0; s < NS; ++s)
#pragma unroll
    for (int qt = 0; qt < QT; ++qt) {
      m[s][qt] = 0.f; st.l[s][qt] = 0.f;
#pragma unroll
      for (int d = 0; d < 8; ++d) st.O[s][d][qt] = f32x4{0.f, 0.f, 0.f, 0.f};
    }
  const int prow = lane >> 3, pch = lane & 7;
  unsigned koff[4], voff[4];
#pragma unroll
  for (int i = 0; i < 4; ++i) {
    const int pi = w * 4 + i;
    { const int row = (pi & 7) * 8 + prow, sub = pi >> 3, c = pch ^ ((row >> 1) & 7);
      koff[i] = (unsigned)((row * kstride + sub * 64 + c * 8) * 2); }
    { const int row = pi * 8 + prow, c = pch ^ ((row >> 1) & 7);
      voff[i] = (unsigned)((row * vtstride + c * 8) * 2); }
  }
  auto gload = [&](int kt, int buf) {
    char* base = lds + buf * 32768;
    const char* kt_base = (const char*)(kp + (size_t)kt * 64 * kstride);
    const char* vt_base = (const char*)(vtp + (size_t)kt * 64);
#pragma unroll
    for (int i = 0; i < 4; ++i)
      __builtin_amdgcn_global_load_lds((const unsigned*)(kt_base + koff[i]), (unsigned*)(base + (w * 4 + i) * 1024 + lane * 16), 16, 0, 0);
#pragma unroll
    for (int i = 0; i < 4; ++i)
      __builtin_amdgcn_global_load_lds((const unsigned*)(vt_base + voff[i]), (unsigned*)(base + 16384 + (w * 4 + i) * 1024 + lane * 16), 16, 0, 0);
  };
  const int qw0 = qpos0 + w * 16 * QT;
  gload(0, 0); __syncthreads();
  for (int kt = 0; kt < nkt; ++kt) {
    if (kt + 1 < nkt) gload(kt + 1, (kt + 1) & 1);
    const char* Kb = lds + (kt & 1) * 32768;
    const char* Vb = Kb + 16384;
    const bool active = !causal || (kt * 64 <= qw0 + 16 * QT - 1);
    if (active) {
      const bool need_mask = causal && (kt * 64 + 63 > qw0);
      bf16x8 pf[NS][2][QT];
      f32x4 S[NS][4][QT];
#pragma unroll
      for (int s = 0; s < NS; ++s)
#pragma unroll
        for (int a = 0; a < 4; ++a)
#pragma unroll
          for (int qt = 0; qt < QT; ++qt) { const float nm = -m[s][qt]; S[s][a][qt] = f32x4{nm, nm, nm, nm}; }
      bf16x8 kfa[8], kfb[8], vfa[8], vfb[8];
#pragma unroll
      for (int i = 0; i < 8; ++i) {
        const int ksub = i & 3, row = ksub * 16 + c16, chunk = (i >> 2) * 4 + quad;
        kfa[i] = *(const bf16x8*)(Kb + row * 128 + (swz(row, chunk) << 4));
      }
      __builtin_amdgcn_sched_barrier(0);
#pragma unroll
      for (int i = 0; i < 8; ++i) {
        const int ksub = i & 3, row = ksub * 16 + c16, chunk = (i >> 2) * 4 + quad;
        kfb[i] = *(const bf16x8*)(Kb + 8192 + row * 128 + (swz(row, chunk) << 4));
      }
#pragma unroll
      for (int i = 0; i < 8; ++i)
#pragma unroll
        for (int qt = 0; qt < QT; ++qt) S[0][i & 3][qt] = MFMA16(kfa[i], qf[qt][i >> 2], S[0][i & 3][qt]);
      __builtin_amdgcn_sched_barrier(0);
#pragma unroll
      for (int d = 0; d < 8; ++d) {
        const int row = d * 16 + c16;
        vfa[d] = *(const bf16x8*)(Vb + row * 128 + (swz(row, quad) << 4));
      }
#pragma unroll
      for (int i = 0; i < 8; ++i)
#pragma unroll
        for (int qt = 0; qt < QT; ++qt) S[NS - 1][i & 3][qt] = MFMA16(kfb[i], qf[qt][2 + (i >> 2)], S[NS - 1][i & 3][qt]);
      if (need_mask) {
#pragma unroll
        for (int s = 0; s < NS; ++s)
#pragma unroll
          for (int ksub = 0; ksub < 4; ++ksub)
#pragma unroll
            for (int qt = 0; qt < QT; ++qt)
#pragma unroll
              for (int r = 0; r < 4; ++r) {
                const int key = kt * 64 + ksub * 16 + quad * 4 + r;
                const int qpos = qw0 + qt * 16 + c16;
                if (key > qpos) S[s][ksub][qt][r] = -1e30f;
              }
      }
      float mx[NS][QT];
      bool need = false;
#pragma unroll
      for (int s = 0; s < NS; ++s)
#pragma unroll
        for (int qt = 0; qt < QT; ++qt) {
          float v = -1e30f;
#pragma unroll
          for (int ksub = 0; ksub < 4; ++ksub)
#pragma unroll
            for (int r = 0; r < 4; ++r) v = fmaxf(v, S[s][ksub][qt][r]);
          v = quadmax(v);
          mx[s][qt] = v;
          need = need || (v > 8.f);
        }
      if (__any(need) || kt == 0) {
#pragma unroll
        for (int s = 0; s < NS; ++s)
#pragma unroll
          for (int qt = 0; qt < QT; ++qt) {
            const float delta = (kt == 0) ? mx[s][qt] : fmaxf(mx[s][qt], 0.f);
            const float alpha = (kt == 0) ? 1.f : __builtin_amdgcn_exp2f(-delta);
            m[s][qt] += delta;
            st.l[s][qt] *= alpha;
#pragma unroll
            for (int d = 0; d < 8; ++d) st.O[s][d][qt] *= alpha;
#pragma unroll
            for (int ksub = 0; ksub < 4; ++ksub)
#pragma unroll
              for (int r = 0; r < 4; ++r) S[s][ksub][qt][r] -= delta;
          }
      }
#pragma unroll
      for (int s = 0; s < NS; ++s)
#pragma unroll
        for (int qt = 0; qt < QT; ++qt) {
          float psum = 0.f;
#pragma unroll
          for (int ksub = 0; ksub < 4; ++ksub)
#pragma unroll
            for (int r = 0; r < 4; ++r) { const float e = __builtin_amdgcn_exp2f(S[s][ksub][qt][r]); S[s][ksub][qt][r] = e; psum += e; }
          st.l[s][qt] += psum;
#pragma unroll
          for (int kk = 0; kk < 2; ++kk) {
            union { unsigned u[4]; bf16x8 v; } pk;
            pk.u[0] = pack2(S[s][2 * kk][qt][0], S[s][2 * kk][qt][1]);
            pk.u[1] = pack2(S[s][2 * kk][qt][2], S[s][2 * kk][qt][3]);
            pk.u[2] = pack2(S[s][2 * kk + 1][qt][0], S[s][2 * kk + 1][qt][1]);
            pk.u[3] = pack2(S[s][2 * kk + 1][qt][2], S[s][2 * kk + 1][qt][3]);
            pf[s][kk][qt] = pk.v;
          }
        }
      __builtin_amdgcn_sched_barrier(0);
#pragma unroll
      for (int d = 0; d < 8; ++d) {
        const int row = d * 16 + c16;
        vfb[d] = *(const bf16x8*)(Vb + row * 128 + (swz(row, 4 + quad) << 4));
      }
#pragma unroll
      for (int d = 0; d < 8; ++d)
#pragma unroll
        for (int s = 0; s < NS; ++s)
#pragma unroll
          for (int qt = 0; qt < QT; ++qt) st.O[s][d][qt] = MFMA16(vfa[d], pf[s][0][qt], st.O[s][d][qt]);
      __builtin_amdgcn_sched_barrier(0);
#pragma unroll
      for (int d = 0; d < 8; ++d)
#pragma unroll
        for (int s = 0; s < NS; ++s)
#pragma unroll
          for (int qt = 0; qt < QT; ++qt) st.O[s][d][qt] = MFMA16(vfb[d], pf[s][1][qt], st.O[s][d][qt]);
    }
    __syncthreads();
  }
#pragma unroll
  for (int s = 0; s < NS; ++s)
#pragma unroll
    for (int qt = 0; qt < QT; ++qt) {
      st.l[s][qt] = quadsum(st.l[s][qt]);
    }
}

DI void diff_attn_item(const Params& p, int layer, int qb, int bh, char* lds) {
  const int b = bh >> 2, h = bh & 3;
  const int tok0 = b * SEQ + qb * 64;
  const int tid_ = opaque_tid(), lane = tid_ & 63, w = tid_ >> 6, c16 = lane & 15, quad = lane >> 4;
  const int sidx = w & 1, g = w >> 1;
  const bf16_t* qp = p.proj + (size_t)tok0 * PW + C_Q + h * 128;
  const bf16_t* kp = p.proj + (size_t)b * SEQ * PW + C_K + h * 128;
  const bf16_t* vtp = p.vt + (size_t)((b * 4 + h) * 128) * SEQ;
  const int nkt = qb + 1;
  bf16x8 qf[2][2];
#pragma unroll
  for (int qt = 0; qt < 2; ++qt)
#pragma unroll
    for (int ff = 0; ff < 2; ++ff)
      qf[qt][ff] = *(const bf16x8*)(qp + (size_t)(g * 32 + qt * 16 + c16) * PW + (sidx * 2 + ff) * 32 + quad * 8);
  float m[2], l[2];
  f32x4 O[8][2];
#pragma unroll
  for (int qt = 0; qt < 2; ++qt) {
    m[qt] = 0.f; l[qt] = 0.f;
#pragma unroll
    for (int d = 0; d < 8; ++d) O[d][qt] = f32x4{0.f, 0.f, 0.f, 0.f};
  }
  const int prow = lane >> 3, pch = lane & 7;
  unsigned koff[4], voff[4];
#pragma unroll
  for (int i = 0; i < 4; ++i) {
    const int pi = w * 4 + i;
    { const int row = (pi & 7) * 8 + prow, sub = pi >> 3, c = pch ^ ((row >> 1) & 7);
      koff[i] = (unsigned)((row * PW + sub * 64 + c * 8) * 2); }
    { const int row = pi * 8 + prow, c = pch ^ ((row >> 1) & 7);
      voff[i] = (unsigned)((row * SEQ + c * 8) * 2); }
  }
  auto gload = [&](int kt, int buf) {
    char* base = lds + buf * 32768;
    const char* kt_base = (const char*)(kp + (size_t)kt * 64 * PW);
    const char* vt_base = (const char*)(vtp + (size_t)kt * 64);
#pragma unroll
    for (int i = 0; i < 4; ++i)
      __builtin_amdgcn_global_load_lds((const unsigned*)(kt_base + koff[i]), (unsigned*)(base + (w * 4 + i) * 1024 + lane * 16), 16, 0, 0);
#pragma unroll
    for (int i = 0; i < 4; ++i)
      __builtin_amdgcn_global_load_lds((const unsigned*)(vt_base + voff[i]), (unsigned*)(base + 16384 + (w * 4 + i) * 1024 + lane * 16), 16, 0, 0);
  };
  const int qw0 = qb * 64 + g * 32;
  gload(0, 0); __syncthreads();
  for (int kt = 0; kt < nkt; ++kt) {
    if (kt + 1 < nkt) gload(kt + 1, (kt + 1) & 1);
    const char* Kb = lds + (kt & 1) * 32768 + sidx * 8192;
    const char* Vb = lds + (kt & 1) * 32768 + 16384;
    if (kt * 64 <= qw0 + 31) {
      f32x4 S[4][2];
#pragma unroll
      for (int a = 0; a < 4; ++a)
#pragma unroll
        for (int qt = 0; qt < 2; ++qt) { const float nm = -m[qt]; S[a][qt] = f32x4{nm, nm, nm, nm}; }
      bf16x8 kf[8], vfa[8], vfb[8];
#pragma unroll
      for (int i = 0; i < 8; ++i) {
        const int row = (i & 3) * 16 + c16, chunk = (i >> 2) * 4 + quad;
        kf[i] = *(const bf16x8*)(Kb + row * 128 + (swz(row, chunk) << 4));
      }
      __builtin_amdgcn_sched_barrier(0);
#pragma unroll
      for (int d = 0; d < 8; ++d) { const int row = d * 16 + c16; vfa[d] = *(const bf16x8*)(Vb + row * 128 + (swz(row, quad) << 4)); }
#pragma unroll
      for (int i = 0; i < 8; ++i)
#pragma unroll
        for (int qt = 0; qt < 2; ++qt) S[i & 3][qt] = MFMA16(kf[i], qf[qt][i >> 2], S[i & 3][qt]);
      __builtin_amdgcn_sched_barrier(0);
      if (kt * 64 + 63 > qw0) {
#pragma unroll
        for (int ksub = 0; ksub < 4; ++ksub)
#pragma unroll
          for (int qt = 0; qt < 2; ++qt)
#pragma unroll
            for (int r = 0; r < 4; ++r) {
              const int key = kt * 64 + ksub * 16 + quad * 4 + r;
              if (key > qw0 + qt * 16 + c16) S[ksub][qt][r] = -1e30f;
            }
      }
      float mx[2];
      bool need = false;
#pragma unroll
      for (int qt = 0; qt < 2; ++qt) {
        float v = -1e30f;
#pragma unroll
        for (int ksub = 0; ksub < 4; ++ksub)
#pragma unroll
          for (int r = 0; r < 4; ++r) v = fmaxf(v, S[ksub][qt][r]);
        v = quadmax(v);
        mx[qt] = v;
        need = need || (v > 8.f);
      }
      if (__any(need) || kt == 0) {
#pragma unroll
        for (int qt = 0; qt < 2; ++qt) {
          const float delta = (kt == 0) ? mx[qt] : fmaxf(mx[qt], 0.f);
          const float alpha = (kt == 0) ? 1.f : __builtin_amdgcn_exp2f(-delta);
          m[qt] += delta;
          l[qt] *= alpha;
#pragma unroll
          for (int d = 0; d < 8; ++d) O[d][qt] *= alpha;
#pragma unroll
          for (int ksub = 0; ksub < 4; ++ksub)
#pragma unroll
            for (int r = 0; r < 4; ++r) S[ksub][qt][r] -= delta;
        }
      }
      bf16x8 pf[2][2];
#pragma unroll
      for (int qt = 0; qt < 2; ++qt) {
        float psum = 0.f;
#pragma unroll
        for (int ksub = 0; ksub < 4; ++ksub)
#pragma unroll
          for (int r = 0; r < 4; ++r) { const float e = __builtin_amdgcn_exp2f(S[ksub][qt][r]); S[ksub][qt][r] = e; psum += e; }
        l[qt] += psum;
#pragma unroll
        for (int kk = 0; kk < 2; ++kk) {
          union { unsigned u[4]; bf16x8 v; } pk;
          pk.u[0] = pack2(S[2 * kk][qt][0], S[2 * kk][qt][1]);
          pk.u[1] = pack2(S[2 * kk][qt][2], S[2 * kk][qt][3]);
          pk.u[2] = pack2(S[2 * kk + 1][qt][0], S[2 * kk + 1][qt][1]);
          pk.u[3] = pack2(S[2 * kk + 1][qt][2], S[2 * kk + 1][qt][3]);
          pf[kk][qt] = pk.v;
        }
      }
      __builtin_amdgcn_sched_barrier(0);
#pragma unroll
      for (int d = 0; d < 8; ++d) { const int row = d * 16 + c16; vfb[d] = *(const bf16x8*)(Vb + row * 128 + (swz(row, 4 + quad) << 4)); }
#pragma unroll
      for (int d = 0; d < 8; ++d)
#pragma unroll
        for (int qt = 0; qt < 2; ++qt) O[d][qt] = MFMA16(vfa[d], pf[0][qt], O[d][qt]);
      __builtin_amdgcn_sched_barrier(0);
#pragma unroll
      for (int d = 0; d < 8; ++d)
#pragma unroll
        for (int qt = 0; qt < 2; ++qt) O[d][qt] = MFMA16(vfb[d], pf[1][qt], O[d][qt]);
    }
    __syncthreads();
  }
  const float lam = p.lamv[layer];
  const float lam_init = 0.8f - 0.6f * expf(-0.3f * (float)layer);
  float* xch = (float*)(lds + g * 16384);
  float cf[2];
#pragma unroll
  for (int qt = 0; qt < 2; ++qt) cf[qt] = ((sidx == 0) ? 1.f : lam) / quadsum(l[qt]);
  if (sidx == 1) {
#pragma unroll
    for (int d = 0; d < 8; ++d)
#pragma unroll
      for (int qt = 0; qt < 2; ++qt)
#pragma unroll
        for (int r = 0; r < 4; ++r) xch[((d * 2 + qt) * 4 + r) * 64 + lane] = O[d][qt][r] * cf[qt];
  }
  __syncthreads();
  if (sidx == 0) {
    const float* sg = p.da_g + layer * 128;
#pragma unroll
    for (int qt = 0; qt < 2; ++qt) {
      float ss = 0.f;
#pragma unroll
      for (int d = 0; d < 8; ++d)
#pragma unroll
        for (int r = 0; r < 4; ++r) {
          const float o = O[d][qt][r] * cf[qt] - xch[((d * 2 + qt) * 4 + r) * 64 + lane];
          O[d][qt][r] = o; ss += o * o;
        }
      ss = quadsum(ss);
      const float rn = rsqrtf(ss * (1.f / 128.f) + 1e-6f) * (1.f - lam_init);
      const int tok = tok0 + g * 32 + qt * 16 + c16;
#pragma unroll
      for (int d = 0; d < 8; ++d) {
        const int dv0 = d * 16 + quad * 4;
        bf16_t* gp = p.proj + (size_t)tok * PW + C_BG + h * 128 + dv0;
        const uint2 gv = *(const uint2*)gp;
        const float g0 = __uint_as_float(gv.x << 16), g1 = __uint_as_float(gv.x & 0xffff0000u);
        const float g2 = __uint_as_float(gv.y << 16), g3 = __uint_as_float(gv.y & 0xffff0000u);
        uint2 o;
        o.x = pack2(O[d][qt][0] * rn * sg[dv0] * g0, O[d][qt][1] * rn * sg[dv0 + 1] * g1);
        o.y = pack2(O[d][qt][2] * rn * sg[dv0 + 2] * g2, O[d][qt][3] * rn * sg[dv0 + 3] * g3);
        *(uint2*)gp = o;
      }
    }
  }
}

DI void mem_attn_item(const Params& p, int layer, int item, char* lds) {
  const int qb = item >> 4, bh = item & 15, b = bh >> 2, h = bh & 3;
  const int tok0 = b * SEQ + qb * 64;
  const int tid_ = opaque_tid(), lane = tid_ & 63, w = tid_ >> 6, c16 = lane & 15, quad = lane >> 4;
  AttnState<1, 1> st;
  attn_core<1, 1>(st, p.proj + (size_t)tok0 * PW + C_MQ + h * 128, PW,
               p.memk + ((size_t)layer * 1024 + b * 256) * 512 + h * 128, 512,
               p.memvt + ((size_t)((layer * 4 + b) * 4 + h) * 128) * 256, 256, 4, 0, false, lds);
#pragma unroll
  for (int qt = 0; qt < 1; ++qt) {
    const float i1 = 1.f / st.l[0][qt];
    const int tok = tok0 + w * 16 + qt * 16 + c16;
#pragma unroll
    for (int d = 0; d < 8; ++d) {
      const int dv0 = d * 16 + quad * 4;
      bf16_t* g = p.proj + (size_t)tok * PW + C_MG + h * 128 + dv0;
      const uint2 gv = *(const uint2*)g;
      const float g0 = __uint_as_float(gv.x << 16), g1 = __uint_as_float(gv.x & 0xffff0000u);
      const float g2 = __uint_as_float(gv.y << 16), g3 = __uint_as_float(gv.y & 0xffff0000u);
      uint2 o;
      o.x = pack2(st.O[0][d][qt][0] * i1 * g0, st.O[0][d][qt][1] * i1 * g1);
      o.y = pack2(st.O[0][d][qt][2] * i1 * g2, st.O[0][d][qt][3] * i1 * g3);
      *(uint2*)g = o;
    }
  }
}

DI float gelu_tanh(float x) {
  const float u = 0.7978845608028654f * (x + 0.044715f * x * x * x);
  const float t = 1.f - 2.f / (1.f + __expf(2.f * u));
  return 0.5f * x * (1.f + t);
}

template <bool FINAL>
DI void s5_item(const Params& p, int layer, int item, char* lds) {
  const int gq = item & 7, c = (item >> 3) & 127, b = item >> 10;
  const int tid_ = opaque_tid(), lane = tid_ & 63, w = tid_ >> 6, c16 = lane & 15, quad = lane >> 4;
  const int g = gq * 4 + w;
  const int tok0 = b * SEQ + c * 64;
  float* bu = (float*)(lds + w * 16384);
  char* xsb = lds + w * 16384 + 8192;
  bf16x8 bbf[8];
  {
    const bf16_t* bt = p.s5bt + (size_t)(layer * 32 + g) * 128 * 32;
#pragma unroll
    for (int nt = 0; nt < 8; ++nt) bbf[nt] = *(const bf16x8*)(bt + (nt * 16 + c16) * 32 + quad * 8);
  }
  const float* par = p.s5par + (size_t)((layer * 32 + g) * 36) * 64 + lane;
  const float are = par[0], aim = par[64];
  float xr = 0.f, xi = 0.f;
  float* stp = p.s5st + ((size_t)((b * 32 + g) * 128)) * 128 + lane;
  bf16x8 cf[FINAL ? 4 : 1];
  float dsk = 0.f;
  if constexpr (FINAL) {
    xr = stp[c * 128]; xi = stp[c * 128 + 64];
    const float* cr = p.s5_cre + (size_t)((layer * 32 + g) * 16 + c16) * 64;
    const float* ci = p.s5_cim + (size_t)((layer * 32 + g) * 16 + c16) * 64;
#pragma unroll
    for (int ks = 0; ks < 4; ++ks) {
      const float* src = ((ks < 2) ? cr : ci) + (ks & 1) * 32 + quad * 8;
      const float sg = (ks < 2) ? 1.f : -1.f;
      const float4 v0 = *(const float4*)src, v1 = *(const float4*)(src + 4);
      union { unsigned u[4]; bf16x8 v; } pk;
      pk.u[0] = pack2(sg * v0.x, sg * v0.y); pk.u[1] = pack2(sg * v0.z, sg * v0.w);
      pk.u[2] = pack2(sg * v1.x, sg * v1.y); pk.u[3] = pack2(sg * v1.z, sg * v1.w);
      cf[ks] = pk.v;
    }
    dsk = p.s5_d[(layer * 32 + g) * 16 + c16];
  }
  for (int sc = 0; sc < 4; ++sc) {
    const int tb = tok0 + sc * 16;
    bf16x8 uf = bf16x8{0, 0, 0, 0, 0, 0, 0, 0};
    if (quad < 2) uf = *(const bf16x8*)(p.proj + (size_t)(tb + c16) * PW + C_AU + g * 16 + quad * 8);
    float uo[FINAL ? 4 : 1];
    if constexpr (FINAL) {
#pragma unroll
      for (int r = 0; r < 4; ++r) uo[r] = bf2f(p.proj[(size_t)(tb + quad * 4 + r) * PW + C_AU + g * 16 + c16]);
    }
#pragma unroll
    for (int nt = 0; nt < 8; ++nt) {
      f32x4 acc = MFMA16(uf, bbf[nt], (f32x4{0.f, 0.f, 0.f, 0.f}));
#pragma unroll
      for (int r = 0; r < 4; ++r) bu[(quad * 4 + r) * 128 + nt * 16 + c16] = acc[r];
    }
    __syncthreads();
#pragma unroll
    for (int tt = 0; tt < 16; ++tt) {
      const float br_ = bu[tt * 128 + lane], bi_ = bu[tt * 128 + 64 + lane];
      const float nr = are * xr - aim * xi + br_;
      const float ni = are * xi + aim * xr + bi_;
      xr = nr; xi = ni;
      if constexpr (FINAL) {
        *(bf16_t*)(xsb + tt * 256 + ((((lane >> 3)) ^ tt) << 4) + (lane & 7) * 2) = f2bf(xr);
        *(bf16_t*)(xsb + tt * 256 + (((8 + (lane >> 3)) ^ tt) << 4) + (lane & 7) * 2) = f2bf(xi);
      }
    }
    if constexpr (FINAL) {
      __syncthreads();
      f32x4 y = f32x4{0.f, 0.f, 0.f, 0.f};
#pragma unroll
      for (int ks = 0; ks < 4; ++ks) {
        const bf16x8 xf = *(const bf16x8*)(xsb + c16 * 256 + (((ks * 4 + quad) ^ c16) << 4));
        y = MFMA16(xf, cf[ks], y);
      }
#pragma unroll
      for (int r = 0; r < 4; ++r) {
        const float v = y[r] + dsk * uo[r];
        p.proj[(size_t)(tb + quad * 4 + r) * PW + C_AU + g * 16 + c16] = f2bf(gelu_tanh(v));
      }
    }
    __syncthreads();
  }
  if constexpr (!FINAL) { stp[c * 128] = xr; stp[c * 128 + 64] = xi; }
}

template <bool FINAL>
DI void lru_item(const Params& p, int layer, int item, char* lds) {
  const int half = item & 1, c = (item >> 1) & 127, b = item >> 8;
  const int tid_ = opaque_tid(), lane = tid_ & 63, w = tid_ >> 6, c16 = lane & 15, quad = lane >> 4;
  const int n = half * 4 + w, ch = n * 64 + lane;
  const int l0 = c * 64, tok0 = b * SEQ + l0;
  char* xcb = lds + w * 16384;
  float* aba = (float*)(xcb + 8192);
  float* abb = aba + 1024;
  bf16x8 wf[8][2];
  {
    const float* pa = p.lru_wa + (size_t)((layer * 8 + n) * 64) * 64;
    const float* px = p.lru_wx + (size_t)((layer * 8 + n) * 64) * 64;
#pragma unroll
    for (int nt = 0; nt < 8; ++nt) {
      const float* base = ((nt < 4) ? pa : px) + (nt & 3) * 16 + c16;
#pragma unroll
      for (int ks = 0; ks < 2; ++ks) {
        union { unsigned u[4]; bf16x8 v; } pk;
#pragma unroll
        for (int jj = 0; jj < 4; ++jj) {
          const int k = ks * 32 + quad * 8 + jj * 2;
          pk.u[jj] = pack2(base[k * 64], base[(k + 1) * 64]);
        }
        wf[nt][ks] = pk.v;
      }
    }
  }
  float bav[4], bxv[4], spv[4];
#pragma unroll
  for (int nt = 0; nt < 4; ++nt) {
    const int cch = layer * 512 + n * 64 + nt * 16 + c16;
    bav[nt] = p.lru_ba[cch]; bxv[nt] = p.lru_bx[cch];
    spv[nt] = 8.f * log1pf(expf(-p.lru_lam[cch])) * 1.4426950408889634f;
  }
  {
    const float cw0 = p.conv_w[(layer * 4 + 0) * 512 + ch], cw1 = p.conv_w[(layer * 4 + 1) * 512 + ch];
    const float cw2 = p.conv_w[(layer * 4 + 2) * 512 + ch], cw3 = p.conv_w[(layer * 4 + 3) * 512 + ch];
    const float cb = p.conv_b[layer * 512 + ch];
    const bf16_t* xp = p.proj + (size_t)tok0 * PW + C_CX + ch;
    bf16_t xin[67];
#pragma unroll
    for (int t = 0; t < 3; ++t) xin[t] = (l0 + t - 3 >= 0) ? xp[(t - 3) * PW] : (bf16_t)0;
#pragma unroll
    for (int t = 3; t < 67; ++t) xin[t] = xp[(size_t)(t - 3) * PW];
#pragma unroll
    for (int t = 0; t < 64; ++t) {
      const float xc = cw0 * bf2f(xin[t]) + cw1 * bf2f(xin[t + 1]) + cw2 * bf2f(xin[t + 2]) + cw3 * bf2f(xin[t + 3]) + cb;
      *(bf16_t*)(xcb + t * 128 + (swz(t, lane >> 3) << 4) + (lane & 7) * 2) = f2bf(xc);
    }
  }
  float hst = 0.f, pr = 1.f;
  float* stp = p.lrust + ((size_t)(b * 128) * 512 + ch) * 2;
  if constexpr (FINAL) hst = stp[(size_t)c * 1024 + 1];
  __syncthreads();
  for (int sc = 0; sc < 4; ++sc) {
    float gv[FINAL ? 16 : 1];
    if constexpr (FINAL) {
      const bf16_t* gp0 = p.proj + (size_t)(tok0 + sc * 16) * PW + C_CG + ch;
#pragma unroll
      for (int t = 0; t < 16; ++t) gv[t] = bf2f(gp0[(size_t)t * PW]);
    }
    f32x4 acc[8];
#pragma unroll
    for (int nt = 0; nt < 8; ++nt) acc[nt] = f32x4{0.f, 0.f, 0.f, 0.f};
    const int arow = sc * 16 + c16;
#pragma unroll
    for (int ks = 0; ks < 2; ++ks) {
      const bf16x8 af = *(const bf16x8*)(xcb + arow * 128 + (swz(arow, ks * 4 + quad) << 4));
#pragma unroll
      for (int nt = 0; nt < 8; ++nt) acc[nt] = MFMA16(af, wf[nt][ks], acc[nt]);
    }
#pragma unroll
    for (int nt = 0; nt < 4; ++nt) {
      const int chl = nt * 16 + c16;
#pragma unroll
      for (int r = 0; r < 4; ++r) {
        const int tl = sc * 16 + quad * 4 + r;
        const float xcv = bf2f(*(const bf16_t*)(xcb + tl * 128 + (swz(tl, chl >> 3) << 4) + (chl & 7) * 2));
        const float ga = acc[nt][r] + bav[nt], gx = acc[nt + 4][r] + bxv[nt];
        const float rr = __builtin_amdgcn_rcpf(1.f + __builtin_amdgcn_exp2f(-1.4426950408889634f * ga));
        const float ig = __builtin_amdgcn_rcpf(1.f + __builtin_amdgcn_exp2f(-1.4426950408889634f * gx));
        const float la2 = -spv[nt] * rr;
        const float a = __builtin_amdgcn_exp2f(la2);
        const float y = la2 * 1.3862943611198906f;
        float q = 1.f + y * (1.f / 6.f);
        q = 1.f + y * 0.2f * q; q = 1.f + y * 0.25f * q; q = 1.f + y * (1.f / 3.f) * q; q = 1.f + y * 0.5f * q;
        const float om = (y < -0.5f) ? (1.f - a * a) : (-y * q);
        const float mult = __builtin_amdgcn_sqrtf(om);
        aba[(quad * 4 + r) * 64 + chl] = a;
        abb[(quad * 4 + r) * 64 + chl] = mult * ig * xcv;
      }
    }
    __syncthreads();
#pragma unroll
    for (int tt = 0; tt < 16; ++tt) {
      const float a = aba[tt * 64 + lane], bv = abb[tt * 64 + lane];
      hst = a * hst + bv;
      if constexpr (FINAL) p.proj[(size_t)(tok0 + sc * 16 + tt) * PW + C_CG + ch] = f2bf(hst * gv[tt]);
      else pr *= a;
    }
    __syncthreads();
  }
  if constexpr (!FINAL) { *(float2*)(stp + (size_t)c * 1024) = make_float2(pr, hst); }
}

DI void transpose_tile(const Params& p, int t, char* lds) {
  const float* src; bf16_t* dst; int K, N, kt, nt, perm = 0;
  const float* gs = nullptr;
  if (t < 5120) { int l = t / 1280, r = t % 1280; kt = r / 80; nt = r % 80; K = 1024; N = 5120; src = p.w_in + (size_t)l * K * N; dst = p.wt_in + (size_t)l * K * N; gs = p.norm_g + l * 1024; }
  else if (t < 7168) { t -= 5120; int l = t / 512, r = t % 512; kt = r / 16; nt = r % 16; K = 2048; N = 1024; src = p.w_out + (size_t)l * K * N; dst = p.wt_out + (size_t)l * K * N; }
  else if (t < 7680) { t -= 7168; int l = t / 128, r = t % 128; kt = r / 16; nt = r % 16; K = 512; N = 1024; src = p.s5_wglu + (size_t)l * K * N; dst = p.wt_glu + (size_t)l * K * N; perm = 1; }
  else { t -= 7680; int l = t / 256, r = t % 256; kt = r / 16; nt = r % 16; K = 1024; N = 1024; src = p.w_memkv + (size_t)l * K * N; dst = p.wt_mem + (size_t)l * K * N; }
  float* tile = (float*)lds;
  const int tid = opaque_tid(), ty = tid >> 4, tx = tid & 15;
  const int k0 = kt * 64, n0 = nt * 64;
#pragma unroll
  for (int i = 0; i < 4; ++i) {
    const int k = ty + 16 * i;
    const float4 v = *(const float4*)(src + (size_t)(k0 + k) * N + n0 + tx * 4);
    tile[k * 65 + tx * 4] = v.x; tile[k * 65 + tx * 4 + 1] = v.y; tile[k * 65 + tx * 4 + 2] = v.z; tile[k * 65 + tx * 4 + 3] = v.w;
  }
  __syncthreads();
  const int n = tid >> 2, kq = tid & 3;
  unsigned pk[8];
#pragma unroll
  for (int j = 0; j < 8; ++j) {
    const int kk = kq * 16 + 2 * j;
    const float s0 = gs ? gs[kt * 64 + kk] : 1.f, s1 = gs ? gs[kt * 64 + kk + 1] : 1.f;
    pk[j] = pack2(tile[kk * 65 + n] * s0, tile[(kk + 1) * 65 + n] * s1);
  }
  int row = n0 + n;
  if (perm) { const int j = row & 511; row = (j >> 5) * 64 + ((row >= 512) ? 32 : 0) + (j & 31); }
  uint4* d = (uint4*)(dst + (size_t)row * K + k0 + kq * 16);
  d[0] = make_uint4(pk[0], pk[1], pk[2], pk[3]);
  d[1] = make_uint4(pk[4], pk[5], pk[6], pk[7]);
  __syncthreads();
}

DI void phase0(const Params& p, char* lds) {
  const int tid = opaque_tid(), lane = tid & 63, w = tid >> 6;
  for (int t = blockIdx.x; t < 8704; t += gridDim.x) transpose_tile(p, t, lds);
  for (int it = blockIdx.x; it < 8192 + 1024; it += gridDim.x) {
    if (it < 8192) {
      const int row = it * 4 + w;
      const float* xr = p.x + (size_t)row * 1024;
      float4 v[4]; float ss = 0.f;
#pragma unroll
      for (int i = 0; i < 4; ++i) { v[i] = *(const float4*)(xr + i * 256 + lane * 4); ss += v[i].x * v[i].x + v[i].y * v[i].y + v[i].z * v[i].z + v[i].w * v[i].w; }
#pragma unroll
      for (int o = 32; o >= 1; o >>= 1) ss += __shfl_xor(ss, o);
#pragma unroll
      for (int i = 0; i < 4; ++i) {
        const int col = i * 256 + lane * 4;
        uint2 o; o.x = pack2(v[i].x, v[i].y); o.y = pack2(v[i].z, v[i].w);
        *(uint2*)(p.xb + (size_t)row * 1024 + col) = o;
      }
      if (lane == 0) p.rowss[row] = ss;
    } else {
      const int r = (it - 8192) * 4 + w, l = r >> 10, mr = r & 1023;
      const float* xr = p.mem + (size_t)mr * 1024;
      float4 v[4]; float ss = 0.f;
#pragma unroll
      for (int i = 0; i < 4; ++i) { v[i] = *(const float4*)(xr + i * 256 + lane * 4); ss += v[i].x * v[i].x + v[i].y * v[i].y + v[i].z * v[i].z + v[i].w * v[i].w; }
#pragma unroll
      for (int o = 32; o >= 1; o >>= 1) ss += __shfl_xor(ss, o);
      const float rs = rsqrtf(ss * (1.f / 1024.f) + 1e-6f);
#pragma unroll
      for (int i = 0; i < 4; ++i) {
        const int col = i * 256 + lane * 4;
        const float4 g = *(const float4*)(p.memng + l * 1024 + col);
        uint2 o; o.x = pack2(v[i].x * rs * g.x, v[i].y * rs * g.y); o.y = pack2(v[i].z * rs * g.z, v[i].w * rs * g.w);
        *(uint2*)(p.memn + (size_t)r * 1024 + col) = o;
      }
    }
  }
  const int gtid = blockIdx.x * 256 + tid, gstride = gridDim.x * 256;
  for (int i = gtid; i < NT * 8; i += gstride) {
    const int tok = i >> 3, f = i & 7;
    const float inv = powf(500000.f, -(float)(2 * f) / 16.f);
    const float ang = (float)p.pos[tok] * inv;
    float s, c; sincosf(ang, &s, &c);
    p.ropetab[tok * 16 + f] = c; p.ropetab[tok * 16 + 8 + f] = s;
  }
  for (int i = gtid; i < 4 * 32 * 64; i += gstride) {
    const int pp = i & 63, lg = i >> 6;
    const float dt = expf(p.s5_logdt[lg]);
    const float lr = p.s5_lre[i], li = p.s5_lim[i];
    const float mag = expf(lr * dt);
    const float are = mag * cosf(li * dt), aim = mag * sinf(li * dt);
    const float den = lr * lr + li * li;
    const float nr = are - 1.f, ni = aim;
    const float fre = (nr * lr + ni * li) / den, fim = (ni * lr - nr * li) / den;
    float* o = p.s5par + (size_t)lg * 36 * 64 + pp;
    o[0] = are; o[64] = aim;
    bf16_t* btr = p.s5bt + ((size_t)lg * 128 + pp) * 32;
    bf16_t* bti = btr + 64 * 32;
    for (int h = 0; h < 16; ++h) {
      const float br = p.s5_bre[(size_t)i * 16 + h], bi = p.s5_bim[(size_t)i * 16 + h];
      o[(2 + h) * 64] = fre * br - fim * bi;
      o[(18 + h) * 64] = fre * bi + fim * br;
      btr[h] = f2bf(fre * br - fim * bi); bti[h] = f2bf(fre * bi + fim * br);
      btr[16 + h] = 0; bti[16 + h] = 0;
    }
    float tr = are, ti = aim;
    for (int q = 0; q < 6; ++q) { const float a = tr * tr - ti * ti, bq = 2.f * tr * ti; tr = a; ti = bq; }
    o[34 * 64] = tr; o[35 * 64] = ti;
  }
  for (int i = gtid; i < 15 * NT; i += gstride) p.rowss[NT + i] = 0.f;
  if (gtid < 64) p.ctr[gtid] = 0u;
  if (gtid < 4) {
    float s1 = 0.f, s2 = 0.f;
    for (int j = 0; j < 64; ++j) { s1 += p.da_q1[gtid * 64 + j] * p.da_k1[gtid * 64 + j]; s2 += p.da_q2[gtid * 64 + j] * p.da_k2[gtid * 64 + j]; }
    p.lamv[gtid] = expf(s1) - expf(s2) + (0.8f - 0.6f * expf(-0.3f * (float)gtid));
  }
}

DI void carry_phase(const Params& p, int layer) {
  for (int it = blockIdx.x; it < 40; it += gridDim.x) {
    if (it < 32) {
      const int idx = it * 256 + threadIdx.x, b = idx >> 11, g = (idx >> 6) & 31, pp = idx & 63;
      const float* par = p.s5par + (size_t)((layer * 32 + g) * 36) * 64 + pp;
      const float tre = par[34 * 64], tim = par[35 * 64];
      float* base = p.s5st + ((size_t)((b * 32 + g) * 128)) * 128 + pp;
      float xr = 0.f, xi = 0.f;
      for (int c0 = 0; c0 < 128; c0 += 16) {
        float er[16], ei[16];
#pragma unroll
        for (int j = 0; j < 16; ++j) { er[j] = base[(c0 + j) * 128]; ei[j] = base[(c0 + j) * 128 + 64]; }
#pragma unroll
        for (int j = 0; j < 16; ++j) {
          base[(c0 + j) * 128] = xr; base[(c0 + j) * 128 + 64] = xi;
          const float nr = tre * xr - tim * xi + er[j];
          const float ni = tre * xi + tim * xr + ei[j];
          xr = nr; xi = ni;
        }
      }
    } else {
      const int idx = (it - 32) * 256 + threadIdx.x, b = idx >> 9, ch = idx & 511;
      float* base = p.lrust + ((size_t)(b * 128) * 512 + ch) * 2;
      float h = 0.f;
      for (int c0 = 0; c0 < 128; c0 += 16) {
        float2 e[16];
#pragma unroll
        for (int j = 0; j < 16; ++j) e[j] = *(const float2*)(base + (size_t)(c0 + j) * 1024);
#pragma unroll
        for (int j = 0; j < 16; ++j) {
          base[(size_t)(c0 + j) * 1024 + 1] = h;
          h = e[j].x * h + e[j].y;
        }
      }
    }
  }
}

DI bool tile_map(int i, int ncols, int& m, int& n) {
  if (gridDim.x == 512) {
    const int x = blockIdx.x & 7, j = blockIdx.x >> 3, ncg = ncols >> 3;
    m = 16 * x + 8 * (i / ncg) + (j >> 3);
    n = 8 * (i % ncg) + (j & 7);
    return i < 2 * ncg;
  }
  const int t = blockIdx.x + i * gridDim.x;
  m = t / ncols; n = t % ncols;
  return t < 128 * ncols;
}

DI int next_item(unsigned* ctr, int* sh) {
  __syncthreads();
  if (threadIdx.x == 0) *sh = (int)atomicAdd(ctr, 1u);
  __syncthreads();
  return *sh;
}

__global__ void __launch_bounds__(256, 2) hymba_forward(Params p) {
  extern __shared__ __attribute__((aligned(16))) char lds[];
  __shared__ uint4 xb_words;
  cg::grid_group grid = cg::this_grid();
  int* sh_item = (int*)(lds + 73728);
  if (threadIdx.x == 0) xb_words = make_uint4(0u, 0u, 0u, 0u);
  __syncthreads();
  XcdBarrier xb = xcd_barrier_post(p.bar, (volatile LAS unsigned*)&xb_words);
  phase0(p, lds);
  if (gridDim.x == 0x7fffffffu) grid.sync();
  xcd_barrier(xb);
  for (int layer = 0; layer < 4; ++layer) {
    {
      GemmArgs ga; ga.A = p.xb; ga.lda = 1024; ga.mix = 0; ga.Bt = p.wt_in + (size_t)layer * 5120 * 1024; ga.K = 1024;
      EpiArgs ea; ea.p = &p; ea.layer = layer; ea.rowss = p.rowss + (size_t)layer * 16 * NT; ea.xsrc = nullptr; ea.gnext = nullptr; ea.rowss_next = nullptr;
      for (int i = 0;; ++i) { int m, n; if (!tile_map(i, 40, m, n)) break; gemm_tile<EPI_INPROJ>(ga, ea, m * 256, n * 128, lds); }
      if (layer == 0) {
        for (int t = blockIdx.x; t < 128; t += gridDim.x) {
          const int lm = t >> 5, r = t & 31;
          GemmArgs gm; gm.A = p.memn + (size_t)lm * 1024 * 1024; gm.lda = 1024; gm.mix = 0; gm.Bt = p.wt_mem + (size_t)lm * 1024 * 1024; gm.K = 1024;
          EpiArgs em = ea; em.layer = lm;
          gemm_tile<EPI_MEMKV>(gm, em, (r >> 3) * 256, (r & 7) * 128, lds);
        }
      }
    }
    xcd_barrier(xb);
    {
      unsigned* ctr = p.ctr + layer * 2;
      for (;;) {
        const int it = next_item(ctr, sh_item);
        if (it >= 1024 + 4096) break;
        if (it < 1024) lru_item<false>(p, layer, it, lds);
        else s5_item<false>(p, layer, it - 1024, lds);
      }
    }
    xcd_barrier(xb);
    carry_phase(p, layer);
    xcd_barrier(xb);
    {
      unsigned* actr = p.ctr + 16 + layer * 8 + (blockIdx.x & 7);
      for (;;) {
        const int it = next_item(actr, sh_item);
        if (it >= 256) break;
        diff_attn_item(p, layer, 127 - (it >> 1), (blockIdx.x & 7) * 2 + (it & 1), lds);
      }
      unsigned* ctr = p.ctr + layer * 2 + 1;
      for (;;) {
        const int it = next_item(ctr, sh_item);
        if (it >= 1024 + 4096 + 2048) break;
        if (it < 1024) lru_item<true>(p, layer, it, lds);
        else if (it < 5120) s5_item<true>(p, layer, it - 1024, lds);
        else mem_attn_item(p, layer, it - 5120, lds);
      }
    }
    xcd_barrier(xb);
    {
      GemmArgs ga; ga.A = p.proj + C_AU; ga.lda = PW; ga.mix = 0; ga.Bt = p.wt_glu + (size_t)layer * 1024 * 512; ga.K = 512;
      EpiArgs ea; ea.p = &p; ea.layer = layer; ea.rowss = nullptr; ea.xsrc = nullptr; ea.gnext = nullptr; ea.rowss_next = nullptr;
      for (int i = 0;; ++i) { int m, n; if (!tile_map(i, 8, m, n)) break; gemm_tile<EPI_GLU>(ga, ea, m * 256, n * 128, lds); }
    }
    xcd_barrier(xb);
    {
      GemmArgs ga; ga.A = p.proj; ga.lda = PW; ga.mix = 1; ga.Bt = p.wt_out + (size_t)layer * 1024 * 2048; ga.K = 2048;
      EpiArgs ea; ea.p = &p; ea.layer = layer; ea.rowss = nullptr;
      ea.xsrc = nullptr;
      ea.gnext = (layer < 3) ? (p.norm_g + (layer + 1) * 1024) : nullptr;
      ea.rowss_next = p.rowss + (size_t)(layer + 1) * 16 * NT;
      for (int i = 0;; ++i) { int m, n; if (!tile_map(i, 8, m, n)) break; gemm_tile<EPI_OUT>(ga, ea, m * 256, n * 128, lds); }
    }
    xcd_barrier(xb);
  }
  {
    const float* rss = p.rowss + (size_t)4 * 16 * NT;
    const int lane = threadIdx.x & 63, w = threadIdx.x >> 6;
    for (int row = blockIdx.x * 4 + w; row < NT; row += gridDim.x * 4) {
      const float rs = rsqrtf(sum16(rss, row) * (1.f / 1024.f) + 1e-6f);
#pragma unroll
      for (int i = 0; i < 4; ++i) {
        const int col = i * 256 + lane * 4;
        const uint2 u = *(const uint2*)(p.xb + (size_t)row * 1024 + col);
        const float4 g = *(const float4*)(p.fng + col);
        float4 v;
        v.x = __uint_as_float(u.x << 16) * rs * g.x; v.y = __uint_as_float(u.x & 0xffff0000u) * rs * g.y;
        v.z = __uint_as_float(u.y << 16) * rs * g.z; v.w = __uint_as_float(u.y & 0xffff0000u) * rs * g.w;
        *(float4*)(p.out + (size_t)row * 1024 + col) = v;
      }
    }
  }
}

extern "C" void kernel_launch(void* const* d_in, const int* in_sizes, int n_in, void* d_out, int out_size, void* d_ws,
                              size_t ws_size, hipStream_t stream) {
  Params p{};
  p.x = (const float*)d_in[0]; p.mem = (const float*)d_in[1]; p.pos = (const int*)d_in[2];
  p.norm_g = (const float*)d_in[3]; p.w_in = (const float*)d_in[4]; p.w_out = (const float*)d_in[5];
  p.s5_lre = (const float*)d_in[6]; p.s5_lim = (const float*)d_in[7]; p.s5_logdt = (const float*)d_in[8];
  p.s5_bre = (const float*)d_in[9]; p.s5_bim = (const float*)d_in[10]; p.s5_cre = (const float*)d_in[11];
  p.s5_cim = (const float*)d_in[12]; p.s5_d = (const float*)d_in[13]; p.s5_wglu = (const float*)d_in[14];
  p.da_q1 = (const float*)d_in[15]; p.da_k1 = (const float*)d_in[16]; p.da_q2 = (const float*)d_in[17];
  p.da_k2 = (const float*)d_in[18]; p.da_g = (const float*)d_in[19];
  p.conv_w = (const float*)d_in[20]; p.conv_b = (const float*)d_in[21]; p.lru_wa = (const float*)d_in[22];
  p.lru_ba = (const float*)d_in[23]; p.lru_wx = (const float*)d_in[24]; p.lru_bx = (const float*)d_in[25];
  p.lru_lam = (const float*)d_in[26]; p.memng = (const float*)d_in[27]; p.w_memkv = (const float*)d_in[28];
  p.fng = (const float*)d_in[29];
  p.out = (float*)d_out;
  char* ws = (char*)d_ws; size_t off = 0;
  auto take = [&](size_t bytes) { char* r = ws + off; off += (bytes + 255) & ~(size_t)255; return r; };
  p.proj = (bf16_t*)take((size_t)NT * PW * 2);
  p.vt = (bf16_t*)take((size_t)NT * 512 * 2);
  p.xb = (bf16_t*)take((size_t)NT * 1024 * 2);
  p.wt_in = (bf16_t*)take((size_t)4 * 5120 * 1024 * 2);
  p.wt_out = (bf16_t*)take((size_t)4 * 1024 * 2048 * 2);
  p.wt_glu = (bf16_t*)take((size_t)4 * 1024 * 512 * 2);
  p.wt_mem = (bf16_t*)take((size_t)4 * 1024 * 1024 * 2);
  p.memn = (bf16_t*)take((size_t)4 * 1024 * 1024 * 2);
  p.memk = (bf16_t*)take((size_t)4 * 1024 * 512 * 2);
  p.memvt = (bf16_t*)take((size_t)4 * 1024 * 512 * 2);
  p.rowss = (float*)take((size_t)5 * 16 * NT * 4);
  p.ropetab = (float*)take((size_t)NT * 16 * 4);
  p.s5par = (float*)take((size_t)4 * 32 * 36 * 64 * 4);
  p.s5st = (float*)take((size_t)4 * 32 * 128 * 128 * 4);
  p.lrust = (float*)take((size_t)4 * 128 * 512 * 2 * 4);
  p.lamv = (float*)take(256);
  p.s5bt = (bf16_t*)take((size_t)4 * 32 * 128 * 32 * 2);
  p.ctr = (unsigned*)take(1024);
  p.bar = (unsigned*)take((size_t)XCD_BAR_WORDS * 4);
  if (off > ws_size) { fprintf(stderr, "workspace too small: need %zu have %zu\n", off, ws_size); return; }
  static int grid_blocks = 0;
  if (!grid_blocks) {
    int dev = 0, cus = 0, per_cu = 0;
    hipGetDevice(&dev);
    hipDeviceGetAttribute(&cus, hipDeviceAttributeMultiprocessorCount, dev);
    hipFuncSetAttribute((const void*)hymba_forward, hipFuncAttributeMaxDynamicSharedMemorySize, LDS_BYTES);
    hipOccupancyMaxActiveBlocksPerMultiprocessor(&per_cu, hymba_forward, 256, LDS_BYTES);
    if (per_cu < 1) per_cu = 1;
    if (per_cu > 2) per_cu = 2;
    grid_blocks = cus * per_cu;
  }
  hipMemsetAsync(p.bar, 0, (size_t)XCD_BAR_WORDS * 4, stream);
  void* args[] = {&p};
  hipError_t e = hipLaunchCooperativeKernel((const void*)hymba_forward, dim3(grid_blocks), dim3(256), args, LDS_BYTES, stream);
  if (e != hipSuccess) fprintf(stderr, "cooperative launch failed: %s (grid %d)\n", hipGetErrorString(e), grid_blocks);
}
```

```cpp
#include <hip/hip_runtime.h>
#include <hip/hip_cooperative_groups.h>
#include <cstdio>
namespace cg = cooperative_groups;

typedef unsigned short bf16_t;
typedef __attribute__((ext_vector_type(8))) short bf16x8;
typedef __attribute__((ext_vector_type(4))) short s16x4;
typedef __attribute__((ext_vector_type(4))) float f32x4;

#define DI __device__ __forceinline__
#define MFMA16(a, b, c) __builtin_amdgcn_mfma_f32_16x16x32_bf16((a), (b), (c), 0, 0, 0)

constexpr int NT = 32768;
constexpr int SEQ = 8192;
constexpr int PW = 4608;
constexpr int C_AU = 0, C_AG = 512, C_Q = 1024, C_K = 1536, C_BG = 2048, C_CX = 2560, C_CG = 3072, C_MQ = 3584, C_MG = 4096;
constexpr int LDS_BYTES = 73728 + 64 + 1024;

struct Params {
  const float *x, *mem; const int* pos;
  const float *norm_g, *w_in, *w_out, *s5_lre, *s5_lim, *s5_logdt, *s5_bre, *s5_bim, *s5_cre, *s5_cim, *s5_d, *s5_wglu;
  const float *da_q1, *da_k1, *da_q2, *da_k2, *da_g;
  const float *conv_w, *conv_b, *lru_wa, *lru_ba, *lru_wx, *lru_bx, *lru_lam, *memng, *w_memkv, *fng;
  float* out;
  bf16_t *proj, *vt, *xb, *wt_in, *wt_out, *wt_glu, *wt_mem, *memn, *memk, *memvt;
  float *rowss, *ropetab, *s5par, *s5st, *lrust, *lamv;
  bf16_t* s5bt;
  unsigned* ctr;
  unsigned* bar;
};

typedef __bf16 bf2_t __attribute__((ext_vector_type(2)));
typedef float f2_t __attribute__((ext_vector_type(2)));
DI unsigned pack2(float a, float b) { f2_t v = {a, b}; return __builtin_bit_cast(unsigned, __builtin_convertvector(v, bf2_t)); }
DI bf16_t f2bf(float x) { return (bf16_t)(pack2(x, 0.f) & 0xffffu); }
DI float bf2f(bf16_t h) { return __uint_as_float(((unsigned)h) << 16); }
DI float sigmoidf_(float x) { return 1.f / (1.f + __expf(-x)); }
DI float siluf_(float x) { return x / (1.f + __expf(-x)); }
DI int opaque_tid() { int t = threadIdx.x; asm volatile("" : "+v"(t)); return t; }
DI float quadmax(float x) {
  auto r = __builtin_amdgcn_permlane16_swap(__float_as_uint(x), __float_as_uint(x), false, false);
  const float m = fmaxf(__uint_as_float(r[0]), __uint_as_float(r[1]));
  auto q = __builtin_amdgcn_permlane32_swap(__float_as_uint(m), __float_as_uint(m), false, false);
  return fmaxf(__uint_as_float(q[0]), __uint_as_float(q[1]));
}
DI float quadsum(float x) {
  auto r = __builtin_amdgcn_permlane16_swap(__float_as_uint(x), __float_as_uint(x), false, false);
  const float m = __uint_as_float(r[0]) + __uint_as_float(r[1]);
  auto q = __builtin_amdgcn_permlane32_swap(__float_as_uint(m), __float_as_uint(m), false, false);
  return __uint_as_float(q[0]) + __uint_as_float(q[1]);
}
DI float sum16(const float* base, int row) { float t = 0.f;
#pragma unroll
  for (int k = 0; k < 16; ++k) t += base[(size_t)k * NT + row];
  return t; }
DI void wave_lds_sync() { asm volatile("s_waitcnt lgkmcnt(0)" ::: "memory"); __builtin_amdgcn_wave_barrier(); }
DI int swz(int row, int c) { return c ^ ((row >> 1) & 7); }

#define XB_TMO      128
#define XB_XCNT(j)  (256  + 64 * (j))
#define XB_XSUB(j)  (1280 + 64 * (j))
#define XB_XGEN(j)  (2304 + 64 * (j))
#define XB_TOP      3328
#define XB_TOPGEN   3392
#define XCD_BAR_WORDS 3456
#define XB_SPIN_CAP (1u << 18)
#define LAS __attribute__((address_space(3)))

__device__ __forceinline__ unsigned xb_ld(unsigned* p)              { return __hip_atomic_load(p, __ATOMIC_RELAXED, __HIP_MEMORY_SCOPE_AGENT); }
__device__ __forceinline__ unsigned xb_add(unsigned* p, unsigned v) { return __hip_atomic_fetch_add(p, v, __ATOMIC_RELAXED, __HIP_MEMORY_SCOPE_AGENT); }
__device__ __forceinline__ unsigned xb_xcc_id() { return (unsigned)__builtin_amdgcn_s_getreg((3 << 11) | 20) & 0xFu; }
#define XB_SPIN(cond, bar) do { unsigned _sp = 0; while (cond) { __builtin_amdgcn_s_sleep(1); \
    if ((++_sp & 255u) == 0u) { if (xb_ld(&(bar)[XB_TMO])) break; if (_sp > XB_SPIN_CAP) { atomicAdd(&(bar)[XB_TMO], 1u); break; } } } } while (0)

struct XcdBarrier {
    unsigned* bar; unsigned x;
    volatile LAS unsigned* st;
};

__device__ __forceinline__ XcdBarrier xcd_barrier_post(unsigned* bar, volatile LAS unsigned* st) {
    XcdBarrier b; b.bar = bar; b.x = xb_xcc_id(); b.st = st;
    if (threadIdx.x == 0) (void)xb_add(&bar[XB_XCNT(b.x)], 1u);
    return b;
}
__device__ __forceinline__ void xcd_barrier_complete(unsigned* bar, unsigned x, unsigned& nloc, unsigned& nx) {
    const unsigned G = gridDim.x * gridDim.y * gridDim.z;
    unsigned sum, cnt, mine, sp = 0u;
    for (;;) {
        sum = 0u; cnt = 0u; mine = 0u;
#pragma unroll
        for (unsigned j = 0; j < 16; ++j) { const unsigned c = xb_ld(&bar[XB_XCNT(j)]); sum += c; cnt += (c > 0u) ? 1u : 0u; mine = (j == x) ? c : mine; }
        if (sum == G) break;
        __builtin_amdgcn_s_sleep(1);
        if ((++sp & 255u) == 0u) { if (xb_ld(&bar[XB_TMO])) break; if (sp > XB_SPIN_CAP) { atomicAdd(&bar[XB_TMO], 1u); break; } }
    }
    nloc = mine > 0u ? mine : 1u; nx = cnt > 0u ? cnt : 1u;
}

__device__ __forceinline__ void xcd_barrier(const XcdBarrier& b) {
    asm volatile("s_waitcnt vmcnt(0)" ::: "memory");
    __syncthreads();
    if (threadIdx.x == 0) {
        unsigned* bar = b.bar;
        __builtin_amdgcn_s_waitcnt(0);
        unsigned nloc = b.st[0], nx = b.st[1];
        if (nloc == 0u) { xcd_barrier_complete(bar, b.x, nloc, nx); b.st[0] = nloc; b.st[1] = nx; }
        const unsigned old = xb_add(&bar[XB_XSUB(b.x)], 1u);
        const unsigned gen = old / nloc;
        if (old + 1u == (gen + 1u) * nloc) {
            __builtin_amdgcn_fence(__ATOMIC_RELEASE, "agent");
            asm volatile("s_waitcnt vmcnt(0)" ::: "memory");
            const unsigned og = xb_add(&bar[XB_TOP], 1u);
            const unsigned tg = og / nx;
            if (og + 1u == (tg + 1u) * nx) xb_add(&bar[XB_TOPGEN], 1u);
            else XB_SPIN(xb_ld(&bar[XB_TOPGEN]) == tg, bar);
            __builtin_amdgcn_fence(__ATOMIC_ACQUIRE, "agent");
            xb_add(&bar[XB_XGEN(b.x)], 1u);
            asm volatile("s_waitcnt vmcnt(0)" ::: "memory");
        } else {
            XB_SPIN(xb_ld(&bar[XB_XGEN(b.x)]) == gen, bar);
            __builtin_amdgcn_fence(__ATOMIC_ACQUIRE, "agent");
            asm volatile("s_waitcnt vmcnt(0)" ::: "memory");
        }
    }
    __syncthreads();
}


struct GemmArgs {
  const bf16_t* A; int lda; int mix;
  const bf16_t* Bt; int K;
};
DI int mixcol(int k0) { int g = k0 >> 9; int s = (g == 0) ? C_AG : (g == 1) ? C_BG : (g == 2) ? C_CG : C_MG; return s + (k0 & 511); }

enum { EPI_INPROJ = 0, EPI_MEMKV = 1, EPI_GLU = 2, EPI_OUT = 3 };

struct EpiArgs {
  const Params* p; int layer;
  const float* rowss;
  const float* xsrc;
  const float* gnext;
  float* rowss_next;
};

DI int swz64(int row, int c) { return c ^ ((0x1320 >> (((row >> 2) & 3) * 4)) & 3); }

template <int EPI>
DI void gemm_tile(const GemmArgs& ga, const EpiArgs& ea, int m0, int n0, char* lds) {
  const int tid = opaque_tid(), lane = tid & 63, w = tid >> 6;
  const int wm = w >> 1, wn = w & 1, c16 = lane & 15, quad = lane >> 4;
  f32x4 acc[8][4];
#pragma unroll
  for (int i = 0; i < 8; ++i)
#pragma unroll
    for (int j = 0; j < 4; ++j) acc[i][j] = f32x4{0.f, 0.f, 0.f, 0.f};
  const int K = ga.K, nk = K >> 5;
  float rowsum = 0.f;
  if constexpr (EPI == EPI_INPROJ) rowsum = sum16(ea.rowss, m0 + tid);
  const int prow = lane >> 2, pch = lane & 3;
  const bf16_t* gsrc[6];
  int ldsoff[6];
#pragma unroll
  for (int i = 0; i < 6; ++i) {
    const int pi = w * 6 + i;
    if (pi < 16) {
      const int row = pi * 16 + prow;
      gsrc[i] = ga.A + (size_t)(m0 + row) * ga.lda + swz64(row, pch) * 8;
      ldsoff[i] = pi * 1024 + lane * 16;
    } else {
      const int row = (pi - 16) * 16 + prow;
      gsrc[i] = ga.Bt + (size_t)(n0 + row) * K + swz64(row, pch) * 8;
      ldsoff[i] = pi * 1024 + lane * 16;
    }
  }
  auto dma = [&](int kt, int buf) {
    const int k0 = kt << 5;
    const int ac = ga.mix ? mixcol(k0) : k0;
    char* base = lds + buf * 24576;
#pragma unroll
    for (int i = 0; i < 6; ++i) {
      const int pi = w * 6 + i;
      __builtin_amdgcn_global_load_lds((const unsigned*)(gsrc[i] + ((pi < 16) ? ac : k0)), (unsigned*)(base + ldsoff[i]), 16, 0, 0);
    }
  };
  __syncthreads();
  dma(0, 0);
  if (nk > 1) dma(1, 1);
  for (int kt = 0; kt < nk; ++kt) {
    if (kt + 1 < nk) asm volatile("s_waitcnt vmcnt(6)" ::: "memory");
    else asm volatile("s_waitcnt vmcnt(0)" ::: "memory");
    __builtin_amdgcn_s_barrier();
    const char* Ab = lds + (kt % 3) * 24576 + wm * 128 * 64;
    const char* Bb = lds + (kt % 3) * 24576 + 16384 + wn * 64 * 64;
    bf16x8 af[8], bfr[4];
    const int ch = swz64(c16, quad) << 4;
#pragma unroll
    for (int nt = 0; nt < 4; ++nt) bfr[nt] = *(const bf16x8*)(Bb + (nt * 16 + c16) * 64 + ch);
#pragma unroll
    for (int mt = 0; mt < 2; ++mt) af[mt] = *(const bf16x8*)(Ab + (mt * 16 + c16) * 64 + ch);
    __builtin_amdgcn_sched_barrier(0);
    if (kt + 2 < nk) dma(kt + 2, (kt + 2) % 3);
    __builtin_amdgcn_sched_barrier(0);
#pragma unroll
    for (int g = 0; g < 4; ++g) {
      if (g < 3) {
#pragma unroll
        for (int mt = 2 * g + 2; mt < 2 * g + 4; ++mt) af[mt] = *(const bf16x8*)(Ab + (mt * 16 + c16) * 64 + ch);
      }
#pragma unroll
      for (int mt = 2 * g; mt < 2 * g + 2; ++mt)
#pragma unroll
        for (int nt = 0; nt < 4; ++nt) acc[mt][nt] = MFMA16(bfr[nt], af[mt], acc[mt][nt]);
      __builtin_amdgcn_sched_barrier(0);
    }
  }
  const Params& p = *ea.p;
  if constexpr (EPI == EPI_INPROJ) {
    const int slot = n0 >> 9;
    const int dbase = (slot < 4) ? slot * 512 : (slot - 1) * 512;
    float* rsc = (float*)(lds + 73728 + 64);
    rsc[tid] = rsqrtf(rowsum * (1.f / 1024.f) + 1e-6f);
    __syncthreads();
#pragma unroll
    for (int mt = 0; mt < 8; ++mt) {
      const int row = m0 + wm * 128 + mt * 16 + c16;
      const float rs = rsc[wm * 128 + mt * 16 + c16];
#pragma unroll
      for (int nt = 0; nt < 4; ++nt) {
        const int cc0 = (n0 & 511) + wn * 64 + nt * 16 + quad * 4;
        float v[4];
#pragma unroll
        for (int r = 0; r < 4; ++r) v[r] = acc[mt][nt][r] * rs;
        if (slot == 4) {
          const int b = row >> 13, l = row & 8191, h = cc0 >> 7, dv0 = cc0 & 127;
          const int lp = (l & ~31) | (((l >> 2) & 3) << 3) | (((l >> 4) & 1) << 2) | (l & 3);
#pragma unroll
          for (int r = 0; r < 4; ++r) p.vt[((size_t)((b * 4 + h) * 128 + dv0 + r)) * SEQ + lp] = f2bf(v[r]);
        } else {
          if (slot == 2 || slot == 3) {
            if (nt == 0) {
              const float* cs = p.ropetab + (size_t)row * 16 + (quad & 1) * 4;
              const float4 co = *(const float4*)cs, si = *(const float4*)(cs + 8);
              const float cov[4] = {co.x, co.y, co.z, co.w}, siv[4] = {si.x, si.y, si.z, si.w};
#pragma unroll
              for (int r = 0; r < 4; ++r) {
                const float pr = __shfl_xor(v[r], 32);
                v[r] = (quad < 2) ? (v[r] * cov[r] - pr * siv[r]) : (v[r] * cov[r] + pr * siv[r]);
              }
            }
            if (slot == 2) {
#pragma unroll
              for (int r = 0; r < 4; ++r) v[r] *= 0.18033688011112042f;
            }
          } else if (slot == 1 || slot == 5 || slot == 7 || slot == 9) {
#pragma unroll
            for (int r = 0; r < 4; ++r) v[r] = siluf_(v[r]);
          } else if (slot == 8) {
#pragma unroll
            for (int r = 0; r < 4; ++r) v[r] *= 0.12751743082459868f;
          }
          uint2 pk; pk.x = pack2(v[0], v[1]); pk.y = pack2(v[2], v[3]);
          *(uint2*)(p.proj + (size_t)row * PW + dbase + cc0) = pk;
        }
      }
    }
  } else if constexpr (EPI == EPI_MEMKV) {
    const int lm = ea.layer;
#pragma unroll
    for (int mt = 0; mt < 8; ++mt) {
      const int row = m0 + wm * 128 + mt * 16 + c16;
#pragma unroll
      for (int nt = 0; nt < 4; ++nt) {
        const int col0 = n0 + wn * 64 + nt * 16 + quad * 4;
        if (col0 < 512) {
          uint2 pk; pk.x = pack2(acc[mt][nt][0], acc[mt][nt][1]); pk.y = pack2(acc[mt][nt][2], acc[mt][nt][3]);
          *(uint2*)(p.memk + ((size_t)lm * 1024 + row) * 512 + col0) = pk;
        } else {
          const int cc0 = col0 - 512, h = cc0 >> 7, dv0 = cc0 & 127, b = row >> 8, m = row & 255;
          const int mp = (m & ~31) | (((m >> 2) & 3) << 3) | (((m >> 4) & 1) << 2) | (m & 3);
#pragma unroll
          for (int r = 0; r < 4; ++r) p.memvt[((size_t)((lm * 4 + b) * 4 + h) * 128 + dv0 + r) * 256 + mp] = f2bf(acc[mt][nt][r]);
        }
      }
    }
  } else if constexpr (EPI == EPI_GLU) {
    const int blk = (n0 + wn * 64) >> 6;
#pragma unroll
    for (int mt = 0; mt < 8; ++mt) {
      const int row = m0 + wm * 128 + mt * 16 + c16;
#pragma unroll
      for (int nt = 0; nt < 2; ++nt) {
        const int j0 = blk * 32 + nt * 16 + quad * 4;
        uint2* q = (uint2*)(p.proj + (size_t)row * PW + C_AG + j0);
        const uint2 gv = *q;
        const float g0 = __uint_as_float(gv.x << 16), g1 = __uint_as_float(gv.x & 0xffff0000u);
        const float g2 = __uint_as_float(gv.y << 16), g3 = __uint_as_float(gv.y & 0xffff0000u);
        uint2 o;
        o.x = pack2(acc[mt][nt][0] * sigmoidf_(acc[mt][nt + 2][0]) * g0, acc[mt][nt][1] * sigmoidf_(acc[mt][nt + 2][1]) * g1);
        o.y = pack2(acc[mt][nt][2] * sigmoidf_(acc[mt][nt + 2][2]) * g2, acc[mt][nt][3] * sigmoidf_(acc[mt][nt + 2][3]) * g3);
        *q = o;
      }
    }
  } else {
#pragma unroll
    for (int mt = 0; mt < 8; ++mt) {
      const int row = m0 + wm * 128 + mt * 16 + c16;
      float ss = 0.f;
#pragma unroll
      for (int nt = 0; nt < 4; ++nt) {
        const int col0 = n0 + wn * 64 + nt * 16 + quad * 4;
        const size_t idx = (size_t)row * 1024 + col0;
        float4 xo;
        if (ea.xsrc) xo = *(const float4*)(ea.xsrc + idx);
        else {
          const uint2 u = *(const uint2*)(p.xb + idx);
          xo = make_float4(__uint_as_float(u.x << 16), __uint_as_float(u.x & 0xffff0000u), __uint_as_float(u.y << 16), __uint_as_float(u.y & 0xffff0000u));
        }
        float4 xn;
        xn.x = xo.x + acc[mt][nt][0]; xn.y = xo.y + acc[mt][nt][1]; xn.z = xo.z + acc[mt][nt][2]; xn.w = xo.w + acc[mt][nt][3];
        ss += xn.x * xn.x + xn.y * xn.y + xn.z * xn.z + xn.w * xn.w;
        {
          uint2 o; o.x = pack2(xn.x, xn.y); o.y = pack2(xn.z, xn.w);
          *(uint2*)(p.xb + idx) = o;
        }
      }
      ss = quadsum(ss);
      if (quad == 0) ea.rowss_next[(size_t)((n0 >> 7) * 2 + wn) * NT + row] = ss;
    }
  }
}

template <int NS, int QT>
struct AttnState {
  f32x4 O[NS][8][QT];
  float l[NS][QT];
};

template <int NS, int QT>
DI void attn_core(AttnState<NS, QT>& st, const bf16_t* qp, int qstride, const bf16_t* kp, int kstride,
                          const bf16_t* vtp, int vtstride, int nkt, int qpos0, bool causal, char* lds) {
  const int tid = opaque_tid(), lane = tid & 63, w = tid >> 6, c16 = lane & 15, quad = lane >> 4;
  bf16x8 qf[QT][4];
#pragma unroll
  for (int qt = 0; qt < QT; ++qt)
#pragma unroll
    for (int f = 0; f < 4; ++f)
      qf[qt][f] = *(const bf16x8*)(qp + (size_t)(w * 16 * QT + qt * 16 + c16) * qstride + f * 32 + quad * 8);
  float m[NS][QT];
#pragma unroll
  for (int s = 0; s < NS; ++s)
#pragma unroll
    for (int qt = 0; qt < QT; ++qt) {
      m[s][qt] = 0.f; st.l[s][qt] = 0.f;
#pragma unroll
      for (int d = 0; d < 8; ++d) st.O[s][d][qt] = f32x4{0.f, 0.f, 0.f, 0.f};
    }
  const int prow = lane >> 3, pch = lane & 7;
  unsigned koff[4], voff[4];
#pragma unroll
  for (int i = 0; i < 4; ++i) {
    const int pi = w * 4 + i;
    { const int row = (pi & 7) * 8 + prow, sub = pi >> 3, c = pch ^ ((row >> 1) & 7);
      koff[i] = (unsigned)((row * kstride + sub * 64 + c * 8) * 2); }
    { const int row = pi * 8 + prow, c = pch ^ ((row >> 1) & 7);
      voff[i] = (unsigned)((row * vtstride + c * 8) * 2); }
  }
  auto gload = [&](int kt, int buf) {
    char* base = lds + buf * 32768;
    const char* kt_base = (const char*)(kp + (size_t)kt * 64 * kstride);
    const char* vt_base = (const char*)(vtp + (size_t)kt * 64);
#pragma unroll
    for (int i = 0; i < 4; ++i)
      __builtin_amdgcn_global_load_lds((const unsigned*)(kt_base + koff[i]), (unsigned*)(base + (w * 4 + i) * 1024 + lane * 16), 16, 0, 0);
#pragma unroll
    for (int i = 0; i < 4; ++i)
      __builtin_amdgcn_global_load_lds((const unsigned*)(vt_base + voff[i]), (unsigned*)(base + 16384 + (w * 4 + i) * 1024 + lane * 16), 16, 0, 0);
  };
  const int qw0 = qpos0 + w * 16 * QT;
  gload(0, 0); __syncthreads();
  for (int kt = 0; kt < nkt; ++kt) {
    if (kt + 1 < nkt) gload(kt + 1, (kt + 1) & 1);
    const char* Kb = lds + (kt & 1) * 32768;
    const char* Vb = Kb + 16384;
    const bool active = !causal || (kt * 64 <= qw0 + 16 * QT - 1);
    if (active) {
      const bool need_mask = causal && (kt * 64 + 63 > qw0);
      bf16x8 pf[NS][2][QT];
      f32x4 S[NS][4][QT];
#pragma unroll
      for (int s = 0; s < NS; ++s)
#pragma unroll
        for (int a = 0; a < 4; ++a)
#pragma unroll
          for (int qt = 0; qt < QT; ++qt) { const float nm = -m[s][qt]; S[s][a][qt] = f32x4{nm, nm, nm, nm}; }
      bf16x8 kfa[8], kfb[8], vfa[8], vfb[8];
#pragma unroll
      for (int i = 0; i < 8; ++i) {
        const int ksub = i & 3, row = ksub * 16 + c16, chunk = (i >> 2) * 4 + quad;
        kfa[i] = *(const bf16x8*)(Kb + row * 128 + (swz(row, chunk) << 4));
      }
      __builtin_amdgcn_sched_barrier(0);
#pragma unroll
      for (int i = 0; i < 8; ++i) {
        const int ksub = i & 3, row = ksub * 16 + c16, chunk = (i >> 2) * 4 + quad;
        kfb[i] = *(const bf16x8*)(Kb + 8192 + row * 128 + (swz(row, chunk) << 4));
      }
#pragma unroll
      for (int i = 0; i < 8; ++i)
#pragma unroll
        for (int qt = 0; qt < QT; ++qt) S[0][i & 3][qt] = MFMA16(kfa[i], qf[qt][i >> 2], S[0][i & 3][qt]);
      __builtin_amdgcn_sched_barrier(0);
#pragma unroll
      for (int d = 0; d < 8; ++d) {
        const int row = d * 16 + c16;
        vfa[d] = *(const bf16x8*)(Vb + row * 128 + (swz(row, quad) << 4));
      }
#pragma unroll
      for (int i = 0; i < 8; ++i)
#pragma unroll
        for (int qt = 0; qt < QT; ++qt) S[NS - 1][i & 3][qt] = MFMA16(kfb[i], qf[qt][2 + (i >> 2)], S[NS - 1][i & 3][qt]);
      if (need_mask) {
#pragma unroll
        for (int s = 0; s < NS; ++s)
#pragma unroll
          for (int ksub = 0; ksub < 4; ++ksub)
#pragma unroll
            for (int qt = 0; qt < QT; ++qt)
#pragma unroll
              for (int r = 0; r < 4; ++r) {
                const int key = kt * 64 + ksub * 16 + quad * 4 + r;
                const int qpos = qw0 + qt * 16 + c16;
                if (key > qpos) S[s][ksub][qt][r] = -1e30f;
              }
      }
      float mx[NS][QT];
      bool need = false;
#pragma unroll
      for (int s = 0; s < NS; ++s)
#pragma unroll
        for (int qt = 0; qt < QT; ++qt) {
          float v = -1e30f;
#pragma unroll
          for (int ksub = 0; ksub < 4; ++ksub)
#pragma unroll
            for (int r = 0; r < 4; ++r) v = fmaxf(v, S[s][ksub][qt][r]);
          v = quadmax(v);
          mx[s][qt] = v;
          need = need || (v > 8.f);
        }
      if (__any(need) || kt == 0) {
#pragma unroll
        for (int s = 0; s < NS; ++s)
#pragma unroll
          for (int qt = 0; qt < QT; ++qt) {
            const float delta = (kt == 0) ? mx[s][qt] : fmaxf(mx[s][qt], 0.f);
            const float alpha = (kt == 0) ? 1.f : __builtin_amdgcn_exp2f(-delta);
            m[s][qt] += delta;
            st.l[s][qt] *= alpha;
#pragma unroll
            for (int d = 0; d < 8; ++d) st.O[s][d][qt] *= alpha;
#pragma unroll
            for (int ksub = 0; ksub < 4; ++ksub)
#pragma unroll
              for (int r = 0; r < 4; ++r) S[s][ksub][qt][r] -= delta;
          }
      }
#pragma unroll
      for (int s = 0; s < NS; ++s)
#pragma unroll
        for (int qt = 0; qt < QT; ++qt) {
          float psum = 0.f;
#pragma unroll
          for (int ksub = 0; ksub < 4; ++ksub)
#pragma unroll
            for (int r = 0; r < 4; ++r) { const float e = __builtin_amdgcn_exp2f(S[s][ksub][qt][r]); S[s][ksub][qt][r] = e; psum += e; }
          st.l[s][qt] += psum;
#pragma unroll
          for (int kk = 0; kk < 2; ++kk) {
            union { unsigned u[4]; bf16x8 v; } pk;
            pk.u[0] = pack2(S[s][2 * kk][qt][0], S[s][2 * kk][qt][1]);
            pk.u[1] = pack2(S[s][2 * kk][qt][2], S[s][2 * kk][qt][3]);
            pk.u[2] = pack2(S[s][2 * kk + 1][qt][0], S[s][2 * kk + 1][qt][1]);
            pk.u[3] = pack2(S[s][2 * kk + 1][qt][2], S[s][2 * kk + 1][qt][3]);
            pf[s][kk][qt] = pk.v;
          }
        }
      __builtin_amdgcn_sched_barrier(0);
#pragma unroll
      for (int d = 0; d < 8; ++d) {
        const int row = d * 16 + c16;
        vfb[d] = *(const bf16x8*)(Vb + row * 128 + (swz(row, 4 + quad) << 4));
      }
#pragma unroll
      for (int d = 0; d < 8; ++d)
#pragma unroll
        for (int s = 0; s < NS; ++s)
#pragma unroll
          for (int qt = 0; qt < QT; ++qt) st.O[s][d][qt] = MFMA16(vfa[d], pf[s][0][qt], st.O[s][d][qt]);
      __builtin_amdgcn_sched_barrier(0);
#pragma unroll
      for (int d = 0; d < 8; ++d)
#pragma unroll
        for (int s = 0; s < NS; ++s)
#pragma unroll
          for (int qt = 0; qt < QT; ++qt) st.O[s][d][qt] = MFMA16(vfb[d], pf[s][1][qt], st.O[s][d][qt]);
    }
    __syncthreads();
  }
#pragma unroll
  for (int s = 0; s < NS; ++s)
#pragma unroll
    for (int qt = 0; qt < QT; ++qt) {
      st.l[s][qt] = quadsum(st.l[s][qt]);
    }
}

DI void diff_attn_item(const Params& p, int layer, int qb, int bh, char* lds) {
  const int b = bh >> 2, h = bh & 3;
  const int tok0 = b * SEQ + qb * 64;
  const int tid_ = opaque_tid(), lane = tid_ & 63, w = tid_ >> 6, c16 = lane & 15, quad = lane >> 4;
  const int sidx = w & 1, g = w >> 1;
  const bf16_t* qp = p.proj + (size_t)tok0 * PW + C_Q + h * 128;
  const bf16_t* kp = p.proj + (size_t)b * SEQ * PW + C_K + h * 128;
  const bf16_t* vtp = p.vt + (size_t)((b * 4 + h) * 128) * SEQ;
  const int nkt = qb + 1;
  bf16x8 qf[2][2];
#pragma unroll
  for (int qt = 0; qt < 2; ++qt)
#pragma unroll
    for (int ff = 0; ff < 2; ++ff)
      qf[qt][ff] = *(const bf16x8*)(qp + (size_t)(g * 32 + qt * 16 + c16) * PW + (sidx * 2 + ff) * 32 + quad * 8);
  float m[2], l[2];
  f32x4 O[8][2];
#pragma unroll
  for (int qt = 0; qt < 2; ++qt) {
    m[qt] = 0.f; l[qt] = 0.f;
#pragma unroll
    for (int d = 0; d < 8; ++d) O[d][qt] = f32x4{0.f, 0.f, 0.f, 0.f};
  }
  const int prow = lane >> 3, pch = lane & 7;
  unsigned koff[4], voff[4];
#pragma unroll
  for (int i = 0; i < 4; ++i) {
    const int pi = w * 4 + i;
    { const int row = (pi & 7) * 8 + prow, sub = pi >> 3, c = pch ^ ((row >> 1) & 7);
      koff[i] = (unsigned)((row * PW + sub * 64 + c * 8) * 2); }
    { const int row = pi * 8 + prow, c = pch ^ ((row >> 1) & 7);
      voff[i] = (unsigned)((row * SEQ + c * 8) * 2); }
  }
  auto gload = [&](int kt, int buf) {
    char* base = lds + buf * 32768;
    const char* kt_base = (const char*)(kp + (size_t)kt * 64 * PW);
    const char* vt_base = (const char*)(vtp + (size_t)kt * 64);
#pragma unroll
    for (int i = 0; i < 4; ++i)
      __builtin_amdgcn_global_load_lds((const unsigned*)(kt_base + koff[i]), (unsigned*)(base + (w * 4 + i) * 1024 + lane * 16), 16, 0, 0);
#pragma unroll
    for (int i = 0; i < 4; ++i)
      __builtin_amdgcn_global_load_lds((const unsigned*)(vt_base + voff[i]), (unsigned*)(base + 16384 + (w * 4 + i) * 1024 + lane * 16), 16, 0, 0);
  };
  const int qw0 = qb * 64 + g * 32;
  gload(0, 0); __syncthreads();
  for (int kt = 0; kt < nkt; ++kt) {
    if (kt + 1 < nkt) gload(kt + 1, (kt + 1) & 1);
    const char* Kb = lds + (kt & 1) * 32768 + sidx * 8192;
    const char* Vb = lds + (kt & 1) * 32768 + 16384;
    if (kt * 64 <= qw0 + 31) {
      f32x4 S[4][2];
#pragma unroll
      for (int a = 0; a < 4; ++a)
#pragma unroll
        for (int qt = 0; qt < 2; ++qt) { const float nm = -m[qt]; S[a][qt] = f32x4{nm, nm, nm, nm}; }
      bf16x8 kf[8], vfa[8], vfb[8];
#pragma unroll
      for (int i = 0; i < 8; ++i) {
        const int row = (i & 3) * 16 + c16, chunk = (i >> 2) * 4 + quad;
        kf[i] = *(const bf16x8*)(Kb + row * 128 + (swz(row, chunk) << 4));
      }
      __builtin_amdgcn_sched_barrier(0);
#pragma unroll
      for (int d = 0; d < 8; ++d) { const int row = d * 16 + c16; vfa[d] = *(const bf16x8*)(Vb + row * 128 + (swz(row, quad) << 4)); }
#pragma unroll
      for (int i = 0; i < 8; ++i)
#pragma unroll
        for (int qt = 0; qt < 2; ++qt) S[i & 3][qt] = MFMA16(kf[i], qf[qt][i >> 2], S[i & 3][qt]);
      __builtin_amdgcn_sched_barrier(0);
      if (kt * 64 + 63 > qw0) {
#pragma unroll
        for (int ksub = 0; ksub < 4; ++ksub)
#pragma unroll
          for (int qt = 0; qt < 2; ++qt)
#pragma unroll
            for (int r = 0; r < 4; ++r) {
              const int key = kt * 64 + ksub * 16 + quad * 4 + r;
              if (key > qw0 + qt * 16 + c16) S[ksub][qt][r] = -1e30f;
            }
      }
      float mx[2];
      bool need = false;
#pragma unroll
      for (int qt = 0; qt < 2; ++qt) {
        float v = -1e30f;
#pragma unroll
        for (int ksub = 0; ksub < 4; ++ksub)
#pragma unroll
          for (int r = 0; r < 4; ++r) v = fmaxf(v, S[ksub][qt][r]);
        v = quadmax(v);
        mx[qt] = v;
        need = need || (v > 8.f);
      }
      if (__any(need) || kt == 0) {
#pragma unroll
        for (int qt = 0; qt < 2; ++qt) {
          const float delta = (kt == 0) ? mx[qt] : fmaxf(mx[qt], 0.f);
          const float alpha = (kt == 0) ? 1.f : __builtin_amdgcn_exp2f(-delta);
          m[qt] += delta;
          l[qt] *= alpha;
#pragma unroll
          for (int d = 0; d < 8; ++d) O[d][qt] *= alpha;
#pragma unroll
          for (int ksub = 0; ksub < 4; ++ksub)
#pragma unroll
            for (int r = 0; r < 4; ++r) S[ksub][qt][r] -= delta;
        }
      }
      bf16x8 pf[2][2];
#pragma unroll
      for (int qt = 0; qt < 2; ++qt) {
        float psum = 0.f;
#pragma unroll
        for (int ksub = 0; ksub < 4; ++ksub)
#pragma unroll
          for (int r = 0; r < 4; ++r) { const float e = __builtin_amdgcn_exp2f(S[ksub][qt][r]); S[ksub][qt][r] = e; psum += e; }
        l[qt] += psum;
#pragma unroll
        for (int kk = 0; kk < 2; ++kk) {
          union { unsigned u[4]; bf16x8 v; } pk;
          pk.u[0] = pack2(S[2 * kk][qt][0], S[2 * kk][qt][1]);
          pk.u[1] = pack2(S[2 * kk][qt][2], S[2 * kk][qt][3]);
          pk.u[2] = pack2(S[2 * kk + 1][qt][0], S[2 * kk + 1][qt][1]);
          pk.u[3] = pack2(S[2 * kk + 1][qt][2], S[2 * kk + 1][qt][3]);
          pf[kk][qt] = pk.v;
        }
      }
      __builtin_amdgcn_sched_barrier(0);
#pragma unroll
      for (int d = 0; d < 8; ++d) { const int row = d * 16 + c16; vfb[d] = *(const bf16x8*)(Vb + row * 128 + (swz(row, 4 + quad) << 4)); }
#pragma unroll
      for (int d = 0; d < 8; ++d)
#pragma unroll
        for (int qt = 0; qt < 2; ++qt) O[d][qt] = MFMA16(vfa[d], pf[0][qt], O[d][qt]);
      __builtin_amdgcn_sched_barrier(0);
#pragma unroll
      for (int d = 0; d < 8; ++d)
#pragma unroll
        for (int qt = 0; qt < 2; ++qt) O[d][qt] = MFMA16(vfb[d], pf[1][qt], O[d][qt]);
    }
    __syncthreads();
  }
  const float lam = p.lamv[layer];
  const float lam_init = 0.8f - 0.6f * expf(-0.3f * (float)layer);
  float* xch = (float*)(lds + g * 16384);
  float cf[2];
#pragma unroll
  for (int qt = 0; qt < 2; ++qt) cf[qt] = ((sidx == 0) ? 1.f : lam) / quadsum(l[qt]);
  if (sidx == 1) {
#pragma unroll
    for (int d = 0; d < 8; ++d)
#pragma unroll
      for (int qt = 0; qt < 2; ++qt)
#pragma unroll
        for (int r = 0; r < 4; ++r) xch[((d * 2 + qt) * 4 + r) * 64 + lane] = O[d][qt][r] * cf[qt];
  }
  __syncthreads();
  if (sidx == 0) {
    const float* sg = p.da_g + layer * 128;
#pragma unroll
    for (int qt = 0; qt < 2; ++qt) {
      float ss = 0.f;
#pragma unroll
      for (int d = 0; d < 8; ++d)
#pragma unroll
        for (int r = 0; r < 4; ++r) {
          const float o = O[d][qt][r] * cf[qt] - xch[((d * 2 + qt) * 4 + r) * 64 + lane];
          O[d][qt][r] = o; ss += o * o;
        }
      ss = quadsum(ss);
      const float rn = rsqrtf(ss * (1.f / 128.f) + 1e-6f) * (1.f - lam_init);
      const int tok = tok0 + g * 32 + qt * 16 + c16;
#pragma unroll
      for (int d = 0; d < 8; ++d) {
        const int dv0 = d * 16 + quad * 4;
        bf16_t* gp = p.proj + (size_t)tok * PW + C_BG + h * 128 + dv0;
        const uint2 gv = *(const uint2*)gp;
        const float g0 = __uint_as_float(gv.x << 16), g1 = __uint_as_float(gv.x & 0xffff0000u);
        const float g2 = __uint_as_float(gv.y << 16), g3 = __uint_as_float(gv.y & 0xffff0000u);
        uint2 o;
        o.x = pack2(O[d][qt][0] * rn * sg[dv0] * g0, O[d][qt][1] * rn * sg[dv0 + 1] * g1);
        o.y = pack2(O[d][qt][2] * rn * sg[dv0 + 2] * g2, O[d][qt][3] * rn * sg[dv0 + 3] * g3);
        *(uint2*)gp = o;
      }
    }
  }
}

DI void mem_attn_item(const Params& p, int layer, int item, char* lds) {
  const int qb = item >> 4, bh = item & 15, b = bh >> 2, h = bh & 3;
  const int tok0 = b * SEQ + qb * 64;
  const int tid_ = opaque_tid(), lane = tid_ & 63, w = tid_ >> 6, c16 = lane & 15, quad = lane >> 4;
  AttnState<1, 1> st;
  attn_core<1, 1>(st, p.proj + (size_t)tok0 * PW + C_MQ + h * 128, PW,
               p.memk + ((size_t)layer * 1024 + b * 256) * 512 + h * 128, 512,
               p.memvt + ((size_t)((layer * 4 + b) * 4 + h) * 128) * 256, 256, 4, 0, false, lds);
#pragma unroll
  for (int qt = 0; qt < 1; ++qt) {
    const float i1 = 1.f / st.l[0][qt];
    const int tok = tok0 + w * 16 + qt * 16 + c16;
#pragma unroll
    for (int d = 0; d < 8; ++d) {
      const int dv0 = d * 16 + quad * 4;
      bf16_t* g = p.proj + (size_t)tok * PW + C_MG + h * 128 + dv0;
      const uint2 gv = *(const uint2*)g;
      const float g0 = __uint_as_float(gv.x << 16), g1 = __uint_as_float(gv.x & 0xffff0000u);
      const float g2 = __uint_as_float(gv.y << 16), g3 = __uint_as_float(gv.y & 0xffff0000u);
      uint2 o;
      o.x = pack2(st.O[0][d][qt][0] * i1 * g0, st.O[0][d][qt][1] * i1 * g1);
      o.y = pack2(st.O[0][d][qt][2] * i1 * g2, st.O[0][d][qt][3] * i1 * g3);
      *(uint2*)g = o;
    }
  }
}

DI float gelu_tanh(float x) {
  const float u = 0.7978845608028654f * (x + 0.044715f * x * x * x);
  const float t = 1.f - 2.f / (1.f + __expf(2.f * u));
  return 0.5f * x * (1.f + t);
}

template <bool FINAL>
DI void s5_item(const Params& p, int layer, int item, char* lds) {
  const int gq = item & 7, c = (item >> 3) & 127, b = item >> 10;
  const int tid_ = opaque_tid(), lane = tid_ & 63, w = tid_ >> 6, c16 = lane & 15, quad = lane >> 4;
  const int g = gq * 4 + w;
  const int tok0 = b * SEQ + c * 64;
  float* bu = (float*)(lds + w * 16384);
  char* xsb = lds + w * 16384 + 8192;
  bf16x8 bbf[8];
  {
    const bf16_t* bt = p.s5bt + (size_t)(layer * 32 + g) * 128 * 32;
#pragma unroll
    for (int nt = 0; nt < 8; ++nt) bbf[nt] = *(const bf16x8*)(bt + (nt * 16 + c16) * 32 + quad * 8);
  }
  const float* par = p.s5par + (size_t)((layer * 32 + g) * 36) * 64 + lane;
  const float are = par[0], aim = par[64];
  float xr = 0.f, xi = 0.f;
  float* stp = p.s5st + ((size_t)((b * 32 + g) * 128)) * 128 + lane;
  bf16x8 cf[FINAL ? 4 : 1];
  float dsk = 0.f;
  if constexpr (FINAL) {
    xr = stp[c * 128]; xi = stp[c * 128 + 64];
    const float* cr = p.s5_cre + (size_t)((layer * 32 + g) * 16 + c16) * 64;
    const float* ci = p.s5_cim + (size_t)((layer * 32 + g) * 16 + c16) * 64;
#pragma unroll
    for (int ks = 0; ks < 4; ++ks) {
      const float* src = ((ks < 2) ? cr : ci) + (ks & 1) * 32 + quad * 8;
      const float sg = (ks < 2) ? 1.f : -1.f;
      const float4 v0 = *(const float4*)src, v1 = *(const float4*)(src + 4);
      union { unsigned u[4]; bf16x8 v; } pk;
      pk.u[0] = pack2(sg * v0.x, sg * v0.y); pk.u[1] = pack2(sg * v0.z, sg * v0.w);
      pk.u[2] = pack2(sg * v1.x, sg * v1.y); pk.u[3] = pack2(sg * v1.z, sg * v1.w);
      cf[ks] = pk.v;
    }
    dsk = p.s5_d[(layer * 32 + g) * 16 + c16];
  }
  for (int sc = 0; sc < 4; ++sc) {
    const int tb = tok0 + sc * 16;
    bf16x8 uf = bf16x8{0, 0, 0, 0, 0, 0, 0, 0};
    if (quad < 2) uf = *(const bf16x8*)(p.proj + (size_t)(tb + c16) * PW + C_AU + g * 16 + quad * 8);
    float uo[FINAL ? 4 : 1];
    if constexpr (FINAL) {
#pragma unroll
      for (int r = 0; r < 4; ++r) uo[r] = bf2f(p.proj[(size_t)(tb + quad * 4 + r) * PW + C_AU + g * 16 + c16]);
    }
#pragma unroll
    for (int nt = 0; nt < 8; ++nt) {
      f32x4 acc = MFMA16(uf, bbf[nt], (f32x4{0.f, 0.f, 0.f, 0.f}));
#pragma unroll
      for (int r = 0; r < 4; ++r) bu[(quad * 4 + r) * 128 + nt * 16 + c16] = acc[r];
    }
    wave_lds_sync();
#pragma unroll
    for (int tt = 0; tt < 16; ++tt) {
      const float br_ = bu[tt * 128 + lane], bi_ = bu[tt * 128 + 64 + lane];
      const float nr = are * xr - aim * xi + br_;
      const float ni = are * xi + aim * xr + bi_;
      xr = nr; xi = ni;
      if constexpr (FINAL) {
        *(bf16_t*)(xsb + tt * 256 + ((((lane >> 3)) ^ tt) << 4) + (lane & 7) * 2) = f2bf(xr);
        *(bf16_t*)(xsb + tt * 256 + (((8 + (lane >> 3)) ^ tt) << 4) + (lane & 7) * 2) = f2bf(xi);
      }
    }
    if constexpr (FINAL) {
      wave_lds_sync();
      f32x4 y = f32x4{0.f, 0.f, 0.f, 0.f};
#pragma unroll
      for (int ks = 0; ks < 4; ++ks) {
        const bf16x8 xf = *(const bf16x8*)(xsb + c16 * 256 + (((ks * 4 + quad) ^ c16) << 4));
        y = MFMA16(xf, cf[ks], y);
      }
#pragma unroll
      for (int r = 0; r < 4; ++r) {
        const float v = y[r] + dsk * uo[r];
        p.proj[(size_t)(tb + quad * 4 + r) * PW + C_AU + g * 16 + c16] = f2bf(gelu_tanh(v));
      }
    }
    wave_lds_sync();
  }
  if constexpr (!FINAL) { stp[c * 128] = xr; stp[c * 128 + 64] = xi; }
}

template <bool FINAL>
DI void lru_item(const Params& p, int layer, int item, char* lds) {
  const int half = item & 1, c = (item >> 1) & 127, b = item >> 8;
  const int tid_ = opaque_tid(), lane = tid_ & 63, w = tid_ >> 6, c16 = lane & 15, quad = lane >> 4;
  const int n = half * 4 + w, ch = n * 64 + lane;
  const int l0 = c * 64, tok0 = b * SEQ + l0;
  char* xcb = lds + w * 16384;
  float* aba = (float*)(xcb + 8192);
  float* abb = aba + 1024;
  bf16x8 wf[8][2];
  {
    const float* pa = p.lru_wa + (size_t)((layer * 8 + n) * 64) * 64;
    const float* px = p.lru_wx + (size_t)((layer * 8 + n) * 64) * 64;
#pragma unroll
    for (int nt = 0; nt < 8; ++nt) {
      const float* base = ((nt < 4) ? pa : px) + (nt & 3) * 16 + c16;
#pragma unroll
      for (int ks = 0; ks < 2; ++ks) {
        union { unsigned u[4]; bf16x8 v; } pk;
#pragma unroll
        for (int jj = 0; jj < 4; ++jj) {
          const int k = ks * 32 + quad * 8 + jj * 2;
          pk.u[jj] = pack2(base[k * 64], base[(k + 1) * 64]);
        }
        wf[nt][ks] = pk.v;
      }
    }
  }
  float bav[4], bxv[4], spv[4];
#pragma unroll
  for (int nt = 0; nt < 4; ++nt) {
    const int cch = layer * 512 + n * 64 + nt * 16 + c16;
    bav[nt] = p.lru_ba[cch]; bxv[nt] = p.lru_bx[cch];
    spv[nt] = 8.f * log1pf(expf(-p.lru_lam[cch])) * 1.4426950408889634f;
  }
  {
    const float cw0 = p.conv_w[(layer * 4 + 0) * 512 + ch], cw1 = p.conv_w[(layer * 4 + 1) * 512 + ch];
    const float cw2 = p.conv_w[(layer * 4 + 2) * 512 + ch], cw3 = p.conv_w[(layer * 4 + 3) * 512 + ch];
    const float cb = p.conv_b[layer * 512 + ch];
    const bf16_t* xp = p.proj + (size_t)tok0 * PW + C_CX + ch;
    bf16_t xin[67];
#pragma unroll
    for (int t = 0; t < 3; ++t) xin[t] = (l0 + t - 3 >= 0) ? xp[(t - 3) * PW] : (bf16_t)0;
#pragma unroll
    for (int t = 3; t < 67; ++t) xin[t] = xp[(size_t)(t - 3) * PW];
#pragma unroll
    for (int t = 0; t < 64; ++t) {
      const float xc = cw0 * bf2f(xin[t]) + cw1 * bf2f(xin[t + 1]) + cw2 * bf2f(xin[t + 2]) + cw3 * bf2f(xin[t + 3]) + cb;
      *(bf16_t*)(xcb + t * 128 + (swz(t, lane >> 3) << 4) + (lane & 7) * 2) = f2bf(xc);
    }
  }
  float hst = 0.f, pr = 1.f;
  float* stp = p.lrust + ((size_t)(b * 128) * 512 + ch) * 2;
  if constexpr (FINAL) hst = stp[(size_t)c * 1024 + 1];
  wave_lds_sync();
  for (int sc = 0; sc < 4; ++sc) {
    float gv[FINAL ? 16 : 1];
    if constexpr (FINAL) {
      const bf16_t* gp0 = p.proj + (size_t)(tok0 + sc * 16) * PW + C_CG + ch;
#pragma unroll
      for (int t = 0; t < 16; ++t) gv[t] = bf2f(gp0[(size_t)t * PW]);
    }
    f32x4 acc[8];
#pragma unroll
    for (int nt = 0; nt < 8; ++nt) acc[nt] = f32x4{0.f, 0.f, 0.f, 0.f};
    const int arow = sc * 16 + c16;
#pragma unroll
    for (int ks = 0; ks < 2; ++ks) {
      const bf16x8 af = *(const bf16x8*)(xcb + arow * 128 + (swz(arow, ks * 4 + quad) << 4));
#pragma unroll
      for (int nt = 0; nt < 8; ++nt) acc[nt] = MFMA16(af, wf[nt][ks], acc[nt]);
    }
#pragma unroll
    for (int nt = 0; nt < 4; ++nt) {
      const int chl = nt * 16 + c16;
#pragma unroll
      for (int r = 0; r < 4; ++r) {
        const int tl = sc * 16 + quad * 4 + r;
        const float xcv = bf2f(*(const bf16_t*)(xcb + tl * 128 + (swz(tl, chl >> 3) << 4) + (chl & 7) * 2));
        const float ga = acc[nt][r] + bav[nt], gx = acc[nt + 4][r] + bxv[nt];
        const float rr = __builtin_amdgcn_rcpf(1.f + __builtin_amdgcn_exp2f(-1.4426950408889634f * ga));
        const float ig = __builtin_amdgcn_rcpf(1.f + __builtin_amdgcn_exp2f(-1.4426950408889634f * gx));
        const float la2 = -spv[nt] * rr;
        const float a = __builtin_amdgcn_exp2f(la2);
        const float y = la2 * 1.3862943611198906f;
        float q = 1.f + y * (1.f / 6.f);
        q = 1.f + y * 0.2f * q; q = 1.f + y * 0.25f * q; q = 1.f + y * (1.f / 3.f) * q; q = 1.f + y * 0.5f * q;
        const float om = (y < -0.5f) ? (1.f - a * a) : (-y * q);
        const float mult = __builtin_amdgcn_sqrtf(om);
        aba[(quad * 4 + r) * 64 + chl] = a;
        abb[(quad * 4 + r) * 64 + chl] = mult * ig * xcv;
      }
    }
    wave_lds_sync();
#pragma unroll
    for (int tt = 0; tt < 16; ++tt) {
      const float a = aba[tt * 64 + lane], bv = abb[tt * 64 + lane];
      hst = a * hst + bv;
      if constexpr (FINAL) p.proj[(size_t)(tok0 + sc * 16 + tt) * PW + C_CG + ch] = f2bf(hst * gv[tt]);
      else pr *= a;
    }
    wave_lds_sync();
  }
  if constexpr (!FINAL) { *(float2*)(stp + (size_t)c * 1024) = make_float2(pr, hst); }
}

DI void transpose_tile(const Params& p, int t, char* lds) {
  const float* src; bf16_t* dst; int K, N, kt, nt, perm = 0;
  const float* gs = nullptr;
  if (t < 5120) { int l = t / 1280, r = t % 1280; kt = r / 80; nt = r % 80; K = 1024; N = 5120; src = p.w_in + (size_t)l * K * N; dst = p.wt_in + (size_t)l * K * N; gs = p.norm_g + l * 1024; }
  else if (t < 7168) { t -= 5120; int l = t / 512, r = t % 512; kt = r / 16; nt = r % 16; K = 2048; N = 1024; src = p.w_out + (size_t)l * K * N; dst = p.wt_out + (size_t)l * K * N; }
  else if (t < 7680) { t -= 7168; int l = t / 128, r = t % 128; kt = r / 16; nt = r % 16; K = 512; N = 1024; src = p.s5_wglu + (size_t)l * K * N; dst = p.wt_glu + (size_t)l * K * N; perm = 1; }
  else { t -= 7680; int l = t / 256, r = t % 256; kt = r / 16; nt = r % 16; K = 1024; N = 1024; src = p.w_memkv + (size_t)l * K * N; dst = p.wt_mem + (size_t)l * K * N; }
  float* tile = (float*)lds;
  const int tid = opaque_tid(), ty = tid >> 4, tx = tid & 15;
  const int k0 = kt * 64, n0 = nt * 64;
#pragma unroll
  for (int i = 0; i < 4; ++i) {
    const int k = ty + 16 * i;
    const float4 v = *(const float4*)(src + (size_t)(k0 + k) * N + n0 + tx * 4);
    tile[k * 65 + tx * 4] = v.x; tile[k * 65 + tx * 4 + 1] = v.y; tile[k * 65 + tx * 4 + 2] = v.z; tile[k * 65 + tx * 4 + 3] = v.w;
  }
  __syncthreads();
  const int n = tid >> 2, kq = tid & 3;
  unsigned pk[8];
#pragma unroll
  for (int j = 0; j < 8; ++j) {
    const int kk = kq * 16 + 2 * j;
    const float s0 = gs ? gs[kt * 64 + kk] : 1.f, s1 = gs ? gs[kt * 64 + kk + 1] : 1.f;
    pk[j] = pack2(tile[kk * 65 + n] * s0, tile[(kk + 1) * 65 + n] * s1);
  }
  int row = n0 + n;
  if (perm) { const int j = row & 511; row = (j >> 5) * 64 + ((row >= 512) ? 32 : 0) + (j & 31); }
  uint4* d = (uint4*)(dst + (size_t)row * K + k0 + kq * 16);
  d[0] = make_uint4(pk[0], pk[1], pk[2], pk[3]);
  d[1] = make_uint4(pk[4], pk[5], pk[6], pk[7]);
  __syncthreads();
}

DI void phase0(const Params& p, char* lds) {
  const int tid = opaque_tid(), lane = tid & 63, w = tid >> 6;
  for (int t = blockIdx.x; t < 8704; t += gridDim.x) transpose_tile(p, t, lds);
  for (int it = blockIdx.x; it < 8192 + 1024; it += gridDim.x) {
    if (it < 8192) {
      const int row = it * 4 + w;
      const float* xr = p.x + (size_t)row * 1024;
      float4 v[4]; float ss = 0.f;
#pragma unroll
      for (int i = 0; i < 4; ++i) { v[i] = *(const float4*)(xr + i * 256 + lane * 4); ss += v[i].x * v[i].x + v[i].y * v[i].y + v[i].z * v[i].z + v[i].w * v[i].w; }
#pragma unroll
      for (int o = 32; o >= 1; o >>= 1) ss += __shfl_xor(ss, o);
#pragma unroll
      for (int i = 0; i < 4; ++i) {
        const int col = i * 256 + lane * 4;
        uint2 o; o.x = pack2(v[i].x, v[i].y); o.y = pack2(v[i].z, v[i].w);
        *(uint2*)(p.xb + (size_t)row * 1024 + col) = o;
      }
      if (lane == 0) p.rowss[row] = ss;
    } else {
      const int r = (it - 8192) * 4 + w, l = r >> 10, mr = r & 1023;
      const float* xr = p.mem + (size_t)mr * 1024;
      float4 v[4]; float ss = 0.f;
#pragma unroll
      for (int i = 0; i < 4; ++i) { v[i] = *(const float4*)(xr + i * 256 + lane * 4); ss += v[i].x * v[i].x + v[i].y * v[i].y + v[i].z * v[i].z + v[i].w * v[i].w; }
#pragma unroll
      for (int o = 32; o >= 1; o >>= 1) ss += __shfl_xor(ss, o);
      const float rs = rsqrtf(ss * (1.f / 1024.f) + 1e-6f);
#pragma unroll
      for (int i = 0; i < 4; ++i) {
        const int col = i * 256 + lane * 4;
        const float4 g = *(const float4*)(p.memng + l * 1024 + col);
        uint2 o; o.x = pack2(v[i].x * rs * g.x, v[i].y * rs * g.y); o.y = pack2(v[i].z * rs * g.z, v[i].w * rs * g.w);
        *(uint2*)(p.memn + (size_t)r * 1024 + col) = o;
      }
    }
  }
  const int gtid = blockIdx.x * 256 + tid, gstride = gridDim.x * 256;
  for (int i = gtid; i < NT * 8; i += gstride) {
    const int tok = i >> 3, f = i & 7;
    const float inv = powf(500000.f, -(float)(2 * f) / 16.f);
    const float ang = (float)p.pos[tok] * inv;
    float s, c; sincosf(ang, &s, &c);
    p.ropetab[tok * 16 + f] = c; p.ropetab[tok * 16 + 8 + f] = s;
  }
  for (int i = gtid; i < 4 * 32 * 64; i += gstride) {
    const int pp = i & 63, lg = i >> 6;
    const float dt = expf(p.s5_logdt[lg]);
    const float lr = p.s5_lre[i], li = p.s5_lim[i];
    const float mag = expf(lr * dt);
    const float are = mag * cosf(li * dt), aim = mag * sinf(li * dt);
    const float den = lr * lr + li * li;
    const float nr = are - 1.f, ni = aim;
    const float fre = (nr * lr + ni * li) / den, fim = (ni * lr - nr * li) / den;
    float* o = p.s5par + (size_t)lg * 36 * 64 + pp;
    o[0] = are; o[64] = aim;
    bf16_t* btr = p.s5bt + ((size_t)lg * 128 + pp) * 32;
    bf16_t* bti = btr + 64 * 32;
    for (int h = 0; h < 16; ++h) {
      const float br = p.s5_bre[(size_t)i * 16 + h], bi = p.s5_bim[(size_t)i * 16 + h];
      o[(2 + h) * 64] = fre * br - fim * bi;
      o[(18 + h) * 64] = fre * bi + fim * br;
      btr[h] = f2bf(fre * br - fim * bi); bti[h] = f2bf(fre * bi + fim * br);
      btr[16 + h] = 0; bti[16 + h] = 0;
    }
    float tr = are, ti = aim;
    for (int q = 0; q < 6; ++q) { const float a = tr * tr - ti * ti, bq = 2.f * tr * ti; tr = a; ti = bq; }
    o[34 * 64] = tr; o[35 * 64] = ti;
  }
  for (int i = gtid; i < 15 * NT; i += gstride) p.rowss[NT + i] = 0.f;
  if (gtid < 64) p.ctr[gtid] = 0u;
  if (gtid < 4) {
    float s1 = 0.f, s2 = 0.f;
    for (int j = 0; j < 64; ++j) { s1 += p.da_q1[gtid * 64 + j] * p.da_k1[gtid * 64 + j]; s2 += p.da_q2[gtid * 64 + j] * p.da_k2[gtid * 64 + j]; }
    p.lamv[gtid] = expf(s1) - expf(s2) + (0.8f - 0.6f * expf(-0.3f * (float)gtid));
  }
}

DI void carry_phase(const Params& p, int layer) {
  for (int it = blockIdx.x; it < 40; it += gridDim.x) {
    if (it < 32) {
      const int idx = it * 256 + threadIdx.x, b = idx >> 11, g = (idx >> 6) & 31, pp = idx & 63;
      const float* par = p.s5par + (size_t)((layer * 32 + g) * 36) * 64 + pp;
      const float tre = par[34 * 64], tim = par[35 * 64];
      float* base = p.s5st + ((size_t)((b * 32 + g) * 128)) * 128 + pp;
      float xr = 0.f, xi = 0.f;
      for (int c0 = 0; c0 < 128; c0 += 16) {
        float er[16], ei[16];
#pragma unroll
        for (int j = 0; j < 16; ++j) { er[j] = base[(c0 + j) * 128]; ei[j] = base[(c0 + j) * 128 + 64]; }
#pragma unroll
        for (int j = 0; j < 16; ++j) {
          base[(c0 + j) * 128] = xr; base[(c0 + j) * 128 + 64] = xi;
          const float nr = tre * xr - tim * xi + er[j];
          const float ni = tre * xi + tim * xr + ei[j];
          xr = nr; xi = ni;
        }
      }
    } else {
      const int idx = (it - 32) * 256 + threadIdx.x, b = idx >> 9, ch = idx & 511;
      float* base = p.lrust + ((size_t)(b * 128) * 512 + ch) * 2;
      float h = 0.f;
      for (int c0 = 0; c0 < 128; c0 += 16) {
        float2 e[16];
#pragma unroll
        for (int j = 0; j < 16; ++j) e[j] = *(const float2*)(base + (size_t)(c0 + j) * 1024);
#pragma unroll
        for (int j = 0; j < 16; ++j) {
          base[(size_t)(c0 + j) * 1024 + 1] = h;
          h = e[j].x * h + e[j].y;
        }
      }
    }
  }
}

DI bool tile_map(int i, int ncols, int& m, int& n) {
  if (gridDim.x == 512) {
    const int x = blockIdx.x & 7, j = blockIdx.x >> 3, ncg = ncols >> 3;
    m = 16 * x + 8 * (i / ncg) + (j >> 3);
    n = 8 * (i % ncg) + (j & 7);
    return i < 2 * ncg;
  }
  const int t = blockIdx.x + i * gridDim.x;
  m = t / ncols; n = t % ncols;
  return t < 128 * ncols;
}

DI int next_item(unsigned* ctr, int* sh) {
  __syncthreads();
  if (threadIdx.x == 0) *sh = (int)atomicAdd(ctr, 1u);
  __syncthreads();
  return *sh;
}

__global__ void __launch_bounds__(256, 2) hymba_forward(Params p) {
  extern __shared__ __attribute__((aligned(16))) char lds[];
  __shared__ uint4 xb_words;
  cg::grid_group grid = cg::this_grid();
  int* sh_item = (int*)(lds + 73728);
  if (threadIdx.x == 0) xb_words = make_uint4(0u, 0u, 0u, 0u);
  __syncthreads();
  XcdBarrier xb = xcd_barrier_post(p.bar, (volatile LAS unsigned*)&xb_words);
  phase0(p, lds);
  if (gridDim.x == 0x7fffffffu) grid.sync();
  xcd_barrier(xb);
  for (int layer = 0; layer < 4; ++layer) {
    {
      GemmArgs ga; ga.A = p.xb; ga.lda = 1024; ga.mix = 0; ga.Bt = p.wt_in + (size_t)layer * 5120 * 1024; ga.K = 1024;
      EpiArgs ea; ea.p = &p; ea.layer = layer; ea.rowss = p.rowss + (size_t)layer * 16 * NT; ea.xsrc = nullptr; ea.gnext = nullptr; ea.rowss_next = nullptr;
      for (int i = 0;; ++i) { int m, n; if (!tile_map(i, 40, m, n)) break; gemm_tile<EPI_INPROJ>(ga, ea, m * 256, n * 128, lds); }
      if (layer == 0) {
        for (int t = blockIdx.x; t < 128; t += gridDim.x) {
          const int lm = t >> 5, r = t & 31;
          GemmArgs gm; gm.A = p.memn + (size_t)lm * 1024 * 1024; gm.lda = 1024; gm.mix = 0; gm.Bt = p.wt_mem + (size_t)lm * 1024 * 1024; gm.K = 1024;
          EpiArgs em = ea; em.layer = lm;
          gemm_tile<EPI_MEMKV>(gm, em, (r >> 3) * 256, (r & 7) * 128, lds);
        }
      }
    }
    xcd_barrier(xb);
    {
      unsigned* ctr = p.ctr + layer * 2;
      for (;;) {
        const int it = next_item(ctr, sh_item);
        if (it >= 1024 + 4096) break;
        if (it < 1024) lru_item<false>(p, layer, it, lds);
        else s5_item<false>(p, layer, it - 1024, lds);
      }
    }
    xcd_barrier(xb);
    carry_phase(p, layer);
    xcd_barrier(xb);
    {
      unsigned* actr = p.ctr + 16 + layer * 8 + (blockIdx.x & 7);
      for (;;) {
        const int it = next_item(actr, sh_item);
        if (it >= 256) break;
        diff_attn_item(p, layer, 127 - (it >> 1), (blockIdx.x & 7) * 2 + (it & 1), lds);
      }
      unsigned* ctr = p.ctr + layer * 2 + 1;
      for (;;) {
        const int it = next_item(ctr, sh_item);
        if (it >= 1024 + 4096 + 2048) break;
        if (it < 1024) lru_item<true>(p, layer, it, lds);
        else if (it < 5120) s5_item<true>(p, layer, it - 1024, lds);
        else mem_attn_item(p, layer, it - 5120, lds);
      }
    }
    xcd_barrier(xb);
    {
      GemmArgs ga; ga.A = p.proj + C_AU; ga.lda = PW; ga.mix = 0; ga.Bt = p.wt_glu + (size_t)layer * 1024 * 512; ga.K = 512;
      EpiArgs ea; ea.p = &p; ea.layer = layer; ea.rowss = nullptr; ea.xsrc = nullptr; ea.gnext = nullptr; ea.rowss_next = nullptr;
      for (int i = 0;; ++i) { int m, n; if (!tile_map(i, 8, m, n)) break; gemm_tile<EPI_GLU>(ga, ea, m * 256, n * 128, lds); }
    }
    xcd_barrier(xb);
    {
      GemmArgs ga; ga.A = p.proj; ga.lda = PW; ga.mix = 1; ga.Bt = p.wt_out + (size_t)layer * 1024 * 2048; ga.K = 2048;
      EpiArgs ea; ea.p = &p; ea.layer = layer; ea.rowss = nullptr;
      ea.xsrc = nullptr;
      ea.gnext = (layer < 3) ? (p.norm_g + (layer + 1) * 1024) : nullptr;
      ea.rowss_next = p.rowss + (size_t)(layer + 1) * 16 * NT;
      for (int i = 0;; ++i) { int m, n; if (!tile_map(i, 8, m, n)) break; gemm_tile<EPI_OUT>(ga, ea, m * 256, n * 128, lds); }
    }
    xcd_barrier(xb);
  }
  {
    const float* rss = p.rowss + (size_t)4 * 16 * NT;
    const int lane = threadIdx.x & 63, w = threadIdx.x >> 6;
    for (int row = blockIdx.x * 4 + w; row < NT; row += gridDim.x * 4) {
      const float rs = rsqrtf(sum16(rss, row) * (1.f / 1024.f) + 1e-6f);
#pragma unroll
      for (int i = 0; i < 4; ++i) {
        const int col = i * 256 + lane * 4;
        const uint2 u = *(const uint2*)(p.xb + (size_t)row * 1024 + col);
        const float4 g = *(const float4*)(p.fng + col);
        float4 v;
        v.x = __uint_as_float(u.x << 16) * rs * g.x; v.y = __uint_as_float(u.x & 0xffff0000u) * rs * g.y;
        v.z = __uint_as_float(u.y << 16) * rs * g.z; v.w = __uint_as_float(u.y & 0xffff0000u) * rs * g.w;
        *(float4*)(p.out + (size_t)row * 1024 + col) = v;
      }
    }
  }
}

extern "C" void kernel_launch(void* const* d_in, const int* in_sizes, int n_in, void* d_out, int out_size, void* d_ws,
                              size_t ws_size, hipStream_t stream) {
  Params p{};
  p.x = (const float*)d_in[0]; p.mem = (const float*)d_in[1]; p.pos = (const int*)d_in[2];
  p.norm_g = (const float*)d_in[3]; p.w_in = (const float*)d_in[4]; p.w_out = (const float*)d_in[5];
  p.s5_lre = (const float*)d_in[6]; p.s5_lim = (const float*)d_in[7]; p.s5_logdt = (const float*)d_in[8];
  p.s5_bre = (const float*)d_in[9]; p.s5_bim = (const float*)d_in[10]; p.s5_cre = (const float*)d_in[11];
  p.s5_cim = (const float*)d_in[12]; p.s5_d = (const float*)d_in[13]; p.s5_wglu = (const float*)d_in[14];
  p.da_q1 = (const float*)d_in[15]; p.da_k1 = (const float*)d_in[16]; p.da_q2 = (const float*)d_in[17];
  p.da_k2 = (const float*)d_in[18]; p.da_g = (const float*)d_in[19];
  p.conv_w = (const float*)d_in[20]; p.conv_b = (const float*)d_in[21]; p.lru_wa = (const float*)d_in[22];
  p.lru_ba = (const float*)d_in[23]; p.lru_wx = (const float*)d_in[24]; p.lru_bx = (const float*)d_in[25];
  p.lru_lam = (const float*)d_in[26]; p.memng = (const float*)d_in[27]; p.w_memkv = (const float*)d_in[28];
  p.fng = (const float*)d_in[29];
  p.out = (float*)d_out;
  char* ws = (char*)d_ws; size_t off = 0;
  auto take = [&](size_t bytes) { char* r = ws + off; off += (bytes + 255) & ~(size_t)255; return r; };
  p.proj = (bf16_t*)take((size_t)NT * PW * 2);
  p.vt = (bf16_t*)take((size_t)NT * 512 * 2);
  p.xb = (bf16_t*)take((size_t)NT * 1024 * 2);
  p.wt_in = (bf16_t*)take((size_t)4 * 5120 * 1024 * 2);
  p.wt_out = (bf16_t*)take((size_t)4 * 1024 * 2048 * 2);
  p.wt_glu = (bf16_t*)take((size_t)4 * 1024 * 512 * 2);
  p.wt_mem = (bf16_t*)take((size_t)4 * 1024 * 1024 * 2);
  p.memn = (bf16_t*)take((size_t)4 * 1024 * 1024 * 2);
  p.memk = (bf16_t*)take((size_t)4 * 1024 * 512 * 2);
  p.memvt = (bf16_t*)take((size_t)4 * 1024 * 512 * 2);
  p.rowss = (float*)take((size_t)5 * 16 * NT * 4);
  p.ropetab = (float*)take((size_t)NT * 16 * 4);
  p.s5par = (float*)take((size_t)4 * 32 * 36 * 64 * 4);
  p.s5st = (float*)take((size_t)4 * 32 * 128 * 128 * 4);
  p.lrust = (float*)take((size_t)4 * 128 * 512 * 2 * 4);
  p.lamv = (float*)take(256);
  p.s5bt = (bf16_t*)take((size_t)4 * 32 * 128 * 32 * 2);
  p.ctr = (unsigned*)take(1024);
  p.bar = (unsigned*)take((size_t)XCD_BAR_WORDS * 4);
  if (off > ws_size) { fprintf(stderr, "workspace too small: need %zu have %zu\n", off, ws_size); return; }
  static int grid_blocks = 0;
  if (!grid_blocks) {
    int dev = 0, cus = 0, per_cu = 0;
    hipGetDevice(&dev);
    hipDeviceGetAttribute(&cus, hipDeviceAttributeMultiprocessorCount, dev);
    hipFuncSetAttribute((const void*)hymba_forward, hipFuncAttributeMaxDynamicSharedMemorySize, LDS_BYTES);
    hipOccupancyMaxActiveBlocksPerMultiprocessor(&per_cu, hymba_forward, 256, LDS_BYTES);
    if (per_cu < 1) per_cu = 1;
    if (per_cu > 2) per_cu = 2;
    grid_blocks = cus * per_cu;
  }
  hipMemsetAsync(p.bar, 0, (size_t)XCD_BAR_WORDS * 4, stream);
  void* args[] = {&p};
  hipError_t e = hipLaunchCooperativeKernel((const void*)hymba_forward, dim3(grid_blocks), dim3(256), args, LDS_BYTES, stream);
  if (e != hipSuccess) fprintf(stderr, "cooperative launch failed: %s (grid %d)\n", hipGetErrorString(e), grid_blocks);
}
```

```cpp
#include <hip/hip_runtime.h>
#include <hip/hip_cooperative_groups.h>
#include <cstdio>
namespace cg = cooperative_groups;

typedef unsigned short bf16_t;
typedef __attribute__((ext_vector_type(8))) short bf16x8;
typedef __attribute__((ext_vector_type(4))) short s16x4;
typedef __attribute__((ext_vector_type(4))) float f32x4;

#define DI __device__ __forceinline__
#define MFMA16(a, b, c) __builtin_amdgcn_mfma_f32_16x16x32_bf16((a), (b), (c), 0, 0, 0)

constexpr int NT = 32768;
constexpr int SEQ = 8192;
constexpr int PW = 4608;
constexpr int C_AU = 0, C_AG = 512, C_Q = 1024, C_K = 1536, C_BG = 2048, C_CX = 2560, C_CG = 3072, C_MQ = 3584, C_MG = 4096;
constexpr int LDS_BYTES = 73728 + 64 + 1024;

struct Params {
  const float *x, *mem; const int* pos;
  const float *norm_g, *w_in, *w_out, *s5_lre, *s5_lim, *s5_logdt, *s5_bre, *s5_bim, *s5_cre, *s5_cim, *s5_d, *s5_wglu;
  const float *da_q1, *da_k1, *da_q2, *da_k2, *da_g;
  const float *conv_w, *conv_b, *lru_wa, *lru_ba, *lru_wx, *lru_bx, *lru_lam, *memng, *w_memkv, *fng;
  float* out;
  bf16_t *proj, *vt, *xb, *wt_in, *wt_out, *wt_glu, *wt_mem, *memn, *memk, *memvt;
  float *rowss, *ropetab, *s5par, *s5st, *lrust, *lamv;
  bf16_t* s5bt;
  bf16_t* lruwt;
  unsigned* ctr;
  unsigned* bar;
};

typedef __bf16 bf2_t __attribute__((ext_vector_type(2)));
typedef float f2_t __attribute__((ext_vector_type(2)));
DI unsigned pack2(float a, float b) { f2_t v = {a, b}; return __builtin_bit_cast(unsigned, __builtin_convertvector(v, bf2_t)); }
DI bf16_t f2bf(float x) { return (bf16_t)(pack2(x, 0.f) & 0xffffu); }
DI float bf2f(bf16_t h) { return __uint_as_float(((unsigned)h) << 16); }
DI float sigmoidf_(float x) { return 1.f / (1.f + __expf(-x)); }
DI float siluf_(float x) { return x / (1.f + __expf(-x)); }
DI int opaque_tid() { int t = threadIdx.x; asm volatile("" : "+v"(t)); return t; }
DI float quadmax(float x) {
  auto r = __builtin_amdgcn_permlane16_swap(__float_as_uint(x), __float_as_uint(x), false, false);
  const float m = fmaxf(__uint_as_float(r[0]), __uint_as_float(r[1]));
  auto q = __builtin_amdgcn_permlane32_swap(__float_as_uint(m), __float_as_uint(m), false, false);
  return fmaxf(__uint_as_float(q[0]), __uint_as_float(q[1]));
}
DI float quadsum(float x) {
  auto r = __builtin_amdgcn_permlane16_swap(__float_as_uint(x), __float_as_uint(x), false, false);
  const float m = __uint_as_float(r[0]) + __uint_as_float(r[1]);
  auto q = __builtin_amdgcn_permlane32_swap(__float_as_uint(m), __float_as_uint(m), false, false);
  return __uint_as_float(q[0]) + __uint_as_float(q[1]);
}
DI float sum16(const float* base, int row) { float t = 0.f;
#pragma unroll
  for (int k = 0; k < 16; ++k) t += base[(size_t)k * NT + row];
  return t; }
DI void wave_lds_sync() { asm volatile("s_waitcnt lgkmcnt(0)" ::: "memory"); __builtin_amdgcn_wave_barrier(); }
DI int swz(int row, int c) { return c ^ ((row >> 1) & 7); }

#define XB_TMO      128
#define XB_XCNT(j)  (256  + 64 * (j))
#define XB_XSUB(j)  (1280 + 64 * (j))
#define XB_XGEN(j)  (2304 + 64 * (j))
#define XB_TOP      3328
#define XB_TOPGEN   3392
#define XCD_BAR_WORDS 3456
#define XB_SPIN_CAP (1u << 18)
#define LAS __attribute__((address_space(3)))

__device__ __forceinline__ unsigned xb_ld(unsigned* p)              { return __hip_atomic_load(p, __ATOMIC_RELAXED, __HIP_MEMORY_SCOPE_AGENT); }
__device__ __forceinline__ unsigned xb_add(unsigned* p, unsigned v) { return __hip_atomic_fetch_add(p, v, __ATOMIC_RELAXED, __HIP_MEMORY_SCOPE_AGENT); }
__device__ __forceinline__ unsigned xb_xcc_id() { return (unsigned)__builtin_amdgcn_s_getreg((3 << 11) | 20) & 0xFu; }
#define XB_SPIN(cond, bar) do { unsigned _sp = 0; while (cond) { __builtin_amdgcn_s_sleep(1); \
    if ((++_sp & 255u) == 0u) { if (xb_ld(&(bar)[XB_TMO])) break; if (_sp > XB_SPIN_CAP) { atomicAdd(&(bar)[XB_TMO], 1u); break; } } } } while (0)

struct XcdBarrier {
    unsigned* bar; unsigned x;
    volatile LAS unsigned* st;
};

__device__ __forceinline__ XcdBarrier xcd_barrier_post(unsigned* bar, volatile LAS unsigned* st) {
    XcdBarrier b; b.bar = bar; b.x = xb_xcc_id(); b.st = st;
    if (threadIdx.x == 0) (void)xb_add(&bar[XB_XCNT(b.x)], 1u);
    return b;
}
__device__ __forceinline__ void xcd_barrier_complete(unsigned* bar, unsigned x, unsigned& nloc, unsigned& nx) {
    const unsigned G = gridDim.x * gridDim.y * gridDim.z;
    unsigned sum, cnt, mine, sp = 0u;
    for (;;) {
        sum = 0u; cnt = 0u; mine = 0u;
#pragma unroll
        for (unsigned j = 0; j < 16; ++j) { const unsigned c = xb_ld(&bar[XB_XCNT(j)]); sum += c; cnt += (c > 0u) ? 1u : 0u; mine = (j == x) ? c : mine; }
        if (sum == G) break;
        __builtin_amdgcn_s_sleep(1);
        if ((++sp & 255u) == 0u) { if (xb_ld(&bar[XB_TMO])) break; if (sp > XB_SPIN_CAP) { atomicAdd(&bar[XB_TMO], 1u); break; } }
    }
    nloc = mine > 0u ? mine : 1u; nx = cnt > 0u ? cnt : 1u;
}

__device__ __forceinline__ void xcd_barrier(const XcdBarrier& b) {
    asm volatile("s_waitcnt vmcnt(0)" ::: "memory");
    __syncthreads();
    if (threadIdx.x == 0) {
        unsigned* bar = b.bar;
        __builtin_amdgcn_s_waitcnt(0);
        unsigned nloc = b.st[0], nx = b.st[1];
        if (nloc == 0u) { xcd_barrier_complete(bar, b.x, nloc, nx); b.st[0] = nloc; b.st[1] = nx; }
        const unsigned old = xb_add(&bar[XB_XSUB(b.x)], 1u);
        const unsigned gen = old / nloc;
        if (old + 1u == (gen + 1u) * nloc) {
            __builtin_amdgcn_fence(__ATOMIC_RELEASE, "agent");
            asm volatile("s_waitcnt vmcnt(0)" ::: "memory");
            const unsigned og = xb_add(&bar[XB_TOP], 1u);
            const unsigned tg = og / nx;
            if (og + 1u == (tg + 1u) * nx) xb_add(&bar[XB_TOPGEN], 1u);
            else XB_SPIN(xb_ld(&bar[XB_TOPGEN]) == tg, bar);
            __builtin_amdgcn_fence(__ATOMIC_ACQUIRE, "agent");
            xb_add(&bar[XB_XGEN(b.x)], 1u);
            asm volatile("s_waitcnt vmcnt(0)" ::: "memory");
        } else {
            XB_SPIN(xb_ld(&bar[XB_XGEN(b.x)]) == gen, bar);
            __builtin_amdgcn_fence(__ATOMIC_ACQUIRE, "agent");
            asm volatile("s_waitcnt vmcnt(0)" ::: "memory");
        }
    }
    __syncthreads();
}


struct GemmArgs {
  const bf16_t* A; int lda; int mix;
  const bf16_t* Bt; int K;
};
DI int mixcol(int k0) { int g = k0 >> 9; int s = (g == 0) ? C_AG : (g == 1) ? C_BG : (g == 2) ? C_CG : C_MG; return s + (k0 & 511); }

enum { EPI_INPROJ = 0, EPI_MEMKV = 1, EPI_GLU = 2, EPI_OUT = 3 };

struct EpiArgs {
  const Params* p; int layer;
  const float* rowss;
  const float* xsrc;
  const float* gnext;
  float* rowss_next;
};

DI int swz64(int row, int c) { return c ^ ((0x1320 >> (((row >> 2) & 3) * 4)) & 3); }

template <int EPI>
DI void gemm_tile(const GemmArgs& ga, const EpiArgs& ea, int m0, int n0, char* lds) {
  const int tid = opaque_tid(), lane = tid & 63, w = tid >> 6;
  const int wm = w >> 1, wn = w & 1, c16 = lane & 15, quad = lane >> 4;
  f32x4 acc[8][4];
#pragma unroll
  for (int i = 0; i < 8; ++i)
#pragma unroll
    for (int j = 0; j < 4; ++j) acc[i][j] = f32x4{0.f, 0.f, 0.f, 0.f};
  const int K = ga.K, nk = K >> 5;
  float rowsum = 0.f;
  if constexpr (EPI == EPI_INPROJ) rowsum = sum16(ea.rowss, m0 + tid);
  const int prow = lane >> 2, pch = lane & 3;
  const bf16_t* gsrc[6];
  int ldsoff[6];
#pragma unroll
  for (int i = 0; i < 6; ++i) {
    const int pi = w * 6 + i;
    if (pi < 16) {
      const int row = pi * 16 + prow;
      gsrc[i] = ga.A + (size_t)(m0 + row) * ga.lda + swz64(row, pch) * 8;
      ldsoff[i] = pi * 1024 + lane * 16;
    } else {
      const int row = (pi - 16) * 16 + prow;
      gsrc[i] = ga.Bt + (size_t)(n0 + row) * K + swz64(row, pch) * 8;
      ldsoff[i] = pi * 1024 + lane * 16;
    }
  }
  auto dma = [&](int kt, int buf) {
    const int k0 = kt << 5;
    const int ac = ga.mix ? mixcol(k0) : k0;
    char* base = lds + buf * 24576;
#pragma unroll
    for (int i = 0; i < 6; ++i) {
      const int pi = w * 6 + i;
      __builtin_amdgcn_global_load_lds((const unsigned*)(gsrc[i] + ((pi < 16) ? ac : k0)), (unsigned*)(base + ldsoff[i]), 16, 0, 0);
    }
  };
  __syncthreads();
  dma(0, 0);
  if (nk > 1) dma(1, 1);
  for (int kt = 0; kt < nk; ++kt) {
    if (kt + 1 < nk) asm volatile("s_waitcnt vmcnt(6)" ::: "memory");
    else asm volatile("s_waitcnt vmcnt(0)" ::: "memory");
    __builtin_amdgcn_s_barrier();
    const char* Ab = lds + (kt % 3) * 24576 + wm * 128 * 64;
    const char* Bb = lds + (kt % 3) * 24576 + 16384 + wn * 64 * 64;
    bf16x8 af[8], bfr[4];
    const int ch = swz64(c16, quad) << 4;
#pragma unroll
    for (int nt = 0; nt < 4; ++nt) bfr[nt] = *(const bf16x8*)(Bb + (nt * 16 + c16) * 64 + ch);
#pragma unroll
    for (int mt = 0; mt < 2; ++mt) af[mt] = *(const bf16x8*)(Ab + (mt * 16 + c16) * 64 + ch);
    __builtin_amdgcn_sched_barrier(0);
    if (kt + 2 < nk) dma(kt + 2, (kt + 2) % 3);
    __builtin_amdgcn_sched_barrier(0);
#pragma unroll
    for (int g = 0; g < 4; ++g) {
      if (g < 3) {
#pragma unroll
        for (int mt = 2 * g + 2; mt < 2 * g + 4; ++mt) af[mt] = *(const bf16x8*)(Ab + (mt * 16 + c16) * 64 + ch);
      }
#pragma unroll
      for (int mt = 2 * g; mt < 2 * g + 2; ++mt)
#pragma unroll
        for (int nt = 0; nt < 4; ++nt) acc[mt][nt] = MFMA16(bfr[nt], af[mt], acc[mt][nt]);
      __builtin_amdgcn_sched_barrier(0);
    }
  }
  const Params& p = *ea.p;
  if constexpr (EPI == EPI_INPROJ) {
    const int slot = n0 >> 9;
    const int dbase = (slot < 4) ? slot * 512 : (slot - 1) * 512;
    float* rsc = (float*)(lds + 73728 + 64);
    rsc[tid] = rsqrtf(rowsum * (1.f / 1024.f) + 1e-6f);
    __syncthreads();
#pragma unroll
    for (int mt = 0; mt < 8; ++mt) {
      const int row = m0 + wm * 128 + mt * 16 + c16;
      const float rs = rsc[wm * 128 + mt * 16 + c16];
#pragma unroll
      for (int nt = 0; nt < 4; ++nt) {
        const int cc0 = (n0 & 511) + wn * 64 + nt * 16 + quad * 4;
        float v[4];
#pragma unroll
        for (int r = 0; r < 4; ++r) v[r] = acc[mt][nt][r] * rs;
        if (slot == 4) {
          const int b = row >> 13, l = row & 8191, h = cc0 >> 7, dv0 = cc0 & 127;
          const int lp = (l & ~31) | (((l >> 2) & 3) << 3) | (((l >> 4) & 1) << 2) | (l & 3);
#pragma unroll
          for (int r = 0; r < 4; ++r) p.vt[((size_t)((b * 4 + h) * 128 + dv0 + r)) * SEQ + lp] = f2bf(v[r]);
        } else {
          if (slot == 2 || slot == 3) {
            if (nt == 0) {
              const float* cs = p.ropetab + (size_t)row * 16 + (quad & 1) * 4;
              const float4 co = *(const float4*)cs, si = *(const float4*)(cs + 8);
              const float cov[4] = {co.x, co.y, co.z, co.w}, siv[4] = {si.x, si.y, si.z, si.w};
#pragma unroll
              for (int r = 0; r < 4; ++r) {
                const float pr = __shfl_xor(v[r], 32);
                v[r] = (quad < 2) ? (v[r] * cov[r] - pr * siv[r]) : (v[r] * cov[r] + pr * siv[r]);
              }
            }
            if (slot == 2) {
#pragma unroll
              for (int r = 0; r < 4; ++r) v[r] *= 0.18033688011112042f;
            }
          } else if (slot == 1 || slot == 5 || slot == 7 || slot == 9) {
#pragma unroll
            for (int r = 0; r < 4; ++r) v[r] = siluf_(v[r]);
          } else if (slot == 8) {
#pragma unroll
            for (int r = 0; r < 4; ++r) v[r] *= 0.12751743082459868f;
          }
          uint2 pk; pk.x = pack2(v[0], v[1]); pk.y = pack2(v[2], v[3]);
          *(uint2*)(p.proj + (size_t)row * PW + dbase + cc0) = pk;
        }
      }
    }
  } else if constexpr (EPI == EPI_MEMKV) {
    const int lm = ea.layer;
#pragma unroll
    for (int mt = 0; mt < 8; ++mt) {
      const int row = m0 + wm * 128 + mt * 16 + c16;
#pragma unroll
      for (int nt = 0; nt < 4; ++nt) {
        const int col0 = n0 + wn * 64 + nt * 16 + quad * 4;
        if (col0 < 512) {
          uint2 pk; pk.x = pack2(acc[mt][nt][0], acc[mt][nt][1]); pk.y = pack2(acc[mt][nt][2], acc[mt][nt][3]);
          *(uint2*)(p.memk + ((size_t)lm * 1024 + row) * 512 + col0) = pk;
        } else {
          const int cc0 = col0 - 512, h = cc0 >> 7, dv0 = cc0 & 127, b = row >> 8, m = row & 255;
          const int mp = (m & ~31) | (((m >> 2) & 3) << 3) | (((m >> 4) & 1) << 2) | (m & 3);
#pragma unroll
          for (int r = 0; r < 4; ++r) p.memvt[((size_t)((lm * 4 + b) * 4 + h) * 128 + dv0 + r) * 256 + mp] = f2bf(acc[mt][nt][r]);
        }
      }
    }
  } else if constexpr (EPI == EPI_GLU) {
    const int blk = (n0 + wn * 64) >> 6;
#pragma unroll
    for (int mt = 0; mt < 8; ++mt) {
      const int row = m0 + wm * 128 + mt * 16 + c16;
#pragma unroll
      for (int nt = 0; nt < 2; ++nt) {
        const int j0 = blk * 32 + nt * 16 + quad * 4;
        uint2* q = (uint2*)(p.proj + (size_t)row * PW + C_AG + j0);
        const uint2 gv = *q;
        const float g0 = __uint_as_float(gv.x << 16), g1 = __uint_as_float(gv.x & 0xffff0000u);
        const float g2 = __uint_as_float(gv.y << 16), g3 = __uint_as_float(gv.y & 0xffff0000u);
        uint2 o;
        o.x = pack2(acc[mt][nt][0] * sigmoidf_(acc[mt][nt + 2][0]) * g0, acc[mt][nt][1] * sigmoidf_(acc[mt][nt + 2][1]) * g1);
        o.y = pack2(acc[mt][nt][2] * sigmoidf_(acc[mt][nt + 2][2]) * g2, acc[mt][nt][3] * sigmoidf_(acc[mt][nt + 2][3]) * g3);
        *q = o;
      }
    }
  } else {
#pragma unroll
    for (int mt = 0; mt < 8; ++mt) {
      const int row = m0 + wm * 128 + mt * 16 + c16;
      float ss = 0.f;
#pragma unroll
      for (int nt = 0; nt < 4; ++nt) {
        const int col0 = n0 + wn * 64 + nt * 16 + quad * 4;
        const size_t idx = (size_t)row * 1024 + col0;
        float4 xo;
        if (ea.xsrc) xo = *(const float4*)(ea.xsrc + idx);
        else {
          const uint2 u = *(const uint2*)(p.xb + idx);
          xo = make_float4(__uint_as_float(u.x << 16), __uint_as_float(u.x & 0xffff0000u), __uint_as_float(u.y << 16), __uint_as_float(u.y & 0xffff0000u));
        }
        float4 xn;
        xn.x = xo.x + acc[mt][nt][0]; xn.y = xo.y + acc[mt][nt][1]; xn.z = xo.z + acc[mt][nt][2]; xn.w = xo.w + acc[mt][nt][3];
        ss += xn.x * xn.x + xn.y * xn.y + xn.z * xn.z + xn.w * xn.w;
        {
          uint2 o; o.x = pack2(xn.x, xn.y); o.y = pack2(xn.z, xn.w);
          *(uint2*)(p.xb + idx) = o;
        }
      }
      ss = quadsum(ss);
      if (quad == 0) ea.rowss_next[(size_t)((n0 >> 7) * 2 + wn) * NT + row] = ss;
    }
  }
}

template <int NS, int QT>
struct AttnState {
  f32x4 O[NS][8][QT];
  float l[NS][QT];
};

template <int NS, int QT>
DI void attn_core(AttnState<NS, QT>& st, const bf16_t* qp, int qstride, const bf16_t* kp, int kstride,
                          const bf16_t* vtp, int vtstride, int nkt, int qpos0, bool causal, char* lds) {
  const int tid = opaque_tid(), lane = tid & 63, w = tid >> 6, c16 = lane & 15, quad = lane >> 4;
  bf16x8 qf[QT][4];
#pragma unroll
  for (int qt = 0; qt < QT; ++qt)
#pragma unroll
    for (int f = 0; f < 4; ++f)
      qf[qt][f] = *(const bf16x8*)(qp + (size_t)(w * 16 * QT + qt * 16 + c16) * qstride + f * 32 + quad * 8);
  float m[NS][QT];
#pragma unroll
  for (int s = 0; s < NS; ++s)
#pragma unroll
    for (int qt = 0; qt < QT; ++qt) {
      m[s][qt] = 0.f; st.l[s][qt] = 0.f;
#pragma unroll
      for (int d = 0; d < 8; ++d) st.O[s][d][qt] = f32x4{0.f, 0.f, 0.f, 0.f};
    }
  const int prow = lane >> 3, pch = lane & 7;
  unsigned koff[4], voff[4];
#pragma unroll
  for (int i = 0; i < 4; ++i) {
    const int pi = w * 4 + i;
    { const int row = (pi & 7) * 8 + prow, sub = pi >> 3, c = pch ^ ((row >> 1) & 7);
      koff[i] = (unsigned)((row * kstride + sub * 64 + c * 8) * 2); }
    { const int row = pi * 8 + prow, c = pch ^ ((row >> 1) & 7);
      voff[i] = (unsigned)((row * vtstride + c * 8) * 2); }
  }
  auto gload = [&](int kt, int buf) {
    char* base = lds + buf * 32768;
    const char* kt_base = (const char*)(kp + (size_t)kt * 64 * kstride);
    const char* vt_base = (const char*)(vtp + (size_t)kt * 64);
#pragma unroll
    for (int i = 0; i < 4; ++i)
      __builtin_amdgcn_global_load_lds((const unsigned*)(kt_base + koff[i]), (unsigned*)(base + (w * 4 + i) * 1024 + lane * 16), 16, 0, 0);
#pragma unroll
    for (int i = 0; i < 4; ++i)
      __builtin_amdgcn_global_load_lds((const unsigned*)(vt_base + voff[i]), (unsigned*)(base + 16384 + (w * 4 + i) * 1024 + lane * 16), 16, 0, 0);
  };
  const int qw0 = qpos0 + w * 16 * QT;
  gload(0, 0); __syncthreads();
  for (int kt = 0; kt < nkt; ++kt) {
    if (kt + 1 < nkt) gload(kt + 1, (kt + 1) & 1);
    const char* Kb = lds + (kt & 1) * 32768;
    const char* Vb = Kb + 16384;
    const bool active = !causal || (kt * 64 <= qw0 + 16 * QT - 1);
    if (active) {
      const bool need_mask = causal && (kt * 64 + 63 > qw0);
      bf16x8 pf[NS][2][QT];
      f32x4 S[NS][4][QT];
#pragma unroll
      for (int s = 0; s < NS; ++s)
#pragma unroll
        for (int a = 0; a < 4; ++a)
#pragma unroll
          for (int qt = 0; qt < QT; ++qt) { const float nm = -m[s][qt]; S[s][a][qt] = f32x4{nm, nm, nm, nm}; }
      bf16x8 kfa[8], kfb[8], vfa[8], vfb[8];
#pragma unroll
      for (int i = 0; i < 8; ++i) {
        const int ksub = i & 3, row = ksub * 16 + c16, chunk = (i >> 2) * 4 + quad;
        kfa[i] = *(const bf16x8*)(Kb + row * 128 + (swz(row, chunk) << 4));
      }
      __builtin_amdgcn_sched_barrier(0);
#pragma unroll
      for (int i = 0; i < 8; ++i) {
        const int ksub = i & 3, row = ksub * 16 + c16, chunk = (i >> 2) * 4 + quad;
        kfb[i] = *(const bf16x8*)(Kb + 8192 + row * 128 + (swz(row, chunk) << 4));
      }
#pragma unroll
      for (int i = 0; i < 8; ++i)
#pragma unroll
        for (int qt = 0; qt < QT; ++qt) S[0][i & 3][qt] = MFMA16(kfa[i], qf[qt][i >> 2], S[0][i & 3][qt]);
      __builtin_amdgcn_sched_barrier(0);
#pragma unroll
      for (int d = 0; d < 8; ++d) {
        const int row = d * 16 + c16;
        vfa[d] = *(const bf16x8*)(Vb + row * 128 + (swz(row, quad) << 4));
      }
#pragma unroll
      for (int i = 0; i < 8; ++i)
#pragma unroll
        for (int qt = 0; qt < QT; ++qt) S[NS - 1][i & 3][qt] = MFMA16(kfb[i], qf[qt][2 + (i >> 2)], S[NS - 1][i & 3][qt]);
      if (need_mask) {
#pragma unroll
        for (int s = 0; s < NS; ++s)
#pragma unroll
          for (int ksub = 0; ksub < 4; ++ksub)
#pragma unroll
            for (int qt = 0; qt < QT; ++qt)
#pragma unroll
              for (int r = 0; r < 4; ++r) {
                const int key = kt * 64 + ksub * 16 + quad * 4 + r;
                const int qpos = qw0 + qt * 16 + c16;
                if (key > qpos) S[s][ksub][qt][r] = -1e30f;
              }
      }
      float mx[NS][QT];
      bool need = false;
#pragma unroll
      for (int s = 0; s < NS; ++s)
#pragma unroll
        for (int qt = 0; qt < QT; ++qt) {
          float v = -1e30f;
#pragma unroll
          for (int ksub = 0; ksub < 4; ++ksub)
#pragma unroll
            for (int r = 0; r < 4; ++r) v = fmaxf(v, S[s][ksub][qt][r]);
          v = quadmax(v);
          mx[s][qt] = v;
          need = need || (v > 8.f);
        }
      if (__any(need) || kt == 0) {
#pragma unroll
        for (int s = 0; s < NS; ++s)
#pragma unroll
          for (int qt = 0; qt < QT; ++qt) {
            const float delta = (kt == 0) ? mx[s][qt] : fmaxf(mx[s][qt], 0.f);
            const float alpha = (kt == 0) ? 1.f : __builtin_amdgcn_exp2f(-delta);
            m[s][qt] += delta;
            st.l[s][qt] *= alpha;
#pragma unroll
            for (int d = 0; d < 8; ++d) st.O[s][d][qt] *= alpha;
#pragma unroll
            for (int ksub = 0; ksub < 4; ++ksub)
#pragma unroll
              for (int r = 0; r < 4; ++r) S[s][ksub][qt][r] -= delta;
          }
      }
#pragma unroll
      for (int s = 0; s < NS; ++s)
#pragma unroll
        for (int qt = 0; qt < QT; ++qt) {
          float psum = 0.f;
#pragma unroll
          for (int ksub = 0; ksub < 4; ++ksub)
#pragma unroll
            for (int r = 0; r < 4; ++r) { const float e = __builtin_amdgcn_exp2f(S[s][ksub][qt][r]); S[s][ksub][qt][r] = e; psum += e; }
          st.l[s][qt] += psum;
#pragma unroll
          for (int kk = 0; kk < 2; ++kk) {
            union { unsigned u[4]; bf16x8 v; } pk;
            pk.u[0] = pack2(S[s][2 * kk][qt][0], S[s][2 * kk][qt][1]);
            pk.u[1] = pack2(S[s][2 * kk][qt][2], S[s][2 * kk][qt][3]);
            pk.u[2] = pack2(S[s][2 * kk + 1][qt][0], S[s][2 * kk + 1][qt][1]);
            pk.u[3] = pack2(S[s][2 * kk + 1][qt][2], S[s][2 * kk + 1][qt][3]);
            pf[s][kk][qt] = pk.v;
          }
        }
      __builtin_amdgcn_sched_barrier(0);
#pragma unroll
      for (int d = 0; d < 8; ++d) {
        const int row = d * 16 + c16;
        vfb[d] = *(const bf16x8*)(Vb + row * 128 + (swz(row, 4 + quad) << 4));
      }
#pragma unroll
      for (int d = 0; d < 8; ++d)
#pragma unroll
        for (int s = 0; s < NS; ++s)
#pragma unroll
          for (int qt = 0; qt < QT; ++qt) st.O[s][d][qt] = MFMA16(vfa[d], pf[s][0][qt], st.O[s][d][qt]);
      __builtin_amdgcn_sched_barrier(0);
#pragma unroll
      for (int d = 0; d < 8; ++d)
#pragma unroll
        for (int s = 0; s < NS; ++s)
#pragma unroll
          for (int qt = 0; qt < QT; ++qt) st.O[s][d][qt] = MFMA16(vfb[d], pf[s][1][qt], st.O[s][d][qt]);
    }
    __syncthreads();
  }
#pragma unroll
  for (int s = 0; s < NS; ++s)
#pragma unroll
    for (int qt = 0; qt < QT; ++qt) {
      st.l[s][qt] = quadsum(st.l[s][qt]);
    }
}

DI void diff_attn_item(const Params& p, int layer, int qb, int bh, char* lds) {
  const int b = bh >> 2, h = bh & 3;
  const int tok0 = b * SEQ + qb * 64;
  const int tid_ = opaque_tid(), lane = tid_ & 63, w = tid_ >> 6, c16 = lane & 15, quad = lane >> 4;
  const int sidx = w & 1, g = w >> 1;
  const bf16_t* qp = p.proj + (size_t)tok0 * PW + C_Q + h * 128;
  const bf16_t* kp = p.proj + (size_t)b * SEQ * PW + C_K + h * 128;
  const bf16_t* vtp = p.vt + (size_t)((b * 4 + h) * 128) * SEQ;
  const int nkt = qb + 1;
  bf16x8 qf[2][2];
#pragma unroll
  for (int qt = 0; qt < 2; ++qt)
#pragma unroll
    for (int ff = 0; ff < 2; ++ff)
      qf[qt][ff] = *(const bf16x8*)(qp + (size_t)(g * 32 + qt * 16 + c16) * PW + (sidx * 2 + ff) * 32 + quad * 8);
  float m[2], l[2];
  f32x4 O[8][2];
#pragma unroll
  for (int qt = 0; qt < 2; ++qt) {
    m[qt] = 0.f; l[qt] = 0.f;
#pragma unroll
    for (int d = 0; d < 8; ++d) O[d][qt] = f32x4{0.f, 0.f, 0.f, 0.f};
  }
  const int prow = lane >> 3, pch = lane & 7;
  unsigned koff[4], voff[4];
#pragma unroll
  for (int i = 0; i < 4; ++i) {
    const int pi = w * 4 + i;
    { const int row = (pi & 7) * 8 + prow, sub = pi >> 3, c = pch ^ ((row >> 1) & 7);
      koff[i] = (unsigned)((row * PW + sub * 64 + c * 8) * 2); }
    { const int row = pi * 8 + prow, c = pch ^ ((row >> 1) & 7);
      voff[i] = (unsigned)((row * SEQ + c * 8) * 2); }
  }
  auto gload = [&](int kt, int buf) {
    char* base = lds + buf * 32768;
    const char* kt_base = (const char*)(kp + (size_t)kt * 64 * PW);
    const char* vt_base = (const char*)(vtp + (size_t)kt * 64);
#pragma unroll
    for (int i = 0; i < 4; ++i)
      __builtin_amdgcn_global_load_lds((const unsigned*)(kt_base + koff[i]), (unsigned*)(base + (w * 4 + i) * 1024 + lane * 16), 16, 0, 0);
#pragma unroll
    for (int i = 0; i < 4; ++i)
      __builtin_amdgcn_global_load_lds((const unsigned*)(vt_base + voff[i]), (unsigned*)(base + 16384 + (w * 4 + i) * 1024 + lane * 16), 16, 0, 0);
  };
  const int qw0 = qb * 64 + g * 32;
  gload(0, 0); __syncthreads();
  for (int kt = 0; kt < nkt; ++kt) {
    if (kt + 1 < nkt) gload(kt + 1, (kt + 1) & 1);
    const char* Kb = lds + (kt & 1) * 32768 + sidx * 8192;
    const char* Vb = lds + (kt & 1) * 32768 + 16384;
    if (kt * 64 <= qw0 + 31) {
      f32x4 S[4][2];
#pragma unroll
      for (int a = 0; a < 4; ++a)
#pragma unroll
        for (int qt = 0; qt < 2; ++qt) { const float nm = -m[qt]; S[a][qt] = f32x4{nm, nm, nm, nm}; }
      bf16x8 kf[8], vfa[8], vfb[8];
#pragma unroll
      for (int i = 0; i < 8; ++i) {
        const int row = (i & 3) * 16 + c16, chunk = (i >> 2) * 4 + quad;
        kf[i] = *(const bf16x8*)(Kb + row * 128 + (swz(row, chunk) << 4));
      }
      __builtin_amdgcn_sched_barrier(0);
#pragma unroll
      for (int d = 0; d < 8; ++d) { const int row = d * 16 + c16; vfa[d] = *(const bf16x8*)(Vb + row * 128 + (swz(row, quad) << 4)); }
#pragma unroll
      for (int i = 0; i < 8; ++i)
#pragma unroll
        for (int qt = 0; qt < 2; ++qt) S[i & 3][qt] = MFMA16(kf[i], qf[qt][i >> 2], S[i & 3][qt]);
      __builtin_amdgcn_sched_barrier(0);
      if (kt * 64 + 63 > qw0) {
#pragma unroll
        for (int ksub = 0; ksub < 4; ++ksub)
#pragma unroll
          for (int qt = 0; qt < 2; ++qt)
#pragma unroll
            for (int r = 0; r < 4; ++r) {
              const int key = kt * 64 + ksub * 16 + quad * 4 + r;
              if (key > qw0 + qt * 16 + c16) S[ksub][qt][r] = -1e30f;
            }
      }
      float mx[2];
      bool need = false;
#pragma unroll
      for (int qt = 0; qt < 2; ++qt) {
        float v = -1e30f;
#pragma unroll
        for (int ksub = 0; ksub < 4; ++ksub)
#pragma unroll
          for (int r = 0; r < 4; ++r) v = fmaxf(v, S[ksub][qt][r]);
        v = quadmax(v);
        mx[qt] = v;
        need = need || (v > 8.f);
      }
      if (__any(need) || kt == 0) {
#pragma unroll
        for (int qt = 0; qt < 2; ++qt) {
          const float delta = (kt == 0) ? mx[qt] : fmaxf(mx[qt], 0.f);
          const float alpha = (kt == 0) ? 1.f : __builtin_amdgcn_exp2f(-delta);
          m[qt] += delta;
          l[qt] *= alpha;
#pragma unroll
          for (int d = 0; d < 8; ++d) O[d][qt] *= alpha;
#pragma unroll
          for (int ksub = 0; ksub < 4; ++ksub)
#pragma unroll
            for (int r = 0; r < 4; ++r) S[ksub][qt][r] -= delta;
        }
      }
      bf16x8 pf[2][2];
#pragma unroll
      for (int qt = 0; qt < 2; ++qt) {
        float psum = 0.f;
#pragma unroll
        for (int ksub = 0; ksub < 4; ++ksub)
#pragma unroll
          for (int r = 0; r < 4; ++r) { const float e = __builtin_amdgcn_exp2f(S[ksub][qt][r]); S[ksub][qt][r] = e; psum += e; }
        l[qt] += psum;
#pragma unroll
        for (int kk = 0; kk < 2; ++kk) {
          union { unsigned u[4]; bf16x8 v; } pk;
          pk.u[0] = pack2(S[2 * kk][qt][0], S[2 * kk][qt][1]);
          pk.u[1] = pack2(S[2 * kk][qt][2], S[2 * kk][qt][3]);
          pk.u[2] = pack2(S[2 * kk + 1][qt][0], S[2 * kk + 1][qt][1]);
          pk.u[3] = pack2(S[2 * kk + 1][qt][2], S[2 * kk + 1][qt][3]);
          pf[kk][qt] = pk.v;
        }
      }
      __builtin_amdgcn_sched_barrier(0);
#pragma unroll
      for (int d = 0; d < 8; ++d) { const int row = d * 16 + c16; vfb[d] = *(const bf16x8*)(Vb + row * 128 + (swz(row, 4 + quad) << 4)); }
#pragma unroll
      for (int d = 0; d < 8; ++d)
#pragma unroll
        for (int qt = 0; qt < 2; ++qt) O[d][qt] = MFMA16(vfa[d], pf[0][qt], O[d][qt]);
      __builtin_amdgcn_sched_barrier(0);
#pragma unroll
      for (int d = 0; d < 8; ++d)
#pragma unroll
        for (int qt = 0; qt < 2; ++qt) O[d][qt] = MFMA16(vfb[d], pf[1][qt], O[d][qt]);
    }
    __syncthreads();
  }
  const float lam = p.lamv[layer];
  const float lam_init = 0.8f - 0.6f * expf(-0.3f * (float)layer);
  float* xch = (float*)(lds + g * 16384);
  float cf[2];
#pragma unroll
  for (int qt = 0; qt < 2; ++qt) cf[qt] = ((sidx == 0) ? 1.f : lam) / quadsum(l[qt]);
  if (sidx == 1) {
#pragma unroll
    for (int d = 0; d < 8; ++d)
#pragma unroll
      for (int qt = 0; qt < 2; ++qt)
#pragma unroll
        for (int r = 0; r < 4; ++r) xch[((d * 2 + qt) * 4 + r) * 64 + lane] = O[d][qt][r] * cf[qt];
  }
  __syncthreads();
  if (sidx == 0) {
    const float* sg = p.da_g + layer * 128;
#pragma unroll
    for (int qt = 0; qt < 2; ++qt) {
      float ss = 0.f;
#pragma unroll
      for (int d = 0; d < 8; ++d)
#pragma unroll
        for (int r = 0; r < 4; ++r) {
          const float o = O[d][qt][r] * cf[qt] - xch[((d * 2 + qt) * 4 + r) * 64 + lane];
          O[d][qt][r] = o; ss += o * o;
        }
      ss = quadsum(ss);
      const float rn = rsqrtf(ss * (1.f / 128.f) + 1e-6f) * (1.f - lam_init);
      const int tok = tok0 + g * 32 + qt * 16 + c16;
#pragma unroll
      for (int d = 0; d < 8; ++d) {
        const int dv0 = d * 16 + quad * 4;
        bf16_t* gp = p.proj + (size_t)tok * PW + C_BG + h * 128 + dv0;
        const uint2 gv = *(const uint2*)gp;
        const float g0 = __uint_as_float(gv.x << 16), g1 = __uint_as_float(gv.x & 0xffff0000u);
        const float g2 = __uint_as_float(gv.y << 16), g3 = __uint_as_float(gv.y & 0xffff0000u);
        uint2 o;
        o.x = pack2(O[d][qt][0] * rn * sg[dv0] * g0, O[d][qt][1] * rn * sg[dv0 + 1] * g1);
        o.y = pack2(O[d][qt][2] * rn * sg[dv0 + 2] * g2, O[d][qt][3] * rn * sg[dv0 + 3] * g3);
        *(uint2*)gp = o;
      }
    }
  }
}

DI void mem_attn_item(const Params& p, int layer, int item, char* lds) {
  const int qb = item >> 4, bh = item & 15, b = bh >> 2, h = bh & 3;
  const int tok0 = b * SEQ + qb * 64;
  const int tid_ = opaque_tid(), lane = tid_ & 63, w = tid_ >> 6, c16 = lane & 15, quad = lane >> 4;
  AttnState<1, 1> st;
  attn_core<1, 1>(st, p.proj + (size_t)tok0 * PW + C_MQ + h * 128, PW,
               p.memk + ((size_t)layer * 1024 + b * 256) * 512 + h * 128, 512,
               p.memvt + ((size_t)((layer * 4 + b) * 4 + h) * 128) * 256, 256, 4, 0, false, lds);
#pragma unroll
  for (int qt = 0; qt < 1; ++qt) {
    const float i1 = 1.f / st.l[0][qt];
    const int tok = tok0 + w * 16 + qt * 16 + c16;
#pragma unroll
    for (int d = 0; d < 8; ++d) {
      const int dv0 = d * 16 + quad * 4;
      bf16_t* g = p.proj + (size_t)tok * PW + C_MG + h * 128 + dv0;
      const uint2 gv = *(const uint2*)g;
      const float g0 = __uint_as_float(gv.x << 16), g1 = __uint_as_float(gv.x & 0xffff0000u);
      const float g2 = __uint_as_float(gv.y << 16), g3 = __uint_as_float(gv.y & 0xffff0000u);
      uint2 o;
      o.x = pack2(st.O[0][d][qt][0] * i1 * g0, st.O[0][d][qt][1] * i1 * g1);
      o.y = pack2(st.O[0][d][qt][2] * i1 * g2, st.O[0][d][qt][3] * i1 * g3);
      *(uint2*)g = o;
    }
  }
}

DI float gelu_tanh(float x) {
  const float u = 0.7978845608028654f * (x + 0.044715f * x * x * x);
  const float t = 1.f - 2.f / (1.f + __expf(2.f * u));
  return 0.5f * x * (1.f + t);
}

template <bool FINAL>
DI void s5_item(const Params& p, int layer, int item, char* lds) {
  const int gq = item & 7, c = (item >> 3) & 127, b = item >> 10;
  const int tid_ = opaque_tid(), lane = tid_ & 63, w = tid_ >> 6, c16 = lane & 15, quad = lane >> 4;
  const int g = gq * 4 + w;
  const int tok0 = b * SEQ + c * 64;
  float* bu = (float*)(lds + w * 16384);
  char* xsb = lds + w * 16384 + 8192;
  bf16x8 bbf[8];
  {
    const bf16_t* bt = p.s5bt + (size_t)(layer * 32 + g) * 128 * 32;
#pragma unroll
    for (int nt = 0; nt < 8; ++nt) bbf[nt] = *(const bf16x8*)(bt + (nt * 16 + c16) * 32 + quad * 8);
  }
  const float* par = p.s5par + (size_t)((layer * 32 + g) * 36) * 64 + lane;
  const float are = par[0], aim = par[64];
  float xr = 0.f, xi = 0.f;
  float* stp = p.s5st + ((size_t)((b * 32 + g) * 128)) * 128 + lane;
  bf16x8 cf[FINAL ? 4 : 1];
  float dsk = 0.f;
  if constexpr (FINAL) {
    xr = stp[c * 128]; xi = stp[c * 128 + 64];
    const float* cr = p.s5_cre + (size_t)((layer * 32 + g) * 16 + c16) * 64;
    const float* ci = p.s5_cim + (size_t)((layer * 32 + g) * 16 + c16) * 64;
#pragma unroll
    for (int ks = 0; ks < 4; ++ks) {
      const float* src = ((ks < 2) ? cr : ci) + (ks & 1) * 32 + quad * 8;
      const float sg = (ks < 2) ? 1.f : -1.f;
      const float4 v0 = *(const float4*)src, v1 = *(const float4*)(src + 4);
      union { unsigned u[4]; bf16x8 v; } pk;
      pk.u[0] = pack2(sg * v0.x, sg * v0.y); pk.u[1] = pack2(sg * v0.z, sg * v0.w);
      pk.u[2] = pack2(sg * v1.x, sg * v1.y); pk.u[3] = pack2(sg * v1.z, sg * v1.w);
      cf[ks] = pk.v;
    }
    dsk = p.s5_d[(layer * 32 + g) * 16 + c16];
  }
  for (int sc = 0; sc < 4; ++sc) {
    const int tb = tok0 + sc * 16;
    bf16x8 uf = bf16x8{0, 0, 0, 0, 0, 0, 0, 0};
    if (quad < 2) uf = *(const bf16x8*)(p.proj + (size_t)(tb + c16) * PW + C_AU + g * 16 + quad * 8);
    float uo[FINAL ? 4 : 1];
    if constexpr (FINAL) {
#pragma unroll
      for (int r = 0; r < 4; ++r) uo[r] = bf2f(p.proj[(size_t)(tb + quad * 4 + r) * PW + C_AU + g * 16 + c16]);
    }
#pragma unroll
    for (int nt = 0; nt < 8; ++nt) {
      f32x4 acc = MFMA16(uf, bbf[nt], (f32x4{0.f, 0.f, 0.f, 0.f}));
#pragma unroll
      for (int r = 0; r < 4; ++r) bu[(quad * 4 + r) * 128 + nt * 16 + c16] = acc[r];
    }
    wave_lds_sync();
#pragma unroll
    for (int tt = 0; tt < 16; ++tt) {
      const float br_ = bu[tt * 128 + lane], bi_ = bu[tt * 128 + 64 + lane];
      const float nr = are * xr - aim * xi + br_;
      const float ni = are * xi + aim * xr + bi_;
      xr = nr; xi = ni;
      if constexpr (FINAL) {
        *(bf16_t*)(xsb + tt * 256 + ((((lane >> 3)) ^ tt) << 4) + (lane & 7) * 2) = f2bf(xr);
        *(bf16_t*)(xsb + tt * 256 + (((8 + (lane >> 3)) ^ tt) << 4) + (lane & 7) * 2) = f2bf(xi);
      }
    }
    if constexpr (FINAL) {
      wave_lds_sync();
      f32x4 y = f32x4{0.f, 0.f, 0.f, 0.f};
#pragma unroll
      for (int ks = 0; ks < 4; ++ks) {
        const bf16x8 xf = *(const bf16x8*)(xsb + c16 * 256 + (((ks * 4 + quad) ^ c16) << 4));
        y = MFMA16(xf, cf[ks], y);
      }
#pragma unroll
      for (int r = 0; r < 4; ++r) {
        const float v = y[r] + dsk * uo[r];
        p.proj[(size_t)(tb + quad * 4 + r) * PW + C_AU + g * 16 + c16] = f2bf(gelu_tanh(v));
      }
    }
    wave_lds_sync();
  }
  if constexpr (!FINAL) { stp[c * 128] = xr; stp[c * 128 + 64] = xi; }
}

template <bool FINAL>
DI void lru_item(const Params& p, int layer, int item, char* lds) {
  const int half = item & 1, c = (item >> 1) & 127, b = item >> 8;
  const int tid_ = opaque_tid(), lane = tid_ & 63, w = tid_ >> 6, c16 = lane & 15, quad = lane >> 4;
  const int n = half * 4 + w, ch = n * 64 + lane;
  const int l0 = c * 64, tok0 = b * SEQ + l0;
  char* xcb = lds + w * 16384;
  float* aba = (float*)(xcb + 8192);
  float* abb = aba + 1024;
  bf16x8 wf[8][2];
  {
    const bf16_t* wp = p.lruwt + ((size_t)(layer * 8 + n) * 16) * 512 + lane * 8;
#pragma unroll
    for (int nt = 0; nt < 8; ++nt)
#pragma unroll
      for (int ks = 0; ks < 2; ++ks) wf[nt][ks] = *(const bf16x8*)(wp + (nt * 2 + ks) * 512);
  }
  float bav[4], bxv[4], spv[4];
#pragma unroll
  for (int nt = 0; nt < 4; ++nt) {
    const int cch = layer * 512 + n * 64 + nt * 16 + c16;
    bav[nt] = p.lru_ba[cch]; bxv[nt] = p.lru_bx[cch];
    spv[nt] = 8.f * log1pf(expf(-p.lru_lam[cch])) * 1.4426950408889634f;
  }
  {
    const float cw0 = p.conv_w[(layer * 4 + 0) * 512 + ch], cw1 = p.conv_w[(layer * 4 + 1) * 512 + ch];
    const float cw2 = p.conv_w[(layer * 4 + 2) * 512 + ch], cw3 = p.conv_w[(layer * 4 + 3) * 512 + ch];
    const float cb = p.conv_b[layer * 512 + ch];
    const bf16_t* xp = p.proj + (size_t)tok0 * PW + C_CX + ch;
    bf16_t xin[67];
#pragma unroll
    for (int t = 0; t < 3; ++t) xin[t] = (l0 + t - 3 >= 0) ? xp[(t - 3) * PW] : (bf16_t)0;
#pragma unroll
    for (int t = 3; t < 67; ++t) xin[t] = xp[(size_t)(t - 3) * PW];
#pragma unroll
    for (int t = 0; t < 64; ++t) {
      const float xc = cw0 * bf2f(xin[t]) + cw1 * bf2f(xin[t + 1]) + cw2 * bf2f(xin[t + 2]) + cw3 * bf2f(xin[t + 3]) + cb;
      *(bf16_t*)(xcb + t * 128 + (swz(t, lane >> 3) << 4) + (lane & 7) * 2) = f2bf(xc);
    }
  }
  float hst = 0.f, pr = 1.f;
  float* stp = p.lrust + ((size_t)(b * 128) * 512 + ch) * 2;
  if constexpr (FINAL) hst = stp[(size_t)c * 1024 + 1];
  wave_lds_sync();
  for (int sc = 0; sc < 4; ++sc) {
    float gv[FINAL ? 16 : 1];
    if constexpr (FINAL) {
      const bf16_t* gp0 = p.proj + (size_t)(tok0 + sc * 16) * PW + C_CG + ch;
#pragma unroll
      for (int t = 0; t < 16; ++t) gv[t] = bf2f(gp0[(size_t)t * PW]);
    }
    f32x4 acc[8];
#pragma unroll
    for (int nt = 0; nt < 8; ++nt) acc[nt] = f32x4{0.f, 0.f, 0.f, 0.f};
    const int arow = sc * 16 + c16;
#pragma unroll
    for (int ks = 0; ks < 2; ++ks) {
      const bf16x8 af = *(const bf16x8*)(xcb + arow * 128 + (swz(arow, ks * 4 + quad) << 4));
#pragma unroll
      for (int nt = 0; nt < 8; ++nt) acc[nt] = MFMA16(af, wf[nt][ks], acc[nt]);
    }
#pragma unroll
    for (int nt = 0; nt < 4; ++nt) {
      const int chl = nt * 16 + c16;
#pragma unroll
      for (int r = 0; r < 4; ++r) {
        const int tl = sc * 16 + quad * 4 + r;
        const float xcv = bf2f(*(const bf16_t*)(xcb + tl * 128 + (swz(tl, chl >> 3) << 4) + (chl & 7) * 2));
        const float ga = acc[nt][r] + bav[nt], gx = acc[nt + 4][r] + bxv[nt];
        const float rr = __builtin_amdgcn_rcpf(1.f + __builtin_amdgcn_exp2f(-1.4426950408889634f * ga));
        const float ig = __builtin_amdgcn_rcpf(1.f + __builtin_amdgcn_exp2f(-1.4426950408889634f * gx));
        const float la2 = -spv[nt] * rr;
        const float a = __builtin_amdgcn_exp2f(la2);
        const float y = la2 * 1.3862943611198906f;
        float q = 1.f + y * (1.f / 6.f);
        q = 1.f + y * 0.2f * q; q = 1.f + y * 0.25f * q; q = 1.f + y * (1.f / 3.f) * q; q = 1.f + y * 0.5f * q;
        const float om = (y < -0.5f) ? (1.f - a * a) : (-y * q);
        const float mult = __builtin_amdgcn_sqrtf(om);
        aba[(quad * 4 + r) * 64 + chl] = a;
        abb[(quad * 4 + r) * 64 + chl] = mult * ig * xcv;
      }
    }
    wave_lds_sync();
#pragma unroll
    for (int tt = 0; tt < 16; ++tt) {
      const float a = aba[tt * 64 + lane], bv = abb[tt * 64 + lane];
      hst = a * hst + bv;
      if constexpr (FINAL) p.proj[(size_t)(tok0 + sc * 16 + tt) * PW + C_CG + ch] = f2bf(hst * gv[tt]);
      else pr *= a;
    }
    wave_lds_sync();
  }
  if constexpr (!FINAL) { *(float2*)(stp + (size_t)c * 1024) = make_float2(pr, hst); }
}

DI void transpose_tile(const Params& p, int t, char* lds) {
  const float* src; bf16_t* dst; int K, N, kt, nt, perm = 0;
  const float* gs = nullptr;
  if (t < 5120) { int l = t / 1280, r = t % 1280; kt = r / 80; nt = r % 80; K = 1024; N = 5120; src = p.w_in + (size_t)l * K * N; dst = p.wt_in + (size_t)l * K * N; gs = p.norm_g + l * 1024; }
  else if (t < 7168) { t -= 5120; int l = t / 512, r = t % 512; kt = r / 16; nt = r % 16; K = 2048; N = 1024; src = p.w_out + (size_t)l * K * N; dst = p.wt_out + (size_t)l * K * N; }
  else if (t < 7680) { t -= 7168; int l = t / 128, r = t % 128; kt = r / 16; nt = r % 16; K = 512; N = 1024; src = p.s5_wglu + (size_t)l * K * N; dst = p.wt_glu + (size_t)l * K * N; perm = 1; }
  else { t -= 7680; int l = t / 256, r = t % 256; kt = r / 16; nt = r % 16; K = 1024; N = 1024; src = p.w_memkv + (size_t)l * K * N; dst = p.wt_mem + (size_t)l * K * N; }
  float* tile = (float*)lds;
  const int tid = opaque_tid(), ty = tid >> 4, tx = tid & 15;
  const int k0 = kt * 64, n0 = nt * 64;
#pragma unroll
  for (int i = 0; i < 4; ++i) {
    const int k = ty + 16 * i;
    const float4 v = *(const float4*)(src + (size_t)(k0 + k) * N + n0 + tx * 4);
    tile[k * 65 + tx * 4] = v.x; tile[k * 65 + tx * 4 + 1] = v.y; tile[k * 65 + tx * 4 + 2] = v.z; tile[k * 65 + tx * 4 + 3] = v.w;
  }
  __syncthreads();
  const int n = tid >> 2, kq = tid & 3;
  unsigned pk[8];
#pragma unroll
  for (int j = 0; j < 8; ++j) {
    const int kk = kq * 16 + 2 * j;
    const float s0 = gs ? gs[kt * 64 + kk] : 1.f, s1 = gs ? gs[kt * 64 + kk + 1] : 1.f;
    pk[j] = pack2(tile[kk * 65 + n] * s0, tile[(kk + 1) * 65 + n] * s1);
  }
  int row = n0 + n;
  if (perm) { const int j = row & 511; row = (j >> 5) * 64 + ((row >= 512) ? 32 : 0) + (j & 31); }
  uint4* d = (uint4*)(dst + (size_t)row * K + k0 + kq * 16);
  d[0] = make_uint4(pk[0], pk[1], pk[2], pk[3]);
  d[1] = make_uint4(pk[4], pk[5], pk[6], pk[7]);
  __syncthreads();
}

DI void phase0(const Params& p, char* lds) {
  const int tid = opaque_tid(), lane = tid & 63, w = tid >> 6;
  for (int t = blockIdx.x; t < 8704; t += gridDim.x) transpose_tile(p, t, lds);
  for (int it = blockIdx.x; it < 8192 + 1024; it += gridDim.x) {
    if (it < 8192) {
      const int row = it * 4 + w;
      const float* xr = p.x + (size_t)row * 1024;
      float4 v[4]; float ss = 0.f;
#pragma unroll
      for (int i = 0; i < 4; ++i) { v[i] = *(const float4*)(xr + i * 256 + lane * 4); ss += v[i].x * v[i].x + v[i].y * v[i].y + v[i].z * v[i].z + v[i].w * v[i].w; }
#pragma unroll
      for (int o = 32; o >= 1; o >>= 1) ss += __shfl_xor(ss, o);
#pragma unroll
      for (int i = 0; i < 4; ++i) {
        const int col = i * 256 + lane * 4;
        uint2 o; o.x = pack2(v[i].x, v[i].y); o.y = pack2(v[i].z, v[i].w);
        *(uint2*)(p.xb + (size_t)row * 1024 + col) = o;
      }
      if (lane == 0) p.rowss[row] = ss;
    } else {
      const int r = (it - 8192) * 4 + w, l = r >> 10, mr = r & 1023;
      const float* xr = p.mem + (size_t)mr * 1024;
      float4 v[4]; float ss = 0.f;
#pragma unroll
      for (int i = 0; i < 4; ++i) { v[i] = *(const float4*)(xr + i * 256 + lane * 4); ss += v[i].x * v[i].x + v[i].y * v[i].y + v[i].z * v[i].z + v[i].w * v[i].w; }
#pragma unroll
      for (int o = 32; o >= 1; o >>= 1) ss += __shfl_xor(ss, o);
      const float rs = rsqrtf(ss * (1.f / 1024.f) + 1e-6f);
#pragma unroll
      for (int i = 0; i < 4; ++i) {
        const int col = i * 256 + lane * 4;
        const float4 g = *(const float4*)(p.memng + l * 1024 + col);
        uint2 o; o.x = pack2(v[i].x * rs * g.x, v[i].y * rs * g.y); o.y = pack2(v[i].z * rs * g.z, v[i].w * rs * g.w);
        *(uint2*)(p.memn + (size_t)r * 1024 + col) = o;
      }
    }
  }
  const int gtid = blockIdx.x * 256 + tid, gstride = gridDim.x * 256;
  for (int i = gtid; i < NT * 8; i += gstride) {
    const int tok = i >> 3, f = i & 7;
    const float inv = powf(500000.f, -(float)(2 * f) / 16.f);
    const float ang = (float)p.pos[tok] * inv;
    float s, c; sincosf(ang, &s, &c);
    p.ropetab[tok * 16 + f] = c; p.ropetab[tok * 16 + 8 + f] = s;
  }
  for (int i = gtid; i < 4 * 32 * 64; i += gstride) {
    const int pp = i & 63, lg = i >> 6;
    const float dt = expf(p.s5_logdt[lg]);
    const float lr = p.s5_lre[i], li = p.s5_lim[i];
    const float mag = expf(lr * dt);
    const float are = mag * cosf(li * dt), aim = mag * sinf(li * dt);
    const float den = lr * lr + li * li;
    const float nr = are - 1.f, ni = aim;
    const float fre = (nr * lr + ni * li) / den, fim = (ni * lr - nr * li) / den;
    float* o = p.s5par + (size_t)lg * 36 * 64 + pp;
    o[0] = are; o[64] = aim;
    bf16_t* btr = p.s5bt + ((size_t)lg * 128 + pp) * 32;
    bf16_t* bti = btr + 64 * 32;
    for (int h = 0; h < 16; ++h) {
      const float br = p.s5_bre[(size_t)i * 16 + h], bi = p.s5_bim[(size_t)i * 16 + h];
      o[(2 + h) * 64] = fre * br - fim * bi;
      o[(18 + h) * 64] = fre * bi + fim * br;
      btr[h] = f2bf(fre * br - fim * bi); bti[h] = f2bf(fre * bi + fim * br);
      btr[16 + h] = 0; bti[16 + h] = 0;
    }
    float tr = are, ti = aim;
    for (int q = 0; q < 6; ++q) { const float a = tr * tr - ti * ti, bq = 2.f * tr * ti; tr = a; ti = bq; }
    o[34 * 64] = tr; o[35 * 64] = ti;
  }
  for (int i = gtid; i < 4 * 8 * 16 * 64; i += gstride) {
    const int ln = i & 63, fr = (i >> 6) & 15, nn = (i >> 10) & 7, l = i >> 13;
    const int nt = fr >> 1, ks = fr & 1, c = ln & 15, q = ln >> 4;
    const float* base = ((nt < 4) ? p.lru_wa : p.lru_wx) + (size_t)((l * 8 + nn) * 64) * 64 + (nt & 3) * 16 + c;
    unsigned pk[4];
    for (int jj = 0; jj < 4; ++jj) { const int k = ks * 32 + q * 8 + jj * 2; pk[jj] = pack2(base[k * 64], base[(k + 1) * 64]); }
    *(uint4*)(p.lruwt + (size_t)i * 8) = make_uint4(pk[0], pk[1], pk[2], pk[3]);
  }
  for (int i = gtid; i < 15 * NT; i += gstride) p.rowss[NT + i] = 0.f;
  if (gtid < 64) p.ctr[gtid] = 0u;
  if (gtid < 4) {
    float s1 = 0.f, s2 = 0.f;
    for (int j = 0; j < 64; ++j) { s1 += p.da_q1[gtid * 64 + j] * p.da_k1[gtid * 64 + j]; s2 += p.da_q2[gtid * 64 + j] * p.da_k2[gtid * 64 + j]; }
    p.lamv[gtid] = expf(s1) - expf(s2) + (0.8f - 0.6f * expf(-0.3f * (float)gtid));
  }
}

DI void carry_phase(const Params& p, int layer) {
  for (int it = blockIdx.x; it < 40; it += gridDim.x) {
    if (it < 32) {
      const int idx = it * 256 + threadIdx.x, b = idx >> 11, g = (idx >> 6) & 31, pp = idx & 63;
      const float* par = p.s5par + (size_t)((layer * 32 + g) * 36) * 64 + pp;
      const float tre = par[34 * 64], tim = par[35 * 64];
      float* base = p.s5st + ((size_t)((b * 32 + g) * 128)) * 128 + pp;
      float xr = 0.f, xi = 0.f;
      for (int c0 = 0; c0 < 128; c0 += 16) {
        float er[16], ei[16];
#pragma unroll
        for (int j = 0; j < 16; ++j) { er[j] = base[(c0 + j) * 128]; ei[j] = base[(c0 + j) * 128 + 64]; }
#pragma unroll
        for (int j = 0; j < 16; ++j) {
          base[(c0 + j) * 128] = xr; base[(c0 + j) * 128 + 64] = xi;
          const float nr = tre * xr - tim * xi + er[j];
          const float ni = tre * xi + tim * xr + ei[j];
          xr = nr; xi = ni;
        }
      }
    } else {
      const int idx = (it - 32) * 256 + threadIdx.x, b = idx >> 9, ch = idx & 511;
      float* base = p.lrust + ((size_t)(b * 128) * 512 + ch) * 2;
      float h = 0.f;
      for (int c0 = 0; c0 < 128; c0 += 16) {
        float2 e[16];
#pragma unroll
        for (int j = 0; j < 16; ++j) e[j] = *(const float2*)(base + (size_t)(c0 + j) * 1024);
#pragma unroll
        for (int j = 0; j < 16; ++j) {
          base[(size_t)(c0 + j) * 1024 + 1] = h;
          h = e[j].x * h + e[j].y;
        }
      }
    }
  }
}

DI bool tile_map(int i, int ncols, int& m, int& n) {
  if (gridDim.x == 512) {
    const int x = blockIdx.x & 7, j = blockIdx.x >> 3, ncg = ncols >> 3;
    m = 16 * x + 8 * (i / ncg) + (j >> 3);
    n = 8 * (i % ncg) + (j & 7);
    return i < 2 * ncg;
  }
  const int t = blockIdx.x + i * gridDim.x;
  m = t / ncols; n = t % ncols;
  return t < 128 * ncols;
}

DI int next_item(unsigned* ctr, int* sh) {
  __syncthreads();
  if (threadIdx.x == 0) *sh = (int)atomicAdd(ctr, 1u);
  __syncthreads();
  return *sh;
}

__global__ void __launch_bounds__(256, 2) hymba_forward(Params p) {
  extern __shared__ __attribute__((aligned(16))) char lds[];
  __shared__ uint4 xb_words;
  cg::grid_group grid = cg::this_grid();
  int* sh_item = (int*)(lds + 73728);
  if (threadIdx.x == 0) xb_words = make_uint4(0u, 0u, 0u, 0u);
  __syncthreads();
  XcdBarrier xb = xcd_barrier_post(p.bar, (volatile LAS unsigned*)&xb_words);
  phase0(p, lds);
  if (gridDim.x == 0x7fffffffu) grid.sync();
  xcd_barrier(xb);
  for (int layer = 0; layer < 4; ++layer) {
    {
      GemmArgs ga; ga.A = p.xb; ga.lda = 1024; ga.mix = 0; ga.Bt = p.wt_in + (size_t)layer * 5120 * 1024; ga.K = 1024;
      EpiArgs ea; ea.p = &p; ea.layer = layer; ea.rowss = p.rowss + (size_t)layer * 16 * NT; ea.xsrc = nullptr; ea.gnext = nullptr; ea.rowss_next = nullptr;
      for (int i = 0;; ++i) { int m, n; if (!tile_map(i, 40, m, n)) break; gemm_tile<EPI_INPROJ>(ga, ea, m * 256, n * 128, lds); }
      if (layer == 0) {
        for (int t = blockIdx.x; t < 128; t += gridDim.x) {
          const int lm = t >> 5, r = t & 31;
          GemmArgs gm; gm.A = p.memn + (size_t)lm * 1024 * 1024; gm.lda = 1024; gm.mix = 0; gm.Bt = p.wt_mem + (size_t)lm * 1024 * 1024; gm.K = 1024;
          EpiArgs em = ea; em.layer = lm;
          gemm_tile<EPI_MEMKV>(gm, em, (r >> 3) * 256, (r & 7) * 128, lds);
        }
      }
    }
    xcd_barrier(xb);
    {
      unsigned* ctr = p.ctr + layer * 2;
      for (;;) {
        const int it = next_item(ctr, sh_item);
        if (it >= 1024 + 4096) break;
        if (it < 1024) lru_item<false>(p, layer, it, lds);
        else s5_item<false>(p, layer, it - 1024, lds);
      }
    }
    xcd_barrier(xb);
    carry_phase(p, layer);
    xcd_barrier(xb);
    {
      unsigned* actr = p.ctr + 16 + layer * 8 + (blockIdx.x & 7);
      for (;;) {
        const int it = next_item(actr, sh_item);
        if (it >= 256) break;
        diff_attn_item(p, layer, 127 - (it >> 1), (blockIdx.x & 7) * 2 + (it & 1), lds);
      }
      unsigned* ctr = p.ctr + layer * 2 + 1;
      for (;;) {
        const int it = next_item(ctr, sh_item);
        if (it >= 1024 + 4096 + 2048) break;
        if (it < 1024) lru_item<true>(p, layer, it, lds);
        else if (it < 5120) s5_item<true>(p, layer, it - 1024, lds);
        else mem_attn_item(p, layer, it - 5120, lds);
      }
    }
    xcd_barrier(xb);
    {
      GemmArgs ga; ga.A = p.proj + C_AU; ga.lda = PW; ga.mix = 0; ga.Bt = p.wt_glu + (size_t)layer * 1024 * 512; ga.K = 512;
      EpiArgs ea; ea.p = &p; ea.layer = layer; ea.rowss = nullptr; ea.xsrc = nullptr; ea.gnext = nullptr; ea.rowss_next = nullptr;
      for (int i = 0;; ++i) { int m, n; if (!tile_map(i, 8, m, n)) break; gemm_tile<EPI_GLU>(ga, ea, m * 256, n * 128, lds); }
    }
    xcd_barrier(xb);
    {
      GemmArgs ga; ga.A = p.proj; ga.lda = PW; ga.mix = 1; ga.Bt = p.wt_out + (size_t)layer * 1024 * 2048; ga.K = 2048;
      EpiArgs ea; ea.p = &p; ea.layer = layer; ea.rowss = nullptr;
      ea.xsrc = nullptr;
      ea.gnext = (layer < 3) ? (p.norm_g + (layer + 1) * 1024) : nullptr;
      ea.rowss_next = p.rowss + (size_t)(layer + 1) * 16 * NT;
      for (int i = 0;; ++i) { int m, n; if (!tile_map(i, 8, m, n)) break; gemm_tile<EPI_OUT>(ga, ea, m * 256, n * 128, lds); }
    }
    xcd_barrier(xb);
  }
  {
    const float* rss = p.rowss + (size_t)4 * 16 * NT;
    const int lane = threadIdx.x & 63, w = threadIdx.x >> 6;
    for (int row = blockIdx.x * 4 + w; row < NT; row += gridDim.x * 4) {
      const float rs = rsqrtf(sum16(rss, row) * (1.f / 1024.f) + 1e-6f);
#pragma unroll
      for (int i = 0; i < 4; ++i) {
        const int col = i * 256 + lane * 4;
        const uint2 u = *(const uint2*)(p.xb + (size_t)row * 1024 + col);
        const float4 g = *(const float4*)(p.fng + col);
        float4 v;
        v.x = __uint_as_float(u.x << 16) * rs * g.x; v.y = __uint_as_float(u.x & 0xffff0000u) * rs * g.y;
        v.z = __uint_as_float(u.y << 16) * rs * g.z; v.w = __uint_as_float(u.y & 0xffff0000u) * rs * g.w;
        *(float4*)(p.out + (size_t)row * 1024 + col) = v;
      }
    }
  }
}

extern "C" void kernel_launch(void* const* d_in, const int* in_sizes, int n_in, void* d_out, int out_size, void* d_ws,
                              size_t ws_size, hipStream_t stream) {
  Params p{};
  p.x = (const float*)d_in[0]; p.mem = (const float*)d_in[1]; p.pos = (const int*)d_in[2];
  p.norm_g = (const float*)d_in[3]; p.w_in = (const float*)d_in[4]; p.w_out = (const float*)d_in[5];
  p.s5_lre = (const float*)d_in[6]; p.s5_lim = (const float*)d_in[7]; p.s5_logdt = (const float*)d_in[8];
  p.s5_bre = (const float*)d_in[9]; p.s5_bim = (const float*)d_in[10]; p.s5_cre = (const float*)d_in[11];
  p.s5_cim = (const float*)d_in[12]; p.s5_d = (const float*)d_in[13]; p.s5_wglu = (const float*)d_in[14];
  p.da_q1 = (const float*)d_in[15]; p.da_k1 = (const float*)d_in[16]; p.da_q2 = (const float*)d_in[17];
  p.da_k2 = (const float*)d_in[18]; p.da_g = (const float*)d_in[19];
  p.conv_w = (const float*)d_in[20]; p.conv_b = (const float*)d_in[21]; p.lru_wa = (const float*)d_in[22];
  p.lru_ba = (const float*)d_in[23]; p.lru_wx = (const float*)d_in[24]; p.lru_bx = (const float*)d_in[25];
  p.lru_lam = (const float*)d_in[26]; p.memng = (const float*)d_in[27]; p.w_memkv = (const float*)d_in[28];
  p.fng = (const float*)d_in[29];
  p.out = (float*)d_out;
  char* ws = (char*)d_ws; size_t off = 0;
  auto take = [&](size_t bytes) { char* r = ws + off; off += (bytes + 255) & ~(size_t)255; return r; };
  p.proj = (bf16_t*)take((size_t)NT * PW * 2);
  p.vt = (bf16_t*)take((size_t)NT * 512 * 2);
  p.xb = (bf16_t*)take((size_t)NT * 1024 * 2);
  p.wt_in = (bf16_t*)take((size_t)4 * 5120 * 1024 * 2);
  p.wt_out = (bf16_t*)take((size_t)4 * 1024 * 2048 * 2);
  p.wt_glu = (bf16_t*)take((size_t)4 * 1024 * 512 * 2);
  p.wt_mem = (bf16_t*)take((size_t)4 * 1024 * 1024 * 2);
  p.memn = (bf16_t*)take((size_t)4 * 1024 * 1024 * 2);
  p.memk = (bf16_t*)take((size_t)4 * 1024 * 512 * 2);
  p.memvt = (bf16_t*)take((size_t)4 * 1024 * 512 * 2);
  p.rowss = (float*)take((size_t)5 * 16 * NT * 4);
  p.ropetab = (float*)take((size_t)NT * 16 * 4);
  p.s5par = (float*)take((size_t)4 * 32 * 36 * 64 * 4);
  p.s5st = (float*)take((size_t)4 * 32 * 128 * 128 * 4);
  p.lrust = (float*)take((size_t)4 * 128 * 512 * 2 * 4);
  p.lamv = (float*)take(256);
  p.s5bt = (bf16_t*)take((size_t)4 * 32 * 128 * 32 * 2);
  p.lruwt = (bf16_t*)take((size_t)4 * 8 * 16 * 64 * 8 * 2);
  p.ctr = (unsigned*)take(1024);
  p.bar = (unsigned*)take((size_t)XCD_BAR_WORDS * 4);
  if (off > ws_size) { fprintf(stderr, "workspace too small: need %zu have %zu\n", off, ws_size); return; }
  static int grid_blocks = 0;
  if (!grid_blocks) {
    int dev = 0, cus = 0, per_cu = 0;
    hipGetDevice(&dev);
    hipDeviceGetAttribute(&cus, hipDeviceAttributeMultiprocessorCount, dev);
    hipFuncSetAttribute((const void*)hymba_forward, hipFuncAttributeMaxDynamicSharedMemorySize, LDS_BYTES);
    hipOccupancyMaxActiveBlocksPerMultiprocessor(&per_cu, hymba_forward, 256, LDS_BYTES);
    if (per_cu < 1) per_cu = 1;
    if (per_cu > 2) per_cu = 2;
    grid_blocks = cus * per_cu;
  }
  hipMemsetAsync(p.bar, 0, (size_t)XCD_BAR_WORDS * 4, stream);
  void* args[] = {&p};
  hipError_t e = hipLaunchCooperativeKernel((const void*)hymba_forward, dim3(grid_blocks), dim3(256), args, LDS_BYTES, stream);
  if (e != hipSuccess) fprintf(stderr, "cooperative launch failed: %s (grid %d)\n", hipGetErrorString(e), grid_blocks);
}
```
